# Optimizing an MI355X kernel written in HIP

```python
import math
import jax
import jax.numpy as jnp
from jax import lax
import numpy as np

D_MODEL = 1024
BATCH = 16
SEQ = 4096
DEPTH = 1

ATT_HEADS = 8
HEAD_DIM = 64
ATT_WIDTH = ATT_HEADS * HEAD_DIM
MOBA_BLOCK = 256
MOBA_TOPK = 3
QUERY_CHUNK = 16
NUM_BUCKETS = 32
MAX_DISTANCE = 128
SSM_WIDTH = 256
SSM_GROUP = 16
SSM_GROUPS = SSM_WIDTH // SSM_GROUP
SSM_STATE = 64
DT_MIN = 0.001
DT_MAX = 0.1
IN_SPLITS = (ATT_WIDTH, ATT_WIDTH, ATT_WIDTH, SSM_WIDTH, D_MODEL, D_MODEL)
IN_WIDTH = sum(IN_SPLITS)
N_GROUPS = 4
EXPERTS_PER_GROUP = 8
N_EXPERTS = N_GROUPS * EXPERTS_PER_GROUP
EXPERT_TOPK = 2
D_EXPERT = D_MODEL // 2
MOE_BLOCK = 256
ADA_CHUNKS = 6
RMS_EPS = 1e-6
NEG_INF = -1e30

kernel_name = "hybrid_moba_s5_hiermoe_block"


def rms_norm(x, gain):
    xf = x.astype(jnp.float32)
    y = xf * lax.rsqrt(jnp.mean(xf * xf, axis=-1, keepdims=True) + RMS_EPS)
    return (y * gain.astype(jnp.float32)).astype(x.dtype)


def t5_bucket(dist):
    n = jnp.maximum(dist, 0)
    max_exact = NUM_BUCKETS // 2
    nf = jnp.maximum(n, 1).astype(jnp.float32)
    large = max_exact + (jnp.log(nf / max_exact) / math.log(MAX_DISTANCE / max_exact)
                         * (NUM_BUCKETS - max_exact)).astype(jnp.int32)
    large = jnp.minimum(large, NUM_BUCKETS - 1)
    return jnp.where(n < max_exact, n, large)


def moba_attention(q, k, v, rel_bias):
    bsz, s, nh, dh = q.shape
    nb = -(-s // MOBA_BLOCK)
    s_pad = nb * MOBA_BLOCK
    n_chunks = s_pad // QUERY_CHUNK
    k_sel = min(MOBA_TOPK, nb)
    pad = ((0, 0), (0, s_pad - s), (0, 0), (0, 0))
    q, k, v = [jnp.pad(t, pad).transpose(0, 2, 1, 3) for t in (q, k, v)]
    kb = k.reshape(bsz, nh, nb, MOBA_BLOCK, dh)
    vb = v.reshape(bsz, nh, nb, MOBA_BLOCK, dh)
    k_mean = jnp.mean(kb.astype(jnp.float32), axis=3)
    gate = jnp.einsum("bhsd,bhnd->bhsn", q.astype(jnp.float32), k_mean)
    q_blk = jnp.arange(s_pad) // MOBA_BLOCK
    past = jnp.arange(nb)[None, :] < q_blk[:, None]
    gate = jnp.where(past, gate, NEG_INF)
    _, sel = lax.top_k(gate, k_sel)
    sel_valid = sel < q_blk[:, None]

    def to_chunks(t):
        t = t.reshape(bsz, nh, n_chunks, QUERY_CHUNK, *t.shape[3:])
        return jnp.moveaxis(t, 2, 0)

    head_bias = rel_bias.T.astype(jnp.float32)
    b_ix = jnp.arange(bsz)[:, None, None, None]
    h_ix = jnp.arange(nh)[None, :, None, None]
    h_ix5 = jnp.arange(nh)[None, :, None, None, None]
    offs = jnp.arange(MOBA_BLOCK)
    scale = HEAD_DIM ** -0.5

    def chunk_attend(args):
        qc, selc, validc, ci = args
        q_pos = ci * QUERY_CHUNK + jnp.arange(QUERY_CHUNK)
        own = (ci * QUERY_CHUNK) // MOBA_BLOCK
        kg = kb[b_ix, h_ix, selc]
        vg = vb[b_ix, h_ix, selc]
        key_pos = selc[..., None] * MOBA_BLOCK + offs
        bucket = t5_bucket(q_pos[None, None, :, None, None] - key_pos)
        bias_sel = head_bias[h_ix5, bucket]
        s_sel = jnp.einsum("bhqd,bhqnkd->bhqnk", qc, kg).astype(jnp.float32) * scale + bias_sel
        s_sel = jnp.where(validc[..., None], s_sel, NEG_INF).reshape(bsz, nh, QUERY_CHUNK, k_sel * MOBA_BLOCK)
        k_own = lax.dynamic_index_in_dim(kb, own, axis=2, keepdims=False)
        v_own = lax.dynamic_index_in_dim(vb, own, axis=2, keepdims=False)
        dist = q_pos[:, None] - (own * MOBA_BLOCK + offs)[None, :]
        bias_own = head_bias[:, t5_bucket(dist)]
        s_own = jnp.einsum("bhqd,bhkd->bhqk", qc, k_own).astype(jnp.float32) * scale + bias_own
        s_own = jnp.where(dist >= 0, s_own, NEG_INF)
        p = jax.nn.softmax(jnp.concatenate([s_sel, s_own], axis=-1), axis=-1)
        p_sel = p[..., :k_sel * MOBA_BLOCK].reshape(bsz, nh, QUERY_CHUNK, k_sel, MOBA_BLOCK).astype(vg.dtype)
        p_own = p[..., k_sel * MOBA_BLOCK:].astype(v_own.dtype)
        return (jnp.einsum("bhqnk,bhqnkd->bhqd", p_sel, vg)
                + jnp.einsum("bhqk,bhkd->bhqd", p_own, v_own))

    out = lax.map(chunk_attend, (to_chunks(q), to_chunks(sel), to_chunks(sel_valid),
                                 jnp.arange(n_chunks)))
    out = jnp.moveaxis(out, 0, 2).reshape(bsz, nh, s_pad, dh)[:, :, :s]
    return out.transpose(0, 2, 1, 3).reshape(bsz, s, nh * dh)


def s5_ssm(u, lam_re, lam_im, log_dt, b_re, b_im, c_re, c_im, d_skip):
    bsz, s, _ = u.shape
    uf = u.astype(jnp.float32).reshape(bsz, s, SSM_GROUPS, SSM_GROUP)
    dt = jnp.exp(log_dt.astype(jnp.float32))[:, None]
    lr = lam_re.astype(jnp.float32)
    li = lam_im.astype(jnp.float32)
    mag = jnp.exp(lr * dt)
    ab_re = mag * jnp.cos(li * dt)
    ab_im = mag * jnp.sin(li * dt)
    den = lr * lr + li * li
    nr = ab_re - 1.0
    ni = ab_im
    f_re = (nr * lr + ni * li) / den
    f_im = (ni * lr - nr * li) / den
    br = b_re.astype(jnp.float32)
    bi = b_im.astype(jnp.float32)
    bb_re = f_re[..., None] * br - f_im[..., None] * bi
    bb_im = f_re[..., None] * bi + f_im[..., None] * br
    bu_re = jnp.einsum("gpc,bsgc->bsgp", bb_re, uf)
    bu_im = jnp.einsum("gpc,bsgc->bsgp", bb_im, uf)
    a_re = jnp.broadcast_to(ab_re, (1, s, SSM_GROUPS, SSM_STATE))
    a_im = jnp.broadcast_to(ab_im, (1, s, SSM_GROUPS, SSM_STATE))

    def combine(left, right):
        a1r, a1i, b1r, b1i = left
        a2r, a2i, b2r, b2i = right
        return (a1r * a2r - a1i * a2i, a1r * a2i + a1i * a2r,
                a2r * b1r - a2i * b1i + b2r, a2r * b1i + a2i * b1r + b2i)

    _, _, xr, xi = lax.associative_scan(combine, (a_re, a_im, bu_re, bu_im), axis=1)
    y = (jnp.einsum("gcp,bsgp->bsgc", c_re.astype(jnp.float32), xr)
         - jnp.einsum("gcp,bsgp->bsgc", c_im.astype(jnp.float32), xi))
    y = y.reshape(bsz, s, SSM_WIDTH) + d_skip.astype(jnp.float32) * u.astype(jnp.float32)
    return y.astype(u.dtype)


def hier_moe(h, w_rg, b_rg, w_re, b_re, w_gate, w_up, w_down):
    bsz, s, d = h.shape
    n_tok = bsz * s
    xt = h.reshape(n_tok, d)
    xf = xt.astype(jnp.float32)
    g_prob = jax.nn.softmax(xf @ w_rg.astype(jnp.float32) + b_rg.astype(jnp.float32), axis=-1)
    g_p, g_idx = lax.top_k(g_prob, 1)
    e_logits = (xf @ w_re.astype(jnp.float32) + b_re.astype(jnp.float32)).reshape(n_tok, N_GROUPS, EXPERTS_PER_GROUP)
    e_logits = e_logits[jnp.arange(n_tok), g_idx[:, 0]]
    e_prob = jax.nn.softmax(e_logits, axis=-1)
    e_p, e_local = lax.top_k(e_prob, EXPERT_TOPK)
    weights = g_p * e_p / jnp.sum(e_p, axis=-1, keepdims=True)
    experts = g_idx * EXPERTS_PER_GROUP + e_local
    n_assign = n_tok * EXPERT_TOPK
    flat_e = experts.reshape(-1)
    flat_w = weights.reshape(-1)
    flat_tok = jnp.arange(n_assign, dtype=jnp.int32) // EXPERT_TOPK
    order = jnp.argsort(flat_e)
    e_sorted = flat_e[order]
    counts = jnp.bincount(flat_e, length=N_EXPERTS)
    start = jnp.cumsum(counts) - counts
    padded = (counts + MOE_BLOCK - 1) // MOE_BLOCK * MOE_BLOCK
    pend = jnp.cumsum(padded)
    pstart = pend - padded
    dest = pstart[e_sorted] + (jnp.arange(n_assign) - start[e_sorted])
    n_blocks = -(-n_assign // MOE_BLOCK) + N_EXPERTS
    n_rows = n_blocks * MOE_BLOCK
    row_tok = jnp.full((n_rows,), n_tok, jnp.int32).at[dest].set(flat_tok[order])
    row_w = jnp.zeros((n_rows,), jnp.float32).at[dest].set(flat_w[order])
    block_e = jnp.minimum(jnp.searchsorted(pend, jnp.arange(n_blocks) * MOE_BLOCK, side="right"), N_EXPERTS - 1)
    x_pad = jnp.concatenate([xt, jnp.zeros((1, d), xt.dtype)], axis=0)
    x_rows = x_pad[row_tok].reshape(n_blocks, MOE_BLOCK, d)

    def expert_block(args):
        xb, e = args
        hid = jax.nn.silu(xb @ w_gate[e]) * (xb @ w_up[e])
        return hid @ w_down[e]

    y_rows = lax.map(expert_block, (x_rows, block_e)).reshape(n_rows, d)
    y = jax.ops.segment_sum(y_rows.astype(jnp.float32) * row_w[:, None], row_tok,
                            num_segments=n_tok + 1)[:n_tok]
    return y.reshape(bsz, s, d).astype(h.dtype)


def setup_inputs(seed: int = 0) -> dict:
    key = jax.random.key(seed)
    ks = iter(jax.random.split(key, 40))
    L = DEPTH

    def nrm(shape, scale):
        return jax.random.normal(next(ks), shape, jnp.float32) * scale

    n_idx = jnp.arange(SSM_STATE, dtype=jnp.float32)
    return {
        "x": nrm((BATCH, SEQ, D_MODEL), 1.0),
        "c": nrm((BATCH, D_MODEL), 1.0),
        "rel_bias": nrm((NUM_BUCKETS, ATT_HEADS), 0.5),
        "w_ada": nrm((L, D_MODEL, ADA_CHUNKS * D_MODEL), 0.2 * D_MODEL ** -0.5),
        "b_ada": nrm((L, ADA_CHUNKS * D_MODEL), 0.02),
        "g_pre_mix": 1.0 + nrm((L, D_MODEL), 0.05),
        "g_post_mix": 1.0 + nrm((L, D_MODEL), 0.05),
        "w_in": nrm((L, D_MODEL, IN_WIDTH), D_MODEL ** -0.5),
        "w_att_out": nrm((L, ATT_WIDTH, D_MODEL), ATT_WIDTH ** -0.5),
        "ssm_lambda_re": -0.5 + nrm((L, SSM_GROUPS, SSM_STATE), 0.01),
        "ssm_lambda_im": math.pi * n_idx + nrm((L, SSM_GROUPS, SSM_STATE), 0.01),
        "ssm_log_dt": jax.random.uniform(next(ks), (L, SSM_GROUPS), jnp.float32,
                                         minval=math.log(DT_MIN), maxval=math.log(DT_MAX)),
        "ssm_b_re": nrm((L, SSM_GROUPS, SSM_STATE, SSM_GROUP), (2 * SSM_GROUP) ** -0.5),
        "ssm_b_im": nrm((L, SSM_GROUPS, SSM_STATE, SSM_GROUP), (2 * SSM_GROUP) ** -0.5),
        "ssm_c_re": nrm((L, SSM_GROUPS, SSM_GROUP, SSM_STATE), (2 * SSM_STATE) ** -0.5),
        "ssm_c_im": nrm((L, SSM_GROUPS, SSM_GROUP, SSM_STATE), (2 * SSM_STATE) ** -0.5),
        "ssm_d": nrm((L, SSM_WIDTH), 1.0),
        "w_glu_val": nrm((L, SSM_WIDTH, D_MODEL), SSM_WIDTH ** -0.5),
        "w_glu_gate": nrm((L, SSM_WIDTH, D_MODEL), SSM_WIDTH ** -0.5),
        "w_mix_out": nrm((L, D_MODEL, D_MODEL), D_MODEL ** -0.5),
        "g_pre_ffn": 1.0 + nrm((L, D_MODEL), 0.05),
        "g_post_ffn": 1.0 + nrm((L, D_MODEL), 0.05),
        "w_router_group": nrm((L, D_MODEL, N_GROUPS), D_MODEL ** -0.5),
        "b_router_group": nrm((L, N_GROUPS), 0.01),
        "w_router_expert": nrm((L, D_MODEL, N_EXPERTS), D_MODEL ** -0.5),
        "b_router_expert": nrm((L, N_EXPERTS), 0.01),
        "w_exp_gate": nrm((L, N_EXPERTS, D_MODEL, D_EXPERT), D_MODEL ** -0.5),
        "w_exp_up": nrm((L, N_EXPERTS, D_MODEL, D_EXPERT), D_MODEL ** -0.5),
        "w_exp_down": nrm((L, N_EXPERTS, D_EXPERT, D_MODEL), D_EXPERT ** -0.5),
    }


def reference(x, c, rel_bias, w_ada, b_ada, g_pre_mix, g_post_mix, w_in, w_att_out,
              ssm_lambda_re, ssm_lambda_im, ssm_log_dt, ssm_b_re, ssm_b_im, ssm_c_re, ssm_c_im,
              ssm_d, w_glu_val, w_glu_gate, w_mix_out, g_pre_ffn, g_post_ffn,
              w_router_group, b_router_group, w_router_expert, b_router_expert,
              w_exp_gate, w_exp_up, w_exp_down):
    bsz, s, _ = x.shape
    split_points = [int(p) for p in np.cumsum(IN_SPLITS)[:-1]]
    c_act = jax.nn.silu(c)
    for l in range(DEPTH):
        mod = c_act @ w_ada[l] + b_ada[l]
        shift1, scale1, gate1, shift2, scale2, gate2 = [m[:, None, :] for m in jnp.split(mod, ADA_CHUNKS, axis=-1)]
        h = rms_norm(x, g_pre_mix[l]) * (1.0 + scale1) + shift1
        proj = h @ w_in[l]
        q, k, v, u, g_att, g_ssm = jnp.split(proj, split_points, axis=-1)
        q = q.reshape(bsz, s, ATT_HEADS, HEAD_DIM)
        k = k.reshape(bsz, s, ATT_HEADS, HEAD_DIM)
        v = v.reshape(bsz, s, ATT_HEADS, HEAD_DIM)
        a_br = moba_attention(q, k, v, rel_bias) @ w_att_out[l]
        y_ssm = s5_ssm(u, ssm_lambda_re[l], ssm_lambda_im[l], ssm_log_dt[l], ssm_b_re[l], ssm_b_im[l],
                       ssm_c_re[l], ssm_c_im[l], ssm_d[l])
        z = jax.nn.gelu(y_ssm)
        s_br = (z @ w_glu_val[l]) * jax.nn.sigmoid(z @ w_glu_gate[l])
        merged = jax.nn.sigmoid(g_att) * a_br + jax.nn.sigmoid(g_ssm) * s_br
        x = x + gate1 * rms_norm(merged @ w_mix_out[l], g_post_mix[l])
        h = rms_norm(x, g_pre_ffn[l]) * (1.0 + scale2) + shift2
        f = hier_moe(h, w_router_group[l], b_router_group[l], w_router_expert[l], b_router_expert[l],
                     w_exp_gate[l], w_exp_up[l], w_exp_down[l])
        x = x + gate2 * rms_norm(f, g_post_ffn[l])
    return x
```

```cpp
#include <hip/hip_runtime.h>
#include <cstdio>
#include <cstdint>
#include <cmath>
namespace pg8 {
#define PG8_LAS __attribute__((address_space(3)))
typedef unsigned short bf16_t;
typedef short bf16x8 __attribute__((ext_vector_type(8)));
typedef float f32x4 __attribute__((ext_vector_type(4)));
typedef unsigned u32x4 __attribute__((ext_vector_type(4)));
typedef int i32x4 __attribute__((ext_vector_type(4)));
typedef int i32x8 __attribute__((ext_vector_type(8)));
constexpr int BM = 256, BK = 64, HALF = 128, HTB = HALF * BK * 2  , STAGE_BYTES = 8 * HTB, NXCD = 8, WGM = 8;

__host__ __device__ __forceinline__ int lds_byte(int r, int c) { const int st = (r >> 4) * 2 + (c >> 5), rr = r & 15, cc = c & 31, ob = rr * 64 + cc * 2; return st * 1024 + (ob ^ (((ob >> 9) & 1) << 5)); }
__host__ __device__ __forceinline__ void stage_rc(int b, int& R, int& C) { const int st = b / 1024, sb = b % 1024, swz = sb ^ (((sb >> 9) & 1) << 5); R = (st >> 1) * 16 + swz / 64; C = (st & 1) * 32 + (swz % 64) / 2; }
__host__ __device__ __forceinline__ int perm32(int rho) { const int n = rho >> 4, i = rho & 15; return 8 * (i >> 2) + 4 * n + (i & 3); }

struct Unit { int pm, pn; };
struct Gemm { const bf16_t* A; const bf16_t* Bt; int M, N, K; };

struct StaticOrder {
    int nM, nN, nwg, G, c;
    __host__ __device__ void init(int M, int N, int G_, int c_) { nM = M / BM; nN = N / BM; nwg = nM * nN; G = G_; c = c_; }
    __host__ __device__ bool next(int i, Unit& u) const {
        const long L = (long)i * G + c; if (L >= nwg) return false;
        int wgid = (int)L; { const int q = nwg / NXCD, r = nwg % NXCD, xcd = wgid % NXCD, off = wgid / NXCD; wgid = (xcd < r ? xcd * (q + 1) : r * (q + 1) + (xcd - r) * q) + off; }
        const int nig = WGM * nN, gid = wgid / nig, fm = gid * WGM, gsz = (nM - fm) < WGM ? (nM - fm) : WGM;
        u.pm = fm + ((wgid % nig) % gsz); u.pn = (wgid % nig) / gsz; return true;
    }
    __device__ __forceinline__ void a_ready(const Unit&) const {}
    __device__ __forceinline__ void done(const Unit&) const {}
};

__device__ __forceinline__ unsigned cvt_pk_bf16(float lo, float hi) { unsigned r; asm volatile("v_cvt_pk_bf16_f32 %0, %1, %2" : "=v"(r) : "v"(lo), "v"(hi)); return r; }
typedef unsigned u32x2 __attribute__((ext_vector_type(2)));
__device__ __forceinline__ float bf_lo(unsigned w) { return __uint_as_float(w << 16); }
__device__ __forceinline__ float bf_hi(unsigned w) { return __uint_as_float(w & 0xffff0000u); }
__device__ __forceinline__ float sigmoidf_(float x) { return __builtin_amdgcn_rcpf(1.0f + __builtin_amdgcn_exp2f(-1.4426950408889634f * x)); }

typedef float f32x2_ __attribute__((ext_vector_type(2)));
__device__ __forceinline__ unsigned sig_u8x4(const f32x4 v) {
    const f32x2_ ya = (f32x2_){v[0], v[1]} * -1.4426950408889634f, yb = (f32x2_){v[2], v[3]} * -1.4426950408889634f;
    const f32x2_ da = (f32x2_){__builtin_amdgcn_exp2f(ya.x), __builtin_amdgcn_exp2f(ya.y)} + 1.0f, db = (f32x2_){__builtin_amdgcn_exp2f(yb.x), __builtin_amdgcn_exp2f(yb.y)} + 1.0f;
    const f32x2_ qa = (f32x2_){__builtin_amdgcn_rcpf(da.x), __builtin_amdgcn_rcpf(da.y)} * 255.0f + 8388608.0f, qb = (f32x2_){__builtin_amdgcn_rcpf(db.x), __builtin_amdgcn_rcpf(db.y)} * 255.0f + 8388608.0f;
    unsigned t01, t23, w;
    asm("v_perm_b32 %0, %1, %2, %3" : "=v"(t01) : "v"(qa.y), "v"(qa.x), "s"(0x0c0c0400u));
    asm("v_perm_b32 %0, %1, %2, %3" : "=v"(t23) : "v"(qb.y), "v"(qb.x), "s"(0x0c0c0400u));
    asm("v_perm_b32 %0, %1, %2, %3" : "=v"(w) : "v"(t23), "v"(t01), "s"(0x05040100u));
    return w;
}
__device__ __forceinline__ f32x2_ vsig2(const f32x2_ v, const f32x2_ g) {
    const f32x2_ y = g * -1.4426950408889634f;
    const f32x2_ d = (f32x2_){__builtin_amdgcn_exp2f(y.x), __builtin_amdgcn_exp2f(y.y)} + 1.0f;
    return v * (f32x2_){__builtin_amdgcn_rcpf(d.x), __builtin_amdgcn_rcpf(d.y)};
}
constexpr float QSCALE = 0.125f * 1.4426950408889634f;

struct EpiProj {
    static constexpr bool PERM = true, AFTER_DRAIN = false;
    bf16_t *Q, *K, *V, *U, *GA, *GS; float* kpart;
    __device__ __forceinline__ void operator()(const f32x4 (&acc)[2][2][4][2], const Unit& u, int wr, int wc, int fr, int fq) const {
        const int pn = u.pn; const int row0 = u.pm * BM + wr * 64 + fr;
        bf16_t* base; int ld, colt, mode;
        if (pn < 2) { base = Q; ld = 512; colt = pn * 256; mode = 1; }
        else if (pn < 4) { base = K; ld = 512; colt = (pn - 2) * 256; mode = 0; }
        else if (pn < 6) { base = V; ld = 512; colt = (pn - 4) * 256; mode = 0; }
        else if (pn == 6) { base = U; ld = 256; colt = 0; mode = 0; }
        else if (pn < 11) { base = GA; ld = 1024; colt = (pn - 7) * 256; mode = 2; }
        else { base = GS; ld = 1024; colt = (pn - 11) * 256; mode = 2; }
        const int col0 = colt + wc * 32 + 8 * fq;
#pragma unroll
        for (int ai = 0; ai < 2; ++ai)
#pragma unroll
            for (int m = 0; m < 4; ++m) { bf16_t* rowp = base + (size_t)(row0 + ai * HALF + m * 16) * ld + col0;
#pragma unroll
                for (int bj = 0; bj < 2; ++bj) { f32x4 v0 = acc[ai][bj][m][0], v1 = acc[ai][bj][m][1];
                    if (mode == 2) {
                        u32x2 w; w.x = sig_u8x4(v0); w.y = sig_u8x4(v1);
                        *(u32x2*)((unsigned char*)base + (size_t)(row0 + ai * HALF + m * 16) * 1024 + col0 + bj * HALF) = w;
                    } else {
                        if (mode == 1) { v0 = v0 * QSCALE; v1 = v1 * QSCALE; }
                        u32x4 w; w.x = cvt_pk_bf16(v0[0], v0[1]); w.y = cvt_pk_bf16(v0[2], v0[3]); w.z = cvt_pk_bf16(v1[0], v1[1]); w.w = cvt_pk_bf16(v1[2], v1[3]);
                        *(u32x4*)(rowp + bj * HALF) = w; } } }
        if (pn == 2 || pn == 3) {
#pragma unroll
            for (int bj = 0; bj < 2; ++bj)
#pragma unroll
                for (int n = 0; n < 2; ++n) { f32x4 s = (f32x4){0.f, 0.f, 0.f, 0.f};
#pragma unroll
                    for (int ai = 0; ai < 2; ++ai)
#pragma unroll
                        for (int m = 0; m < 4; ++m) s += acc[ai][bj][m][n];
#pragma unroll
                    for (int i = 0; i < 4; ++i) { float t = s[i]; t += __shfl_xor(t, 1); t += __shfl_xor(t, 2); t += __shfl_xor(t, 4); t += __shfl_xor(t, 8); s[i] = t; }
                    if (fr == 0) *(f32x4*)(kpart + (size_t)(u.pm * 2 + wr) * 512 + (pn - 2) * 256 + bj * HALF + wc * 32 + 8 * fq + 4 * n) = s; }
        }
    }
};

struct EpiGlu {
    static constexpr bool PERM = true, AFTER_DRAIN = false;
    const bf16_t* GS; bf16_t* SG;
    __device__ __forceinline__ void operator()(const f32x4 (&acc)[2][2][4][2], const Unit& u, int wr, int wc, int fr, int fq) const {
        const int row0 = u.pm * BM + wr * 64 + fr; const int col0 = u.pn * 128 + wc * 32 + 8 * fq;
#pragma unroll
        for (int ai = 0; ai < 2; ++ai)
#pragma unroll
            for (int m = 0; m < 4; ++m) { const size_t ro = (size_t)(row0 + ai * HALF + m * 16) * 1024 + col0;
                const f32x4 v0 = acc[ai][0][m][0], v1 = acc[ai][0][m][1], g0 = acc[ai][1][m][0], g1 = acc[ai][1][m][1];
                u32x2 w;
                { const f32x2_ a = vsig2((f32x2_){v0[0], v0[1]}, (f32x2_){g0[0], g0[1]}) * 16.0f, b = vsig2((f32x2_){v0[2], v0[3]}, (f32x2_){g0[2], g0[3]}) * 16.0f;
                  const f32x2_ c = vsig2((f32x2_){v1[0], v1[1]}, (f32x2_){g1[0], g1[1]}) * 16.0f, d = vsig2((f32x2_){v1[2], v1[3]}, (f32x2_){g1[2], g1[3]}) * 16.0f;
                  int t = __builtin_amdgcn_cvt_pk_fp8_f32(__builtin_amdgcn_fmed3f(a.x, -440.f, 440.f), __builtin_amdgcn_fmed3f(a.y, -440.f, 440.f), 0, false);
                  t = __builtin_amdgcn_cvt_pk_fp8_f32(__builtin_amdgcn_fmed3f(b.x, -440.f, 440.f), __builtin_amdgcn_fmed3f(b.y, -440.f, 440.f), t, true); w.x = (unsigned)t;
                  t = __builtin_amdgcn_cvt_pk_fp8_f32(__builtin_amdgcn_fmed3f(c.x, -440.f, 440.f), __builtin_amdgcn_fmed3f(c.y, -440.f, 440.f), 0, false);
                  t = __builtin_amdgcn_cvt_pk_fp8_f32(__builtin_amdgcn_fmed3f(d.x, -440.f, 440.f), __builtin_amdgcn_fmed3f(d.y, -440.f, 440.f), t, true); w.y = (unsigned)t; }
                *(u32x2*)((unsigned char*)SG + ro + (size_t)(row0 + ai * HALF + m * 16) * 1024) = w;
                asm volatile("" ::: "memory"); }
    }
};

struct EpiAttOut {
    static constexpr bool PERM = true, AFTER_DRAIN = false;
    const unsigned char* GA; const unsigned char* GS; const bf16_t* SG; unsigned char* MG;
    __device__ __forceinline__ void operator()(const f32x4 (&acc)[2][2][4][2], const Unit& u, int wr, int wc, int fr, int fq) const {
        const int row0 = u.pm * BM + wr * 64 + fr; const int col0 = u.pn * BM + wc * 32 + 8 * fq;
        u32x2 nga[2], ngs[2]; u32x2 nsg[2];
#define EAO_LOAD(idx) do { const size_t ro_ = (size_t)(row0 + ((idx) >> 2) * HALF + ((idx) & 3) * 16) * 1024 + col0; \
        _Pragma("unroll") for (int bj = 0; bj < 2; ++bj) { nga[bj] = __builtin_nontemporal_load((const u32x2*)(GA + ro_ + bj * HALF)); nsg[bj] = __builtin_nontemporal_load((const u32x2*)((const unsigned char*)SG + 2 * ro_ - col0 + bj * HALF)); ngs[bj] = __builtin_nontemporal_load((const u32x2*)(GS + ro_ + bj * HALF)); } } while (0)
#define U8F(w, i) ((float)(((w) >> (8 * (i))) & 0xffu))
        EAO_LOAD(0);
#pragma unroll
        for (int idx = 0; idx < 8; ++idx) { const int ai = idx >> 2, m = idx & 3; const size_t ro = (size_t)(row0 + ai * HALF + m * 16) * 1024 + col0;
            u32x2 cga[2], cgs[2]; u32x2 csg[2];
#pragma unroll
            for (int bj = 0; bj < 2; ++bj) { cga[bj] = nga[bj]; csg[bj] = nsg[bj]; cgs[bj] = ngs[bj]; }
            if (idx < 7) EAO_LOAD(idx + 1);
#pragma unroll
            for (int bj = 0; bj < 2; ++bj) { const f32x4 v0 = acc[ai][bj][m][0], v1 = acc[ai][bj][m][1]; const u32x2 ga = cga[bj], gs = cgs[bj]; const u32x2 sg = csg[bj];
                constexpr float C = 16.0f / 255.0f, CS = 1.0f / 255.0f;
                float o[8];
#define EAO_PAIR(i, gaw, gsw, b0, va, vb, sgw, hi_) do { const f32x2_ s_ = __builtin_amdgcn_cvt_pk_f32_fp8((int)(sgw), hi_); \
                    const f32x2_ r_ = (f32x2_){U8F(gaw, b0), U8F(gaw, b0 + 1)} * (f32x2_){va, vb} * C + (f32x2_){U8F(gsw, b0), U8F(gsw, b0 + 1)} * s_ * CS; \
                    o[i] = __builtin_amdgcn_fmed3f(r_.x, -440.f, 440.f); o[i + 1] = __builtin_amdgcn_fmed3f(r_.y, -440.f, 440.f); } while (0)
                EAO_PAIR(0, ga.x, gs.x, 0, v0[0], v0[1], sg.x, false); EAO_PAIR(2, ga.x, gs.x, 2, v0[2], v0[3], sg.x, true);
                EAO_PAIR(4, ga.y, gs.y, 0, v1[0], v1[1], sg.y, false); EAO_PAIR(6, ga.y, gs.y, 2, v1[2], v1[3], sg.y, true);
#undef EAO_PAIR
                u32x2 w; int t = __builtin_amdgcn_cvt_pk_fp8_f32(o[0], o[1], 0, false); t = __builtin_amdgcn_cvt_pk_fp8_f32(o[2], o[3], t, true); w.x = (unsigned)t;
                t = __builtin_amdgcn_cvt_pk_fp8_f32(o[4], o[5], 0, false); t = __builtin_amdgcn_cvt_pk_fp8_f32(o[6], o[7], t, true); w.y = (unsigned)t;
                *(u32x2*)(MG + ro + bj * HALF) = w; }
            asm volatile("" ::: "memory"); }
#undef U8F
#undef EAO_LOAD
    }
};

struct EpiMix {
    static constexpr bool PERM = true, AFTER_DRAIN = false;
    bf16_t* Y; float* ssq;
    __device__ __forceinline__ void operator()(const f32x4 (&acc)[2][2][4][2], const Unit& u, int wr, int wc, int fr, int fq) const {
        const int row0 = u.pm * BM + wr * 64 + fr; const int col0 = u.pn * BM + wc * 32 + 8 * fq;
#pragma unroll
        for (int ai = 0; ai < 2; ++ai)
#pragma unroll
            for (int m = 0; m < 4; ++m) { const int row = row0 + ai * HALF + m * 16; const size_t ro = (size_t)row * 1024 + col0; float q = 0.f;
#pragma unroll
                for (int bj = 0; bj < 2; ++bj) { const f32x4 v0 = acc[ai][bj][m][0], v1 = acc[ai][bj][m][1];
                    q += (v0[0] * v0[0] + v0[1] * v0[1]) + (v0[2] * v0[2] + v0[3] * v0[3]) + (v1[0] * v1[0] + v1[1] * v1[1]) + (v1[2] * v1[2] + v1[3] * v1[3]);
                    u32x2 w; int t = __builtin_amdgcn_cvt_pk_fp8_f32(__builtin_amdgcn_fmed3f(v0[0] * 8.0f, -440.f, 440.f), __builtin_amdgcn_fmed3f(v0[1] * 8.0f, -440.f, 440.f), 0, false);
                    t = __builtin_amdgcn_cvt_pk_fp8_f32(__builtin_amdgcn_fmed3f(v0[2] * 8.0f, -440.f, 440.f), __builtin_amdgcn_fmed3f(v0[3] * 8.0f, -440.f, 440.f), t, true); w.x = (unsigned)t;
                    t = __builtin_amdgcn_cvt_pk_fp8_f32(__builtin_amdgcn_fmed3f(v1[0] * 8.0f, -440.f, 440.f), __builtin_amdgcn_fmed3f(v1[1] * 8.0f, -440.f, 440.f), 0, false);
                    t = __builtin_amdgcn_cvt_pk_fp8_f32(__builtin_amdgcn_fmed3f(v1[2] * 8.0f, -440.f, 440.f), __builtin_amdgcn_fmed3f(v1[3] * 8.0f, -440.f, 440.f), t, true); w.y = (unsigned)t;
                    *(u32x2*)((unsigned char*)Y + (size_t)row * 2048 + col0 + bj * HALF) = w; }
                q += __shfl_xor(q, 16); q += __shfl_xor(q, 32);
                if (fq == 0) ssq[(size_t)row * 16 + u.pn * 4 + wc] = q; }
    }
};

constexpr float HID8_SCALE = 8.0f;
struct EpiMoe1 {
    static constexpr bool PERM = true, AFTER_DRAIN = false;
    unsigned char* HID;
    __device__ __forceinline__ void operator()(const f32x4 (&acc)[2][2][4][2], const Unit& u, int wr, int wc, int fr, int fq) const {
        const int row0 = u.pm * BM + wr * 64 + fr; const int col0 = (u.pn & 3) * 128 + wc * 32 + 8 * fq;
#pragma unroll
        for (int ai = 0; ai < 2; ++ai)
#pragma unroll
            for (int m = 0; m < 4; ++m) { const size_t ro = (size_t)(row0 + ai * HALF + m * 16) * 512 + col0;
                float h[8];
#pragma unroll
                for (int n = 0; n < 2; ++n) { const f32x4 g = acc[ai][0][m][n], v = acc[ai][1][m][n];
#pragma unroll
                    for (int i = 0; i < 4; i += 2) { const f32x2_ gg = {g[i], g[i + 1]}; const f32x2_ hh = vsig2(gg, gg) * ((f32x2_){v[i], v[i + 1]} * HID8_SCALE);
                        h[4 * n + i] = __builtin_amdgcn_fmed3f(hh.x, -440.f, 440.f); h[4 * n + i + 1] = __builtin_amdgcn_fmed3f(hh.y, -440.f, 440.f); } }
                u32x2 w; int t = __builtin_amdgcn_cvt_pk_fp8_f32(h[0], h[1], 0, false); t = __builtin_amdgcn_cvt_pk_fp8_f32(h[2], h[3], t, true); w.x = (unsigned)t;
                t = __builtin_amdgcn_cvt_pk_fp8_f32(h[4], h[5], 0, false); t = __builtin_amdgcn_cvt_pk_fp8_f32(h[6], h[7], t, true); w.y = (unsigned)t;
                *(u32x2*)(HID + ro) = w; }
    }
};

constexpr float YR8_SCALE = 256.0f;
struct EpiMoe2 {
    static constexpr bool PERM = true, AFTER_DRAIN = false;
    unsigned char* YR; const float* rw;
    __device__ __forceinline__ void operator()(const f32x4 (&acc)[2][2][4][2], const Unit& u, int wr, int wc, int fr, int fq) const {
        const int row0 = u.pm * BM + wr * 64 + fr; const int col0 = (u.pn & 3) * BM + wc * 32 + 8 * fq;
#pragma unroll
        for (int ai = 0; ai < 2; ++ai)
#pragma unroll
            for (int m = 0; m < 4; ++m) { const int row = row0 + ai * HALF + m * 16; const size_t ro = (size_t)row * 1024 + col0; const float s = rw[row] * YR8_SCALE;
#pragma unroll
                for (int bj = 0; bj < 2; ++bj) { f32x4 v0 = acc[ai][bj][m][0] * s, v1 = acc[ai][bj][m][1] * s;
#pragma unroll
                    for (int i = 0; i < 4; ++i) { v0[i] = fminf(fmaxf(v0[i], -440.f), 440.f); v1[i] = fminf(fmaxf(v1[i], -440.f), 440.f); }
                    u32x2 w; int t = __builtin_amdgcn_cvt_pk_fp8_f32(v0[0], v0[1], 0, false); t = __builtin_amdgcn_cvt_pk_fp8_f32(v0[2], v0[3], t, true); w.x = (unsigned)t;
                    t = __builtin_amdgcn_cvt_pk_fp8_f32(v1[0], v1[1], 0, false); t = __builtin_amdgcn_cvt_pk_fp8_f32(v1[2], v1[3], t, true); w.y = (unsigned)t;
                    *(u32x2*)(YR + ro + bj * HALF) = w; } }
    }
};

struct MoeOrder {
    const PG8_LAS int* tile_e; const int* list; int ntiles, G, c;
    __device__ __forceinline__ bool next(int i, Unit& u) const {
        const int L = i * G + c; if (L >= ntiles * 4) return false;
        const int t = L >> 2; u.pm = t; u.pn = tile_e[t] * 4 + (L & 3); return true;
    }
    __device__ __forceinline__ unsigned a_row(const Unit& u, int lr) const {
        const int e = u.pn >> 2, i = u.pm * 256 + lr - tile_e[600 + e];
        return (i < tile_e[640 + e]) ? (unsigned)(list[(size_t)e * 65536 + i] >> 1) : 0u;
    }
    __device__ __forceinline__ void a_ready(const Unit&) const {}
    __device__ __forceinline__ void done(const Unit&) const {}
};

struct PanelOrder {
    int pm, n, rot;
    __device__ __forceinline__ bool next(int i, Unit& u) const { if (i >= n) return false; int p = pm; asm volatile("" : "+s"(p));
        u.pm = p; u.pn = (i + rot) % n; return true; }
    __device__ __forceinline__ void a_ready(const Unit&) const {}
    __device__ __forceinline__ void done(const Unit&) const {}
};
template <class Epi, class Sched, bool ALIGN_EPI = false, bool SP2 = false, bool F8 = false>
__device__ __forceinline__ void gemm_phase(PG8_LAS unsigned char* lds, const Gemm g, const Sched& S, const Epi& E, int sclA = 127, int sclB = 127) {
    int tid_ = threadIdx.x; asm volatile("" : "+v"(tid_));
    const int tid = tid_, wid = __builtin_amdgcn_readfirstlane(tid >> 6), lane = tid & 63, wr = wid >> 2, wc = wid & 3, fr = lane & 15, fq = lane >> 4;
    const int K = g.K, nt = K / BK;
    unsigned voffA[2], voffB[2];
#pragma unroll
    for (int i = 0; i < 2; ++i) { int R, C; stage_rc(tid * 16 + i * 8192, R, C); const int Rb = Epi::PERM ? ((R & ~31) + perm32(R & 31)) : R;
        voffA[i] = (unsigned)(R * K + C) * 2u; voffB[i] = (unsigned)(Rb * K + C) * 2u; }
    const size_t kstep = (size_t)(BK * 2);
    const size_t hstep = (size_t)HALF * K * 2;
    const size_t tstep = 2 * hstep;
    const unsigned ldsw = (unsigned)wid * 1024u;
    const int aoff = lds_byte(wr * 64 + fr, fq * 8), boff = lds_byte(wc * 32 + fr, fq * 8);
#define PG8_SA(b, h) (((b) * 2 + (h)) * HTB)
#define PG8_SB(b, h) ((4 + (b) * 2 + (h)) * HTB)
#define PG8_STAGE(bufoff, gbase, voff) do { _Pragma("unroll") for (int _i = 0; _i < 2; ++_i) \
        __builtin_amdgcn_global_load_lds((const unsigned*)((const char*)(gbase) + (voff)[_i]), (PG8_LAS unsigned*)(lds + (bufoff) + ldsw + _i * 8192), 16, 0, 0); } while (0)
#define PG8_LDA(dst, b, h) do { _Pragma("unroll") for (int m = 0; m < 4; ++m) _Pragma("unroll") for (int k = 0; k < 2; ++k) dst[m][k] = *(const PG8_LAS bf16x8*)(lds + PG8_SA(b, h) + aoff + m * 2048 + k * 1024); } while (0)
#define PG8_LDB(dst, b, h) do { _Pragma("unroll") for (int n = 0; n < 2; ++n) _Pragma("unroll") for (int k = 0; k < 2; ++k) dst[n][k] = *(const PG8_LAS bf16x8*)(lds + PG8_SB(b, h) + boff + n * 2048 + k * 1024); } while (0)
#define PG8_MMA(ai, bj, At, Bt) do { __builtin_amdgcn_s_setprio(1); _Pragma("unroll") for (int m = 0; m < 4; ++m) _Pragma("unroll") for (int n = 0; n < 2; ++n) { \
        if constexpr (F8) { const i32x4 b0_ = __builtin_bit_cast(i32x4, Bt[n][0]), b1_ = __builtin_bit_cast(i32x4, Bt[n][1]), a0_ = __builtin_bit_cast(i32x4, At[m][0]), a1_ = __builtin_bit_cast(i32x4, At[m][1]); \
            const i32x8 b8_ = __builtin_shufflevector(b0_, b1_, 0, 1, 2, 3, 4, 5, 6, 7), a8_ = __builtin_shufflevector(a0_, a1_, 0, 1, 2, 3, 4, 5, 6, 7); \
            asm volatile("v_mfma_scale_f32_16x16x128_f8f6f4 %0, %1, %2, %0, %3, %4 op_sel_hi:[0,0,0]" : "+v"(acc[ai][bj][m][n]) : "v"(b8_), "v"(a8_), "v"(sclB), "v"(sclA)); } \
        else { _Pragma("unroll") for (int k = 0; k < 2; ++k) acc[ai][bj][m][n] = __builtin_amdgcn_mfma_f32_16x16x32_bf16(Bt[n][k], At[m][k], acc[ai][bj][m][n], 0, 0, 0); } } \
        __builtin_amdgcn_s_setprio(0); } while (0)
#define PG8_WAIT_V(n) asm volatile("s_waitcnt vmcnt(" #n ")" ::: "memory")
#define PG8_WAIT_L(n) asm volatile("s_waitcnt lgkmcnt(" #n ")" ::: "memory")
#define PG8_BAR __builtin_amdgcn_s_barrier()
#define PG8_SCHED __builtin_amdgcn_sched_barrier(0)
    Unit cur, nxt; int ui = 0;
    if (!S.next(0, cur)) return;
    f32x4 acc[2][2][4][2];
#pragma unroll
    for (int a = 0; a < 2; ++a)
#pragma unroll
        for (int b = 0; b < 2; ++b)
#pragma unroll
            for (int m = 0; m < 4; ++m)
#pragma unroll
                for (int n = 0; n < 2; ++n) acc[a][b][m][n] = (f32x4){0.f, 0.f, 0.f, 0.f};
    bf16x8 At[4][2], B0[2][2], B1[2][2];
    const char* cA = (const char*)g.A + (size_t)cur.pm * tstep; const char* cB = (const char*)g.Bt + (size_t)cur.pn * tstep;
    S.a_ready(cur);
    if constexpr (SP2) {
        PG8_STAGE(PG8_SB(0, 0), cB, voffB); PG8_STAGE(PG8_SB(0, 1), cB + hstep, voffB); PG8_STAGE(PG8_SA(0, 0), cA, voffA); PG8_STAGE(PG8_SA(0, 1), cA + hstep, voffA);
        if (wr == 1) PG8_BAR;
        PG8_WAIT_V(2); PG8_BAR;
        PG8_STAGE(PG8_SB(1, 0), cB + kstep, voffB); PG8_STAGE(PG8_SA(1, 0), cA + kstep, voffA); PG8_STAGE(PG8_SB(1, 1), cB + hstep + kstep, voffB);
        PG8_WAIT_V(6); PG8_BAR;
    } else {
        PG8_STAGE(PG8_SB(0, 0), cB, voffB); PG8_STAGE(PG8_SA(0, 0), cA, voffA); PG8_STAGE(PG8_SB(0, 1), cB + hstep, voffB); PG8_STAGE(PG8_SA(0, 1), cA + hstep, voffA);
        if (wr == 1) PG8_BAR;
        PG8_WAIT_V(4); PG8_BAR;
        PG8_STAGE(PG8_SB(1, 0), cB + kstep, voffB); PG8_STAGE(PG8_SA(1, 0), cA + kstep, voffA); PG8_STAGE(PG8_SB(1, 1), cB + hstep + kstep, voffB);
        PG8_WAIT_V(6); PG8_BAR;
    }
    for (;;) {
        const bool has_next = S.next(ui + 1, nxt);
        const char* nA = has_next ? (const char*)g.A + (size_t)nxt.pm * tstep : cA; const char* nB = has_next ? (const char*)g.Bt + (size_t)nxt.pn * tstep : cB;
        for (int t = 0; t < nt; t += 2) {
            const bool last = (t == nt - 2);
            const char* a1 = cA + (size_t)(t + 1) * kstep;
            const char* a2 = last ? nA : cA + (size_t)(t + 2) * kstep; const char* b2 = last ? nB : cB + (size_t)(t + 2) * kstep;
            const char* a3 = a2 + kstep; const char* b3 = b2 + kstep;
            if (last && has_next) S.a_ready(nxt);
            if constexpr (SP2) {
            PG8_LDB(B0, 0, 0); PG8_LDB(B1, 0, 1); PG8_SCHED; PG8_LDA(At, 0, 0); PG8_STAGE(PG8_SA(1, 1), a1 + hstep, voffA);
            PG8_WAIT_V(8); PG8_WAIT_L(0); PG8_BAR; PG8_MMA(0, 0, At, B0); PG8_MMA(0, 1, At, B1); PG8_BAR; PG8_SCHED;
            PG8_LDA(At, 0, 1); PG8_STAGE(PG8_SB(0, 0), b2, voffB); PG8_STAGE(PG8_SB(0, 1), b2 + hstep, voffB); PG8_STAGE(PG8_SA(0, 0), a2, voffA);
            PG8_WAIT_V(8); PG8_WAIT_L(0); PG8_BAR; PG8_MMA(1, 0, At, B0); PG8_MMA(1, 1, At, B1); PG8_BAR; PG8_SCHED;
            PG8_LDB(B0, 1, 0); PG8_LDB(B1, 1, 1); PG8_SCHED; PG8_LDA(At, 1, 0); PG8_STAGE(PG8_SA(0, 1), a2 + hstep, voffA);
            PG8_WAIT_V(8); PG8_WAIT_L(0); PG8_BAR; PG8_MMA(0, 0, At, B0); PG8_MMA(0, 1, At, B1); PG8_BAR; PG8_SCHED;
            PG8_LDA(At, 1, 1); PG8_STAGE(PG8_SB(1, 0), b3, voffB); PG8_STAGE(PG8_SB(1, 1), b3 + hstep, voffB); PG8_STAGE(PG8_SA(1, 0), a3, voffA);
            PG8_WAIT_V(8); PG8_WAIT_L(0); PG8_BAR; PG8_MMA(1, 0, At, B0); PG8_MMA(1, 1, At, B1); PG8_BAR; PG8_SCHED;
            } else {
            PG8_LDB(B0, 0, 0); PG8_SCHED; PG8_LDA(At, 0, 0); PG8_STAGE(PG8_SA(1, 1), a1 + hstep, voffA);
            PG8_WAIT_L(8); PG8_BAR; PG8_WAIT_L(0); PG8_MMA(0, 0, At, B0); PG8_BAR; PG8_SCHED;
            PG8_LDB(B1, 0, 1); PG8_STAGE(PG8_SB(0, 0), b2, voffB);
            PG8_BAR; PG8_WAIT_L(0); PG8_MMA(0, 1, At, B1); PG8_BAR;
            PG8_LDA(At, 0, 1); PG8_STAGE(PG8_SA(0, 0), a2, voffA);
            PG8_BAR; PG8_WAIT_L(0); PG8_MMA(1, 0, At, B0); PG8_BAR; PG8_SCHED;
            PG8_STAGE(PG8_SB(0, 1), b2 + hstep, voffB);
            PG8_WAIT_V(6); PG8_BAR; PG8_MMA(1, 1, At, B1); PG8_BAR;
            PG8_LDB(B0, 1, 0); PG8_SCHED; PG8_LDA(At, 1, 0); PG8_STAGE(PG8_SA(0, 1), a2 + hstep, voffA);
            PG8_WAIT_L(8); PG8_BAR; PG8_WAIT_L(0); PG8_MMA(0, 0, At, B0); PG8_BAR; PG8_SCHED;
            PG8_LDB(B1, 1, 1); PG8_STAGE(PG8_SB(1, 0), b3, voffB);
            PG8_BAR; PG8_WAIT_L(0); PG8_MMA(0, 1, At, B1); PG8_BAR;
            PG8_LDA(At, 1, 1); PG8_STAGE(PG8_SA(1, 0), a3, voffA);
            PG8_BAR; PG8_WAIT_L(0); PG8_MMA(1, 0, At, B0); PG8_BAR; PG8_SCHED;
            PG8_STAGE(PG8_SB(1, 1), b3 + hstep, voffB);
            PG8_WAIT_V(6); PG8_BAR; PG8_MMA(1, 1, At, B1); PG8_BAR;
            }
        }
        if constexpr (ALIGN_EPI) { if (wr == 0) PG8_BAR; }
        if constexpr (F8) asm volatile("s_nop 15\n\ts_nop 15" ::: "memory");
        if constexpr (!Epi::AFTER_DRAIN) { E(acc, cur, wr, wc, fr, fq); S.done(cur); }
        if (!has_next) break;
#pragma unroll
        for (int a = 0; a < 2; ++a)
#pragma unroll
            for (int b = 0; b < 2; ++b)
#pragma unroll
                for (int m = 0; m < 4; ++m)
#pragma unroll
                    for (int n = 0; n < 2; ++n) acc[a][b][m][n] = (f32x4){0.f, 0.f, 0.f, 0.f};
        cur = nxt; cA = nA; cB = nB; ++ui;
        if constexpr (ALIGN_EPI) { if (wr == 1) PG8_BAR; }
    }
    PG8_WAIT_V(0);
    if constexpr (!ALIGN_EPI) { if (wr == 0) PG8_BAR; }
    PG8_BAR;
    if constexpr (Epi::AFTER_DRAIN) { E.fused(acc, cur, wr, wc, fr, fq, lds, wid, lane); S.done(cur); }
#undef PG8_SA
#undef PG8_SB
#undef PG8_STAGE
#undef PG8_LDA
#undef PG8_LDB
#undef PG8_MMA
#undef PG8_WAIT_V
#undef PG8_WAIT_L
#undef PG8_BAR
#undef PG8_SCHED
}
template <class Epi, class Sched, bool F8 = false>
__device__ __forceinline__ void gemm_phase_g(PG8_LAS unsigned char* lds, const Gemm g, const Sched& S, const Epi& E, int sclA = 127, int sclB = 127) {
    int tid_ = threadIdx.x; asm volatile("" : "+v"(tid_));
    const int tid = tid_, wid = __builtin_amdgcn_readfirstlane(tid >> 6), lane = tid & 63, wr = wid >> 2, wc = wid & 3, fr = lane & 15, fq = lane >> 4;
    const int K = g.K, nt = K / BK;
    unsigned voffB[2]; int Rr[2], Cc[2];
#pragma unroll
    for (int i = 0; i < 2; ++i) { int R, C; stage_rc(tid * 16 + i * 8192, R, C); const int Rb = Epi::PERM ? ((R & ~31) + perm32(R & 31)) : R; Rr[i] = R; Cc[i] = C; voffB[i] = (unsigned)(Rb * K + C) * 2u; }
    const size_t kstep = (size_t)(BK * 2); const size_t hstep = (size_t)HALF * K * 2; const size_t tstep = 2 * hstep;
    const unsigned ldsw = (unsigned)wid * 1024u;
    const int aoff = lds_byte(wr * 64 + fr, fq * 8), boff = lds_byte(wc * 32 + fr, fq * 8);
#define PG8_SA(b, h) (((b) * 2 + (h)) * HTB)
#define PG8_SB(b, h) ((4 + (b) * 2 + (h)) * HTB)
#define PG8_STAGE(bufoff, gbase, voff) do { _Pragma("unroll") for (int _i = 0; _i < 2; ++_i) \
        __builtin_amdgcn_global_load_lds((const unsigned*)((const char*)(gbase) + (voff)[_i]), (PG8_LAS unsigned*)(lds + (bufoff) + ldsw + _i * 8192), 16, 0, 0); } while (0)
#define PG8_LDA(dst, b, h) do { _Pragma("unroll") for (int m = 0; m < 4; ++m) _Pragma("unroll") for (int k = 0; k < 2; ++k) dst[m][k] = *(const PG8_LAS bf16x8*)(lds + PG8_SA(b, h) + aoff + m * 2048 + k * 1024); } while (0)
#define PG8_LDB(dst, b, h) do { _Pragma("unroll") for (int n = 0; n < 2; ++n) _Pragma("unroll") for (int k = 0; k < 2; ++k) dst[n][k] = *(const PG8_LAS bf16x8*)(lds + PG8_SB(b, h) + boff + n * 2048 + k * 1024); } while (0)
#define PG8_MMA(ai, bj, At, Bt) do { __builtin_amdgcn_s_setprio(1); _Pragma("unroll") for (int m = 0; m < 4; ++m) _Pragma("unroll") for (int n = 0; n < 2; ++n) { \
        if constexpr (F8) { const i32x4 b0_ = __builtin_bit_cast(i32x4, Bt[n][0]), b1_ = __builtin_bit_cast(i32x4, Bt[n][1]), a0_ = __builtin_bit_cast(i32x4, At[m][0]), a1_ = __builtin_bit_cast(i32x4, At[m][1]); \
            const i32x8 b8_ = __builtin_shufflevector(b0_, b1_, 0, 1, 2, 3, 4, 5, 6, 7), a8_ = __builtin_shufflevector(a0_, a1_, 0, 1, 2, 3, 4, 5, 6, 7); \
            asm volatile("v_mfma_scale_f32_16x16x128_f8f6f4 %0, %1, %2, %0, %3, %4 op_sel_hi:[0,0,0]" : "+v"(acc[ai][bj][m][n]) : "v"(b8_), "v"(a8_), "v"(sclB), "v"(sclA)); } \
        else { _Pragma("unroll") for (int k = 0; k < 2; ++k) acc[ai][bj][m][n] = __builtin_amdgcn_mfma_f32_16x16x32_bf16(Bt[n][k], At[m][k], acc[ai][bj][m][n], 0, 0, 0); } } \
        __builtin_amdgcn_s_setprio(0); } while (0)
#define PG8_WAIT_V(n) asm volatile("s_waitcnt vmcnt(" #n ")" ::: "memory")
#define PG8_WAIT_L(n) asm volatile("s_waitcnt lgkmcnt(" #n ")" ::: "memory")
#define PG8_BAR __builtin_amdgcn_s_barrier()
#define PG8_SCHED __builtin_amdgcn_sched_barrier(0)
#define PG8_ROWS(dst, u) do { _Pragma("unroll") for (int _h = 0; _h < 2; ++_h) _Pragma("unroll") for (int _i = 0; _i < 2; ++_i) dst[_h][_i] = S.a_row(u, _h * HALF + Rr[_i]) * (unsigned)(K * 2) + (unsigned)(Cc[_i] * 2); } while (0)
    Unit cur, nxt; int ui = 0;
    if (!S.next(0, cur)) return;
    f32x4 acc[2][2][4][2];
#pragma unroll
    for (int a = 0; a < 2; ++a)
#pragma unroll
        for (int b = 0; b < 2; ++b)
#pragma unroll
            for (int m = 0; m < 4; ++m)
#pragma unroll
                for (int n = 0; n < 2; ++n) acc[a][b][m][n] = (f32x4){0.f, 0.f, 0.f, 0.f};
    bf16x8 At[4][2], B0[2][2], B1[2][2];
    unsigned gC[2][2], gN[2][2];
    PG8_ROWS(gC, cur);
    const char* const A0 = (const char*)g.A;
    const char* cB = (const char*)g.Bt + (size_t)cur.pn * tstep;
    PG8_STAGE(PG8_SB(0, 0), cB, voffB); PG8_STAGE(PG8_SB(0, 1), cB + hstep, voffB); PG8_STAGE(PG8_SA(0, 0), A0, gC[0]); PG8_STAGE(PG8_SA(0, 1), A0, gC[1]);
    if (wr == 1) PG8_BAR;
    PG8_WAIT_V(2); PG8_BAR;
    PG8_STAGE(PG8_SB(1, 0), cB + kstep, voffB); PG8_STAGE(PG8_SA(1, 0), A0 + kstep, gC[0]); PG8_STAGE(PG8_SB(1, 1), cB + hstep + kstep, voffB);
    PG8_WAIT_V(6); PG8_BAR;
    for (;;) {
        const bool has_next = S.next(ui + 1, nxt);
        const char* nB = has_next ? (const char*)g.Bt + (size_t)nxt.pn * tstep : cB;
        if (has_next) { PG8_ROWS(gN, nxt); } else {
#pragma unroll
            for (int _h = 0; _h < 2; ++_h)
#pragma unroll
                for (int _i = 0; _i < 2; ++_i) gN[_h][_i] = gC[_h][_i]; }
        for (int t = 0; t < nt; t += 2) {
            const bool last = (t == nt - 2);
            const char* a1 = A0 + (size_t)(t + 1) * kstep;
            const char* a2 = last ? A0 : A0 + (size_t)(t + 2) * kstep; const char* b2 = last ? nB : cB + (size_t)(t + 2) * kstep;
            const char* a3 = a2 + kstep; const char* b3 = b2 + kstep;
            unsigned gX[2][2];
#pragma unroll
            for (int _h = 0; _h < 2; ++_h)
#pragma unroll
                for (int _i = 0; _i < 2; ++_i) gX[_h][_i] = last ? gN[_h][_i] : gC[_h][_i];
            PG8_LDB(B0, 0, 0); PG8_LDB(B1, 0, 1); PG8_SCHED; PG8_LDA(At, 0, 0); PG8_STAGE(PG8_SA(1, 1), a1, gC[1]);
            PG8_WAIT_V(8); PG8_WAIT_L(0); PG8_BAR; PG8_MMA(0, 0, At, B0); PG8_MMA(0, 1, At, B1); PG8_BAR; PG8_SCHED;
            PG8_LDA(At, 0, 1); PG8_STAGE(PG8_SB(0, 0), b2, voffB); PG8_STAGE(PG8_SB(0, 1), b2 + hstep, voffB); PG8_STAGE(PG8_SA(0, 0), a2, gX[0]);
            PG8_WAIT_V(8); PG8_WAIT_L(0); PG8_BAR; PG8_MMA(1, 0, At, B0); PG8_MMA(1, 1, At, B1); PG8_BAR; PG8_SCHED;
            PG8_LDB(B0, 1, 0); PG8_LDB(B1, 1, 1); PG8_SCHED; PG8_LDA(At, 1, 0); PG8_STAGE(PG8_SA(0, 1), a2, gX[1]);
            PG8_WAIT_V(8); PG8_WAIT_L(0); PG8_BAR; PG8_MMA(0, 0, At, B0); PG8_MMA(0, 1, At, B1); PG8_BAR; PG8_SCHED;
            PG8_LDA(At, 1, 1); PG8_STAGE(PG8_SB(1, 0), b3, voffB); PG8_STAGE(PG8_SB(1, 1), b3 + hstep, voffB); PG8_STAGE(PG8_SA(1, 0), a3, gX[0]);
            PG8_WAIT_V(8); PG8_WAIT_L(0); PG8_BAR; PG8_MMA(1, 0, At, B0); PG8_MMA(1, 1, At, B1); PG8_BAR; PG8_SCHED;
        }
        if (wr == 0) PG8_BAR;
        if constexpr (F8) asm volatile("s_nop 15\n\ts_nop 15" ::: "memory");
        E(acc, cur, wr, wc, fr, fq); S.done(cur);
        if (!has_next) break;
#pragma unroll
        for (int a = 0; a < 2; ++a)
#pragma unroll
            for (int b = 0; b < 2; ++b)
#pragma unroll
                for (int m = 0; m < 4; ++m)
#pragma unroll
                    for (int n = 0; n < 2; ++n) acc[a][b][m][n] = (f32x4){0.f, 0.f, 0.f, 0.f};
        cur = nxt; cB = nB; ++ui;
#pragma unroll
        for (int _h = 0; _h < 2; ++_h)
#pragma unroll
            for (int _i = 0; _i < 2; ++_i) gC[_h][_i] = gN[_h][_i];
        if (wr == 1) PG8_BAR;
    }
    PG8_WAIT_V(0);
    PG8_BAR;
#undef PG8_SA
#undef PG8_SB
#undef PG8_STAGE
#undef PG8_LDA
#undef PG8_LDB
#undef PG8_MMA
#undef PG8_WAIT_V
#undef PG8_WAIT_L
#undef PG8_BAR
#undef PG8_SCHED
#undef PG8_ROWS
}
}

constexpr int NWAVES = 8;
constexpr int BATCH = 16, SEQ = 4096, DM = 1024, NTOK = BATCH * SEQ;
constexpr int NH = 8, HD = 64, ATTW = 512, SSMW = 256, NPROJ = 3840;
constexpr int NEXP = 32, DEXP = 512, MOEB = 256;
constexpr int NROWS_PAD = NTOK * 2 + NEXP * MOEB;
constexpr int MAXTILES = NROWS_PAD / MOEB;
constexpr float RMS_EPS = 1e-6f;
constexpr float LOG2E = 1.4426950408889634f;
constexpr float W8_SCALE = 256.0f, A8_SCALE = 16.0f;
constexpr int W8_E8 = 119, A8_E8 = 123;
constexpr int SSM_L = 32, SSM_NCH = SEQ / SSM_L;

constexpr size_t MiB = 1u << 20;
constexpr size_t WS_CTL = 0, CTL_ZERO_BYTES = 1 * MiB;
constexpr size_t WS_MOD = 1 * MiB;
constexpr size_t WS_BTAB = WS_MOD + 512 * 1024;
constexpr size_t WS_KPART = 2 * MiB;
constexpr size_t WS_SSMTAB = 3 * MiB;
constexpr size_t SSM_GRP_BYTES = 294912, SSM_T_OFF = 0, SSM_W_OFF = 32768, SSM_S_OFF = 163840;
constexpr size_t WS_SSMAL = WS_SSMTAB + 16 * SSM_GRP_BYTES;
constexpr size_t WS_ROUTW = 1009 * MiB;
constexpr size_t WS_ROUTC = 1011 * MiB;
constexpr size_t WS_WIN = 9 * MiB;
constexpr size_t WS_WO = 17 * MiB;
constexpr size_t WS_WGLU = 18 * MiB;
constexpr size_t WS_WMIX = 19 * MiB;
constexpr size_t WS_WGU = 21 * MiB;
constexpr size_t WS_WDN = 85 * MiB;
constexpr size_t WS_RA = 120 * MiB;
constexpr size_t WS_RB = 256 * MiB;
constexpr size_t WS_Q = WS_RB, WS_K = WS_RB + 64 * MiB;
constexpr size_t WS_V = 384 * MiB, WS_U = 448 * MiB, WS_GA = 480 * MiB, WS_GS = 608 * MiB, WS_ATT = 736 * MiB, WS_Z = 800 * MiB;
constexpr size_t WS_H2F8 = 320 * MiB;
constexpr size_t WS_XS = 480 * MiB;
constexpr size_t WS_LIST = 832 * MiB;
constexpr size_t WS_WGT = 840 * MiB;
constexpr size_t WS_ROWMAP = 841 * MiB;
constexpr size_t WS_RW = 842 * MiB;
constexpr size_t WS_SSQ = 844 * MiB;
constexpr size_t WS_SEL = 848 * MiB;
constexpr size_t WS_PL = 850 * MiB;
constexpr size_t WS_RLIST = 860 * MiB;
constexpr size_t WS_RCNT = 876 * MiB;
constexpr size_t WS_YMIX = WS_RA;
constexpr size_t WS_H2 = 880 * MiB;
constexpr size_t WS_X1A = 384 * MiB, WS_X1B = 768 * MiB; constexpr int X1_SPLIT = 49152;
constexpr size_t WS_END = 1012 * MiB;
static_assert(WS_SSMAL + 16 * 64 * 2 * 4 <= WS_ROUTW && WS_WIN + (size_t)NPROJ * DM * 2 <= WS_WO && WS_WDN + (size_t)NEXP * DM * DEXP * 2 <= WS_RA, "ws map 1");
static_assert(WS_RA + (size_t)NROWS_PAD * DEXP * 2 <= WS_RB && WS_XS + (size_t)NROWS_PAD * DM * 2 <= WS_LIST && WS_Z + (size_t)NTOK * SSMW * 2 <= WS_LIST, "ws map 2");
constexpr int CW_BAR = 4096;
constexpr int CW_CNT = 16384;

constexpr int RING_BYTES = 131072;
constexpr int LDSCTL_OFF = RING_BYTES, MISC_OFF = LDSCTL_OFF + 320;
constexpr int TILEE_OFF = RING_BYTES + 1024;
constexpr int LDS_BYTES = 147456;
static_assert(TILEE_OFF + 4 * 1024 <= LDS_BYTES, "LDS map");

#define GAS __attribute__((address_space(1)))
#define LAS __attribute__((address_space(3)))
typedef unsigned short bf16;
typedef unsigned v4u __attribute__((ext_vector_type(4)));
typedef unsigned v2u __attribute__((ext_vector_type(2)));
typedef float f32x4 __attribute__((ext_vector_type(4)));
typedef float f32x16 __attribute__((ext_vector_type(16)));
typedef short bf16x8 __attribute__((ext_vector_type(8)));
typedef short s16x4 __attribute__((ext_vector_type(4)));
typedef GAS unsigned gu32;
#define RLX_AGENT __ATOMIC_RELAXED, __HIP_MEMORY_SCOPE_AGENT
#define LDS_WAIT() asm volatile("s_waitcnt lgkmcnt(0)" ::: "memory")
#define VM_WAIT() asm volatile("s_waitcnt vmcnt(0)" ::: "memory")
__device__ __forceinline__ unsigned pk2(float lo, float hi) { return pg8::cvt_pk_bf16(lo, hi); }
__device__ __forceinline__ float bflo(unsigned w) { return __uint_as_float(w << 16); }
__device__ __forceinline__ float bfhi(unsigned w) { return __uint_as_float(w & 0xffff0000u); }
__device__ __forceinline__ float bf2f(bf16 h) { return __uint_as_float(((unsigned)h) << 16); }
#define XB_TMO      128
#define XB_XCNT(j)  (256  + 64 * (j))
#define XB_XSUB(j)  (1280 + 64 * (j))
#define XB_XGEN(j)  (2304 + 64 * (j))
#define XB_TOP      3328
#define XB_TOPGEN   3392
#define XCD_BAR_WORDS 3456
#define XB_SPIN_CAP (1u << 18)

__device__ __forceinline__ unsigned xb_ld(unsigned* p)              { return __hip_atomic_load(p, __ATOMIC_RELAXED, __HIP_MEMORY_SCOPE_AGENT); }
__device__ __forceinline__ unsigned xb_add(unsigned* p, unsigned v) { return __hip_atomic_fetch_add(p, v, __ATOMIC_RELAXED, __HIP_MEMORY_SCOPE_AGENT); }
__device__ __forceinline__ unsigned xb_xcc_id() { return (unsigned)__builtin_amdgcn_s_getreg((3 << 11) | 20) & 0xFu; }
#define XB_SPIN(cond, bar) do { unsigned _sp = 0; while (cond) { __builtin_amdgcn_s_sleep(1); \
    if ((++_sp & 255u) == 0u) { if (xb_ld(&(bar)[XB_TMO])) break; if (_sp > XB_SPIN_CAP) { atomicAdd(&(bar)[XB_TMO], 1u); break; } } } } while (0)

struct XcdBarrier {
    unsigned* bar; unsigned x;
    volatile LAS unsigned* st;
};

__device__ __forceinline__ XcdBarrier xcd_barrier_post(unsigned* bar, volatile LAS unsigned* st) {
    XcdBarrier b; b.bar = bar; b.x = xb_xcc_id(); b.st = st;
    if (threadIdx.x == 0) (void)xb_add(&bar[XB_XCNT(b.x)], 1u);
    return b;
}
__device__ __forceinline__ void xcd_barrier_complete(unsigned* bar, unsigned x, unsigned& nloc, unsigned& nx) {
    const unsigned G = gridDim.x * gridDim.y * gridDim.z;
    unsigned sum, cnt, mine, sp = 0u;
    for (;;) {
        sum = 0u; cnt = 0u; mine = 0u;
#pragma unroll
        for (unsigned j = 0; j < 16; ++j) { const unsigned c = xb_ld(&bar[XB_XCNT(j)]); sum += c; cnt += (c > 0u) ? 1u : 0u; mine = (j == x) ? c : mine; }
        if (sum == G) break;
        __builtin_amdgcn_s_sleep(1);
        if ((++sp & 255u) == 0u) { if (xb_ld(&bar[XB_TMO])) break; if (sp > XB_SPIN_CAP) { atomicAdd(&bar[XB_TMO], 1u); break; } }
    }
    nloc = mine > 0u ? mine : 1u; nx = cnt > 0u ? cnt : 1u;
}

__device__ __forceinline__ void xcd_barrier(const XcdBarrier& b) {
    asm volatile("s_waitcnt vmcnt(0)" ::: "memory");
    __syncthreads();
    if (threadIdx.x == 0) {
        unsigned* bar = b.bar;
        __builtin_amdgcn_s_waitcnt(0);
        unsigned nloc = b.st[0], nx = b.st[1];
        if (nloc == 0u) { xcd_barrier_complete(bar, b.x, nloc, nx); b.st[0] = nloc; b.st[1] = nx; }
        const unsigned old = xb_add(&bar[XB_XSUB(b.x)], 1u);
        const unsigned gen = old / nloc;
        if (old + 1u == (gen + 1u) * nloc) {
            __builtin_amdgcn_fence(__ATOMIC_RELEASE, "agent");
            asm volatile("s_waitcnt vmcnt(0)" ::: "memory");
            const unsigned og = xb_add(&bar[XB_TOP], 1u);
            const unsigned tg = og / nx;
            if (og + 1u == (tg + 1u) * nx) xb_add(&bar[XB_TOPGEN], 1u);
            else XB_SPIN(xb_ld(&bar[XB_TOPGEN]) == tg, bar);
            __builtin_amdgcn_fence(__ATOMIC_ACQUIRE, "agent");
            xb_add(&bar[XB_XGEN(b.x)], 1u);
            asm volatile("s_waitcnt vmcnt(0)" ::: "memory");
        } else {
            XB_SPIN(xb_ld(&bar[XB_XGEN(b.x)]) == gen, bar);
            __builtin_amdgcn_fence(__ATOMIC_ACQUIRE, "agent");
            asm volatile("s_waitcnt vmcnt(0)" ::: "memory");
        }
    }
    __syncthreads();
}

struct Frame {
    LAS unsigned char* lds; volatile LAS unsigned* MISC; gu32* ctl; unsigned char* ws;
    int tid, lane, wave, vcu, G;
    const float* in[29]; float* out;
};
enum { I_X = 0, I_C, I_RELB, I_WADA, I_BADA, I_GPREMIX, I_GPOSTMIX, I_WIN, I_WATT, I_LRE, I_LIM, I_LOGDT, I_BRE, I_BIM, I_CRE, I_CIM, I_SSMD, I_WGLUV, I_WGLUG, I_WMIX,
       I_GPREFFN, I_GPOSTFFN, I_WRG, I_BRG, I_WRE, I_BRE2, I_WEG, I_WEU, I_WED };
__device__ __forceinline__ float wave_sum(float v) {
#pragma unroll
    for (int o = 1; o < 64; o <<= 1) v += __shfl_xor(v, o);
    return v;
}

__device__ __forceinline__ void p0_mod(Frame& F) {
    LAS float* cact = (LAS float*)F.lds;
    LAS float* red = (LAS float*)(F.lds + 65536);
    const float* c = F.in[I_C]; const float* w = F.in[I_WADA]; const float* bb = F.in[I_BADA];
    float* mod = (float*)(F.ws + WS_MOD);
    for (int i = F.tid; i < 16 * 1024; i += 512) { const int b = i >> 10, k = i & 1023; const float v = c[i]; cact[k * 16 + b] = v / (1.0f + __expf(-v)); }
    __syncthreads();
    const int blk = blockIdx.x, c4 = F.tid % 6, bg = (F.tid / 6) % 4, ks = F.tid / 24;
    float acc[4][4];
#pragma unroll
    for (int i = 0; i < 4; ++i)
#pragma unroll
        for (int j = 0; j < 4; ++j) acc[i][j] = 0.f;
    if (F.tid < 504) {
        for (int k = ks; k < 1024; k += 21) {
            const f32x4 wv = *(const f32x4*)(w + (size_t)k * 6144 + 24 * blk + 4 * c4);
            const f32x4 av = *(const LAS f32x4*)(cact + k * 16 + 4 * bg);
#pragma unroll
            for (int i = 0; i < 4; ++i)
#pragma unroll
                for (int j = 0; j < 4; ++j) acc[i][j] += av[i] * wv[j];
        }
#pragma unroll
        for (int i = 0; i < 4; ++i)
#pragma unroll
            for (int j = 0; j < 4; ++j) red[(ks * 24 + bg * 6 + c4) * 16 + i * 4 + j] = acc[i][j];
    }
    __syncthreads();
    if (F.tid < 384) {
        const int b = F.tid / 24, cc = F.tid % 24, cq = cc >> 2, j = cc & 3, g = b >> 2, bi = b & 3;
        float s = bb[24 * blk + cc];
        for (int q = 0; q < 21; ++q) s += red[(q * 24 + g * 6 + cq) * 16 + bi * 4 + j];
        mod[b * 6144 + 24 * blk + cc] = s;
    }
    __syncthreads();
}

__device__ __forceinline__ int t5_bucket(int d) {
    if (d < 16) return d;
    const float v = logf((float)d / 16.0f) / 2.0794415416798357f * 16.0f;
    const int b = 16 + (int)v; return b < 31 ? b : 31;
}
__device__ __forceinline__ void p0_tables(Frame& F) {
    { float* bt = (float*)(F.ws + WS_BTAB); const float* rb = F.in[I_RELB];
      for (int i = blockIdx.x * 512 + F.tid; i < 8 * 576; i += F.G * 512) { const int h = i / 576, d = i % 576 - 64;
          bt[i] = d < 0 ? -1e30f : rb[t5_bucket(d) * 8 + h] * LOG2E; } }
    { bf16* rw = (bf16*)(F.ws + WS_ROUTW); float* rcb = (float*)(F.ws + WS_ROUTC); const float* wg = F.in[I_WRG]; const float* we = F.in[I_WRE]; const float* mod = (const float*)(F.ws + WS_MOD);
      for (int i = blockIdx.x * 512 + F.tid; i < 16 * 49152; i += F.G * 512) {
          const int b = i / 49152, r = i % 49152, j = r & 7, ln = (r >> 3) & 63, nt = (r >> 9) % 3, ks = r / 1536;
          const int k = 32 * ks + 8 * (ln >> 4) + j, col = 16 * nt + (ln & 15);
          const float v = col < 4 ? wg[k * 4 + col] : (col < 36 ? we[k * 32 + col - 4] : 0.f);
          rw[i] = (bf16)(pk2(v * F.in[I_GPREFFN][k] * (1.0f + mod[b * 6144 + 4096 + k]), 0.f) & 0xffffu); }
      for (int i = blockIdx.x * 512 + F.tid; i < 16 * 48 * 8; i += F.G * 512) {
          const int sl = i & 7, col = (i >> 3) % 48, b = i / 384; float sm = 0.f;
          if (col < 36) for (int k = sl * 128; k < sl * 128 + 128; ++k) sm += mod[b * 6144 + 3072 + k] * (col < 4 ? wg[k * 4 + col] : we[k * 32 + col - 4]);
          sm += __shfl_xor(sm, 1); sm += __shfl_xor(sm, 2); sm += __shfl_xor(sm, 4);
          if (sl == 0) rcb[b * 48 + col] = col < 36 ? sm + (col < 4 ? F.in[I_BRG][col] : F.in[I_BRE2][col - 4]) : 0.f; } }
    {
        const int g = blockIdx.x & 15, part = blockIdx.x >> 4;
        LAS float* Apow = (LAS float*)F.lds;
        LAS float* Bb = Apow + 64 * 33 * 2;
        LAS float* Cc = Bb + 64 * 16 * 2;
        if (F.tid < 64) {
            const int p = F.tid; const float lr = F.in[I_LRE][g * 64 + p], li = F.in[I_LIM][g * 64 + p], dt = expf(F.in[I_LOGDT][g]);
            const float zr = lr * dt, zi = li * dt;
            for (int e = 0; e <= 32; ++e) { float sn, cs; sincosf(zi * (float)e, &sn, &cs); const float mg = expf(zr * (float)e); Apow[(p * 33 + e) * 2] = mg * cs; Apow[(p * 33 + e) * 2 + 1] = mg * sn; }
            float sn, cs, sh; sincosf(zi, &sn, &cs); sh = sinf(0.5f * zi);
            const float nr = expm1f(zr) * cs - 2.0f * sh * sh, ni = expf(zr) * sn, den = lr * lr + li * li;
            const float fr_ = (nr * lr + ni * li) / den, fi_ = (ni * lr - nr * li) / den;
            for (int ch = 0; ch < 16; ++ch) { const float br = F.in[I_BRE][(g * 64 + p) * 16 + ch], bi = F.in[I_BIM][(g * 64 + p) * 16 + ch];
                Bb[(p * 16 + ch) * 2] = fr_ * br - fi_ * bi; Bb[(p * 16 + ch) * 2 + 1] = fr_ * bi + fi_ * br; }
            if (part == 0) { float* aL = (float*)(F.ws + WS_SSMAL) + (g * 64 + p) * 2; aL[0] = Apow[(p * 33 + 32) * 2]; aL[1] = Apow[(p * 33 + 32) * 2 + 1]; }
        }
        for (int i = F.tid; i < 1024; i += 512) { const int co = i >> 6, p = i & 63; Cc[i * 2] = F.in[I_CRE][(g * 16 + co) * 64 + p]; Cc[i * 2 + 1] = F.in[I_CIM][(g * 16 + co) * 64 + p]; }
        __syncthreads();
        unsigned char* gb = F.ws + WS_SSMTAB + (size_t)g * SSM_GRP_BYTES;
        bf16* Tf = (bf16*)(gb + SSM_T_OFF); bf16* Wf = (bf16*)(gb + SSM_W_OFF); bf16* Sf = (bf16*)(gb + SSM_S_OFF);
        for (int q = F.tid; q < 1024; q += 512) {
            const int idx = part * 1024 + q, j = idx & 7, ln = (idx >> 3) & 63, dj = idx >> 9, kq = ln >> 4, co = ln & 15, lag = dj - (kq >> 1), ch = 8 * (kq & 1) + j;
            float s = 0.f;
            if (lag >= 0) for (int p = 0; p < 64; ++p) {
                const float cr = Cc[(co * 64 + p) * 2], ci = Cc[(co * 64 + p) * 2 + 1], ar = Apow[(p * 33 + lag) * 2], ai = Apow[(p * 33 + lag) * 2 + 1], br = Bb[(p * 16 + ch) * 2], bi = Bb[(p * 16 + ch) * 2 + 1];
                const float tr = cr * ar - ci * ai, ti = cr * ai + ci * ar; s += tr * br - ti * bi; }
            if (lag == 0 && co == ch) s += F.in[I_SSMD][g * 16 + co];
            Tf[idx] = (bf16)(pk2(s, 0.f) & 0xffffu);
        }
        for (int q = F.tid; q < 4096; q += 512) {
            const int idx = part * 4096 + q, j = idx & 7, ln = (idx >> 3) & 63, nt = (idx >> 9) & 7, ks = idx >> 12, kq = ln >> 4;
            const int s_ = 2 * ks + (kq >> 1), ch = 8 * (kq & 1) + j, n = 16 * nt + (ln & 15), p = n & 63, e = 31 - s_;
            const float ar = Apow[(p * 33 + e) * 2], ai = Apow[(p * 33 + e) * 2 + 1], br = Bb[(p * 16 + ch) * 2], bi = Bb[(p * 16 + ch) * 2 + 1];
            const float v = (n < 64) ? (ar * br - ai * bi) : (ar * bi + ai * br);
            Wf[idx] = (bf16)(pk2(v, 0.f) & 0xffffu);
        }
        for (int q = F.tid; q < 4096; q += 512) {
            const int idx = part * 4096 + q, j = idx & 7, ln = (idx >> 3) & 63, t = (idx >> 9) & 31, ks = idx >> 14, kq = ln >> 4;
            const int k = 32 * ks + 8 * kq + j, p = k & 63, co = ln & 15;
            const float cr = Cc[(co * 64 + p) * 2], ci = Cc[(co * 64 + p) * 2 + 1], ar = Apow[(p * 33 + t + 1) * 2], ai = Apow[(p * 33 + t + 1) * 2 + 1];
            const float v = (k < 64) ? (cr * ar - ci * ai) : -(cr * ai + ci * ar);
            Sf[idx] = (bf16)(pk2(v, 0.f) & 0xffffu);
        }
        __syncthreads();
    }
}

__device__ __forceinline__ void transpose_item(const float* W, int K, int N, bf16* WT, int mode, LAS float* scr, int item, int lane) {
    const int nblk = N / 32, kb = item / nblk, nb = item % nblk, k0 = 64 * kb, n0 = 32 * nb;
    float tv[32];
#pragma unroll
    for (int i = 0; i < 32; ++i) { const int kk = 2 * i + (lane >> 5); tv[i] = W[(size_t)(k0 + kk) * N + n0 + (lane & 31)]; }
#pragma unroll
    for (int i = 0; i < 32; ++i) { const int kk = 2 * i + (lane >> 5); scr[kk * 33 + (lane & 31)] = tv[i]; }
    LDS_WAIT(); asm volatile("" ::: "memory");
    const int c = lane & 7;
#pragma unroll
    for (int j = 0; j < 4; ++j) { const int n = (lane >> 3) + 8 * j; const LAS float* s = scr + (8 * c) * 33 + n;
        v4u o; o.x = pk2(s[0 * 33], s[1 * 33]); o.y = pk2(s[2 * 33], s[3 * 33]); o.z = pk2(s[4 * 33], s[5 * 33]); o.w = pk2(s[6 * 33], s[7 * 33]);
        const int ng = n0 + n; const int drow = mode == 0 ? ng : (256 * (ng >> 7) + (ng & 127) + (mode == 2 ? 128 : 0));
        *(GAS v4u*)(WT + (size_t)drow * K + k0 + 8 * c) = o; }
    LDS_WAIT(); asm volatile("" ::: "memory");
}
__device__ __forceinline__ float clamp8(float v) { return __builtin_amdgcn_fmed3f(v, -440.f, 440.f); }
__device__ __forceinline__ unsigned pk4_fp8(float a, float b, float c, float d) { int w = __builtin_amdgcn_cvt_pk_fp8_f32(clamp8(a), clamp8(b), 0, false); w = __builtin_amdgcn_cvt_pk_fp8_f32(clamp8(c), clamp8(d), w, true); return (unsigned)w; }
__device__ __forceinline__ void transpose_item_f8(const float* W, int K, int N, unsigned char* WT, int mode, float scale, LAS float* scr, int item, int lane) {
    const int nblk = N / 32, kb = item / nblk, nb = item % nblk, k0 = 64 * kb, n0 = 32 * nb;
    const int g = lane >> 3, c = lane & 7;
    f32x4 tv[8];
    const float* wp = W + (size_t)(k0 + 8 * g) * N + n0 + 4 * c;
#pragma unroll
    for (int i = 0; i < 8; ++i) tv[i] = *(const f32x4*)(wp + (size_t)i * N);
#pragma unroll
    for (int j = 0; j < 4; ++j) {
        v2u o; o.x = pk4_fp8(tv[0][j] * scale, tv[1][j] * scale, tv[2][j] * scale, tv[3][j] * scale); o.y = pk4_fp8(tv[4][j] * scale, tv[5][j] * scale, tv[6][j] * scale, tv[7][j] * scale);
        const int ng = n0 + 4 * c + j; const int drow = mode == 0 ? ng : (256 * (ng >> 7) + (ng & 127) + (mode == 2 ? 128 : 0));
        *(GAS v2u*)(WT + (size_t)drow * K + k0 + 8 * g) = o; }
    (void)scr;
}
#define WDESC(it, S) const float* W##S; unsigned char* D##S; int K##S, N##S, M##S, I##S; do { const int it_ = (it); \
        if (it_ < I0) { W##S = F.in[I_WIN]; D##S = F.ws + WS_WIN; K##S = 1024; N##S = NPROJ; M##S = 0; I##S = it_; } \
        else if (it_ < I1) { W##S = F.in[I_WATT]; D##S = F.ws + WS_WO; K##S = 512; N##S = 1024; M##S = 0; I##S = it_ - I0; } \
        else if (it_ < I2) { W##S = F.in[I_WGLUV]; D##S = F.ws + WS_WGLU; K##S = 256; N##S = 1024; M##S = 1; I##S = it_ - I1; } \
        else if (it_ < I3) { W##S = F.in[I_WGLUG]; D##S = F.ws + WS_WGLU; K##S = 256; N##S = 1024; M##S = 2; I##S = it_ - I2; } \
        else if (it_ < I4) { W##S = F.in[I_WMIX]; D##S = F.ws + WS_WMIX; K##S = 1024; N##S = 1024; M##S = 0; I##S = it_ - I3; } \
        else if (it_ < I5) { const int r_ = it_ - I4, e_ = r_ >> 8; W##S = F.in[I_WEG] + (size_t)e_ * 1024 * 512; D##S = F.ws + WS_WGU + (size_t)e_ * 1024 * 1024; K##S = 1024; N##S = 512; M##S = 1; I##S = r_ & 255; } \
        else if (it_ < I6) { const int r_ = it_ - I5, e_ = r_ >> 8; W##S = F.in[I_WEU] + (size_t)e_ * 1024 * 512; D##S = F.ws + WS_WGU + (size_t)e_ * 1024 * 1024; K##S = 1024; N##S = 512; M##S = 2; I##S = r_ & 255; } \
        else { const int r_ = it_ - I6, e_ = r_ >> 8; W##S = F.in[I_WED] + (size_t)e_ * 512 * 1024; D##S = F.ws + WS_WDN + (size_t)e_ * 1024 * 512; K##S = 512; N##S = 1024; M##S = 0; I##S = r_ & 255; } } while (0)
#define WLOAD(S, tv) do { const int nblk_ = N##S / 32, kb_ = I##S / nblk_, nb_ = I##S % nblk_; const float* wp_ = W##S + (size_t)(64 * kb_ + 8 * (lane >> 3)) * N##S + 32 * nb_ + 4 * (lane & 7); \
        _Pragma("unroll") for (int i = 0; i < 8; ++i) tv[i] = __builtin_nontemporal_load((const f32x4*)(wp_ + (size_t)i * N##S)); } while (0)
#define WSTORE(S, tv) do { const int nblk_ = N##S / 32, kb_ = I##S / nblk_, nb_ = I##S % nblk_, k0_ = 64 * kb_, n0_ = 32 * nb_, g_ = lane >> 3, c_ = lane & 7; \
        _Pragma("unroll") for (int j = 0; j < 4; ++j) { v2u o; o.x = pk4_fp8(tv[0][j] * W8_SCALE, tv[1][j] * W8_SCALE, tv[2][j] * W8_SCALE, tv[3][j] * W8_SCALE); o.y = pk4_fp8(tv[4][j] * W8_SCALE, tv[5][j] * W8_SCALE, tv[6][j] * W8_SCALE, tv[7][j] * W8_SCALE); \
            const int ng = n0_ + 4 * c_ + j; const int drow = M##S == 0 ? ng : (256 * (ng >> 7) + (ng & 127) + (M##S == 2 ? 128 : 0)); \
            *(GAS v2u*)(D##S + (size_t)drow * K##S + k0_ + 8 * g_) = o; } } while (0)
constexpr int WI_EXPERT = 16 * 120 + 8 * 32 + 4 * 32 + 4 * 32 + 16 * 32, WI_END = WI_EXPERT + 3 * 32 * 256;
__device__ __forceinline__ void p0_weights(Frame& F, const int lo, const int hi) {
    const int lane = F.lane; const int gw = F.vcu * NWAVES + F.wave, NGW = F.G * NWAVES;
    constexpr int I0 = 16 * 120, I1 = I0 + 8 * 32, I2 = I1 + 4 * 32, I3 = I2 + 4 * 32, I4 = I3 + 16 * 32, I5 = I4 + 32 * 256, I6 = I5 + 32 * 256, I7 = I6 + 32 * 256;
    static_assert(I4 == WI_EXPERT && I7 == WI_END, "item ranges");
    f32x4 nv[8];
    if (lo + gw < hi) { WDESC(lo + gw, a); WLOAD(a, nv); }
    for (int it = lo + gw; it < hi; it += NGW) {
        f32x4 cv[8];
#pragma unroll
        for (int i = 0; i < 8; ++i) cv[i] = nv[i];
        const int nit = it + NGW < hi ? it + NGW : it;
        { WDESC(nit, n); WLOAD(n, nv); }
        { WDESC(it, c); WSTORE(c, cv); }
    }
}
#undef WDESC
#undef WLOAD
#undef WSTORE

__device__ __forceinline__ void p1_xn(Frame& F) {
    const int gw = F.vcu * NWAVES + F.wave; const int row0 = gw * 32, b = row0 >> 12;
    const float* mod = (const float*)(F.ws + WS_MOD) + b * 6144; const float* g = F.in[I_GPREMIX];
    f32x4 A1[4], A3[4];
#pragma unroll
    for (int j = 0; j < 4; ++j) { const int c = 4 * F.lane + 256 * j; const f32x4 gg = *(const f32x4*)(g + c), sc = *(const f32x4*)(mod + 1024 + c); A1[j] = gg * (sc + 1.0f); A3[j] = *(const f32x4*)(mod + c); }
    unsigned char* XN = F.ws + WS_RA;
    f32x4 nx[4];
    { const f32x4* xr = (const f32x4*)(F.in[I_X] + (size_t)row0 * 1024) + F.lane;
#pragma unroll
      for (int j = 0; j < 4; ++j) nx[j] = __builtin_nontemporal_load(xr + 64 * j); }
    for (int r = 0; r < 32; ++r) {
        const size_t row = (size_t)(row0 + r);
        f32x4 v[4]; float s = 0.f;
#pragma unroll
        for (int j = 0; j < 4; ++j) v[j] = nx[j];
        { const f32x4* xr = (const f32x4*)(F.in[I_X] + (row + (r < 31 ? 1 : 0)) * 1024) + F.lane;
#pragma unroll
          for (int j = 0; j < 4; ++j) nx[j] = __builtin_nontemporal_load(xr + 64 * j); }
#pragma unroll
        for (int j = 0; j < 4; ++j) s += (v[j].x * v[j].x + v[j].y * v[j].y) + (v[j].z * v[j].z + v[j].w * v[j].w);
        const float rstd = rsqrtf(wave_sum(s) * (1.0f / 1024.0f) + RMS_EPS);
        unsigned* o = (unsigned*)(XN + row * 1024) + F.lane;
#pragma unroll
        for (int j = 0; j < 4; ++j) { const f32x4 h = (v[j] * rstd * A1[j] + A3[j]) * A8_SCALE; o[64 * j] = pk4_fp8(h.x, h.y, h.z, h.w); }
    }
}

namespace att {
constexpr int LK = 0, LV = 32768, LBT = 65536, LKM = 67840, LWS = 72192, LSTG = 74240, LLIST = 111104;
constexpr int STG_ROW = 144, STG_WAVE = 32 * STG_ROW;
#define KSWZ64(row, colB) ((row) * 128 + ((colB) ^ ((((row) >> 1) & 7) << 4)))
__device__ __forceinline__ int crow(int r, int hi) { return (r & 3) + 8 * (r >> 2) + 4 * hi; }
__device__ __forceinline__ int v_st(int k, int c) { const int kk = (k & ~0xC) | ((k & 4) << 1) | ((k & 8) >> 1); return ((kk >> 3) * 2 + (c >> 5)) * 512 + ((kk & 7) * 32 + (c & 31)) * 2; }
__device__ __forceinline__ int v_rd_base(int lane) { return ((lane & 3) << 3) | (((lane >> 2) & 3) << 6) | (((lane >> 4) & 1) << 5) | (((lane >> 5) & 1) << 8); }
constexpr int v_rd_off(int d0, int ks, int half) { return d0 * 512 + ks * 2048 + half * 1024; }
template <int OFF> __device__ __forceinline__ s16x4 tr_read(int vb) { s16x4 r; asm volatile("ds_read_b64_tr_b16 %0, %1 offset:%2" : "=&v"(r) : "v"(vb), "i"(OFF) : "memory"); return r; }
#define SBAR() __builtin_amdgcn_sched_barrier(0)
template <int D0> __device__ __forceinline__ void pv_one(f32x16& od, int vb, bf16x8 pa0, bf16x8 pa1, bf16x8 pa2, bf16x8 pa3) {
    const s16x4 l0 = tr_read<v_rd_off(D0, 0, 0)>(vb), h0 = tr_read<v_rd_off(D0, 0, 1)>(vb), l1 = tr_read<v_rd_off(D0, 1, 0)>(vb), h1 = tr_read<v_rd_off(D0, 1, 1)>(vb);
    const s16x4 l2 = tr_read<v_rd_off(D0, 2, 0)>(vb), h2 = tr_read<v_rd_off(D0, 2, 1)>(vb), l3 = tr_read<v_rd_off(D0, 3, 0)>(vb), h3 = tr_read<v_rd_off(D0, 3, 1)>(vb);
    asm volatile("s_waitcnt lgkmcnt(0)" ::: "memory"); SBAR();
#define PK(L, H) (bf16x8){L[0], L[1], L[2], L[3], H[0], H[1], H[2], H[3]}
    od = __builtin_amdgcn_mfma_f32_32x32x16_bf16(pa0, PK(l0, h0), od, 0, 0, 0);
    od = __builtin_amdgcn_mfma_f32_32x32x16_bf16(pa1, PK(l1, h1), od, 0, 0, 0);
    od = __builtin_amdgcn_mfma_f32_32x32x16_bf16(pa2, PK(l2, h2), od, 0, 0, 0);
    od = __builtin_amdgcn_mfma_f32_32x32x16_bf16(pa3, PK(l3, h3), od, 0, 0, 0);
#undef PK
}
__device__ __forceinline__ void pv_two(f32x16 (&o)[2], int vb, bf16x8 pa0, bf16x8 pa1, bf16x8 pa2, bf16x8 pa3) {
    const s16x4 l0 = tr_read<v_rd_off(0, 0, 0)>(vb), h0 = tr_read<v_rd_off(0, 0, 1)>(vb), l1 = tr_read<v_rd_off(0, 1, 0)>(vb), h1 = tr_read<v_rd_off(0, 1, 1)>(vb);
    const s16x4 l2 = tr_read<v_rd_off(0, 2, 0)>(vb), h2 = tr_read<v_rd_off(0, 2, 1)>(vb), l3 = tr_read<v_rd_off(0, 3, 0)>(vb), h3 = tr_read<v_rd_off(0, 3, 1)>(vb);
    const s16x4 m0 = tr_read<v_rd_off(1, 0, 0)>(vb), g0 = tr_read<v_rd_off(1, 0, 1)>(vb), m1 = tr_read<v_rd_off(1, 1, 0)>(vb), g1 = tr_read<v_rd_off(1, 1, 1)>(vb);
    const s16x4 m2 = tr_read<v_rd_off(1, 2, 0)>(vb), g2 = tr_read<v_rd_off(1, 2, 1)>(vb), m3 = tr_read<v_rd_off(1, 3, 0)>(vb), g3 = tr_read<v_rd_off(1, 3, 1)>(vb);
    asm volatile("s_waitcnt lgkmcnt(8)" ::: "memory"); SBAR();
#define PK(L, H) (bf16x8){L[0], L[1], L[2], L[3], H[0], H[1], H[2], H[3]}
    o[0] = __builtin_amdgcn_mfma_f32_32x32x16_bf16(pa0, PK(l0, h0), o[0], 0, 0, 0);
    o[0] = __builtin_amdgcn_mfma_f32_32x32x16_bf16(pa1, PK(l1, h1), o[0], 0, 0, 0);
    o[0] = __builtin_amdgcn_mfma_f32_32x32x16_bf16(pa2, PK(l2, h2), o[0], 0, 0, 0);
    o[0] = __builtin_amdgcn_mfma_f32_32x32x16_bf16(pa3, PK(l3, h3), o[0], 0, 0, 0);
    asm volatile("s_waitcnt lgkmcnt(0)" ::: "memory"); SBAR();
    o[1] = __builtin_amdgcn_mfma_f32_32x32x16_bf16(pa0, PK(m0, g0), o[1], 0, 0, 0);
    o[1] = __builtin_amdgcn_mfma_f32_32x32x16_bf16(pa1, PK(m1, g1), o[1], 0, 0, 0);
    o[1] = __builtin_amdgcn_mfma_f32_32x32x16_bf16(pa2, PK(m2, g2), o[1], 0, 0, 0);
    o[1] = __builtin_amdgcn_mfma_f32_32x32x16_bf16(pa3, PK(m3, g3), o[1], 0, 0, 0);
#undef PK
}
__device__ __forceinline__ void stage_kv(Frame& F, size_t rowb, int h, int key0, int ntile) {
    const bf16* Kg = (const bf16*)(F.ws + WS_K); const bf16* Vg = (const bf16*)(F.ws + WS_V);
    const int sr = F.tid >> 3, sc = (F.tid & 7) * 8; const int kst = KSWZ64(sr, sc * 2), vst = v_st(sr, sc);
    for (int t = 0; t < ntile; ++t) { const size_t go = (rowb + key0 + t * 64 + sr) * ATTW + h * HD + sc;
        const bf16x8 kv = *(const bf16x8*)(Kg + go), vv = *(const bf16x8*)(Vg + go);
        *(LAS bf16x8*)(F.lds + LK + t * 8192 + kst) = kv; *(LAS bf16x8*)(F.lds + LV + t * 8192 + vst) = vv; }
}
template <bool GENERAL> __device__ __forceinline__ void tile_step(LAS unsigned char* L, int kt, const bf16x8 (&qr)[4], float cinit, int ib, float& m_reg, float& l_reg, f32x16 (&o)[2],
                                                                  LAS float* wsf, int r32, int hi, int vb0) {
    f32x16 p0, p1;
#pragma unroll
    for (int r = 0; r < 16; ++r) { p0[r] = cinit; p1[r] = cinit; }
    const LAS unsigned char* Kt = L + LK + kt * 8192;
#pragma unroll
    for (int d0 = 0; d0 < 4; ++d0) { const int cb = (d0 * 16 + hi * 8) * 2;
        const bf16x8 k0 = *(const LAS bf16x8*)(Kt + KSWZ64(r32, cb)); const bf16x8 k1 = *(const LAS bf16x8*)(Kt + KSWZ64(32 + r32, cb));
        p0 = __builtin_amdgcn_mfma_f32_32x32x16_bf16(k0, qr[d0], p0, 0, 0, 0);
        p1 = __builtin_amdgcn_mfma_f32_32x32x16_bf16(k1, qr[d0], p1, 0, 0, 0); }
    if (GENERAL) {
        const LAS float* btab = (const LAS float*)(L + LBT);
        float bv0[16], bv1[16];
#pragma unroll
        for (int r = 0; r < 16; ++r) { const int c = (r & 3) + 8 * (r >> 2); bv0[r] = btab[ib - c]; bv1[r] = btab[ib - 32 - c]; }
        SBAR();
#pragma unroll
        for (int r = 0; r < 16; ++r) { p0[r] += bv0[r]; p1[r] += bv1[r]; }
    }
    float pmax = p0[0];
#pragma unroll
    for (int r = 1; r < 16; ++r) pmax = fmaxf(pmax, p0[r]);
#pragma unroll
    for (int r = 0; r < 16; ++r) pmax = fmaxf(pmax, p1[r]);
    { auto rr = __builtin_amdgcn_permlane32_swap(__float_as_uint(pmax), __float_as_uint(pmax), false, false); pmax = fmaxf(__uint_as_float(rr[0]), __uint_as_float(rr[1])); }
    pmax = fmaxf(pmax, -1e20f);
    const float mn = fmaxf(m_reg, pmax); const float alpha = __builtin_amdgcn_exp2f(m_reg - mn); m_reg = mn;
    float ps = 0.f;
#pragma unroll
    for (int r = 0; r < 16; ++r) { p0[r] = __builtin_amdgcn_exp2f(p0[r] - mn); p1[r] = __builtin_amdgcn_exp2f(p1[r] - mn); ps += p0[r] + p1[r]; }
    { auto rr = __builtin_amdgcn_permlane32_swap(__float_as_uint(ps), __float_as_uint(ps), false, false); ps = __uint_as_float(rr[0]) + __uint_as_float(rr[1]); }
    l_reg = l_reg * alpha + ps;
    bf16x8 pa0, pa1, pa2, pa3;
#define PK4(P, BASE, OUT) do { unsigned a0 = pk2(P[BASE + 0], P[BASE + 1]), a1 = pk2(P[BASE + 2], P[BASE + 3]); \
    unsigned b0 = pk2(P[BASE + 4], P[BASE + 5]), b1 = pk2(P[BASE + 6], P[BASE + 7]); \
    auto r0 = __builtin_amdgcn_permlane32_swap(a0, b0, false, false); auto r1 = __builtin_amdgcn_permlane32_swap(a1, b1, false, false); \
    v4u w = {r0[0], r1[0], r0[1], r1[1]}; OUT = __builtin_bit_cast(bf16x8, w); } while (0)
    PK4(p0, 0, pa0); PK4(p0, 8, pa1); PK4(p1, 0, pa2); PK4(p1, 8, pa3);
#undef PK4
    if (__any(alpha < 1.f)) { if (hi == 0) wsf[r32] = alpha; LDS_WAIT();
#pragma unroll
        for (int r = 0; r < 16; ++r) { const float a = wsf[crow(r, hi)]; o[0][r] *= a; o[1][r] *= a; }
        LDS_WAIT(); }
    const int vb = vb0 + kt * 8192;
    pv_one<0>(o[0], vb, pa0, pa1, pa2, pa3); pv_one<1>(o[1], vb, pa0, pa1, pa2, pa3);
}

__device__ __forceinline__ bool owned(int qb, int sub) { const int q = qb & 3; return sub ? (q == 1 || q == 2) : (q == 0 || q == 3); }
__device__ __forceinline__ void select_rows(Frame& F, int b, int h, int half) {
    LAS float* kmean = (LAS float*)(F.lds + LKM);
    LAS unsigned short* mloc = (LAS unsigned short*)(F.lds + LK);
    LAS int* lcnt = (LAS int*)(F.lds + LK + 4096);
    { const float* kp = (const float*)(F.ws + WS_KPART);
      for (int i = F.tid; i < 1024; i += 512) { const int n = i >> 6, d = i & 63; const size_t o = (size_t)((b * 16 + n) * 2) * 512 + h * 64 + d; kmean[i] = (kp[o] + kp[o + 512]) * (1.0f / 256.0f); }
      if (F.tid < 32) lcnt[F.tid] = 0; }
    __syncthreads();
    const bf16* Qg = (const bf16*)(F.ws + WS_Q); unsigned short* sel = (unsigned short*)(F.ws + WS_SEL);
    for (int c = 0; c < 4; ++c) {
        const int row = half * 2048 + c * 512 + F.tid, qb = row >> 8;
        const v4u* qp = (const v4u*)(Qg + ((size_t)b * SEQ + row) * ATTW + h * HD);
        float qf[64];
#pragma unroll
        for (int i = 0; i < 8; ++i) { const v4u w = qp[i]; qf[8 * i] = bflo(w.x); qf[8 * i + 1] = bfhi(w.x); qf[8 * i + 2] = bflo(w.y); qf[8 * i + 3] = bfhi(w.y); qf[8 * i + 4] = bflo(w.z); qf[8 * i + 5] = bfhi(w.z); qf[8 * i + 6] = bflo(w.w); qf[8 * i + 7] = bfhi(w.w); }
        float v0 = -3.0e38f, v1 = -3.0e38f, v2 = -3.0e38f; int i0 = -1, i1 = -1, i2 = -1;
        for (int n = 0; n < qb; ++n) {
            float g = 0.f;
#pragma unroll
            for (int d = 0; d < 64; ++d) g += qf[d] * kmean[n * 64 + d];
            if (g > v0) { v2 = v1; i2 = i1; v1 = v0; i1 = i0; v0 = g; i0 = n; }
            else if (g > v1) { v2 = v1; i2 = i1; v1 = g; i1 = n; }
            else if (g > v2) { v2 = g; i2 = n; }
        }
        unsigned m = 0u; if (i0 >= 0) m |= 1u << i0; if (i1 >= 0) m |= 1u << i1; if (i2 >= 0) m |= 1u << i2;
        sel[((size_t)(b * NH + h)) * SEQ + row] = (unsigned short)m; mloc[c * 512 + F.tid] = (unsigned short)m;
    }
    __syncthreads();
    unsigned short* rl = (unsigned short*)(F.ws + WS_RLIST) + ((size_t)(b * NH + h) * 16) * 4 * 1024;
    for (int qi = 0; qi < 8; ++qi) {
        const int qb = half * 8 + qi, sub = owned(qb, 0) ? 0 : 1;
        if (F.tid < 256) { const int lr = qi * 256 + F.tid; unsigned m = mloc[lr];
            while (m) { const int n = __builtin_ctz(m); m &= m - 1u; const int pos = __hip_atomic_fetch_add(lcnt + n * 2 + sub, 1, __ATOMIC_RELAXED, __HIP_MEMORY_SCOPE_WORKGROUP);
                rl[((size_t)(n * 2 + sub) * 2 + half) * 1024 + pos] = (unsigned short)(half * 2048 + lr); } }
        __syncthreads();
    }
    if (F.tid < 32) { int* rc = (int*)(F.ws + WS_RCNT) + ((size_t)(b * NH + h) * 16) * 4; rc[F.tid * 2 + half] = lcnt[F.tid]; }
    __syncthreads();
}

template <bool GENERAL, bool FIRST, bool PREF> __device__ __forceinline__ void tile_pair(LAS unsigned char* L, int kt0, bf16x8 (&qr)[4], float cinit, int ib, float& m_reg, float& l_reg, f32x16 (&o)[2],
                                                                             LAS float* wsf, int r32, int hi, int vb0, const bf16* qnext) {
    f32x16 s[2][2];
#pragma unroll
    for (int t = 0; t < 2; ++t) {
#pragma unroll
        for (int r = 0; r < 16; ++r) { s[t][0][r] = cinit; s[t][1][r] = cinit; }
        const LAS unsigned char* Kt = L + LK + (kt0 + t) * 8192;
#pragma unroll
        for (int d0 = 0; d0 < 4; ++d0) { const int cb = (d0 * 16 + hi * 8) * 2;
            const bf16x8 k0 = *(const LAS bf16x8*)(Kt + KSWZ64(r32, cb)); const bf16x8 k1 = *(const LAS bf16x8*)(Kt + KSWZ64(32 + r32, cb));
            s[t][0] = __builtin_amdgcn_mfma_f32_32x32x16_bf16(k0, qr[d0], s[t][0], 0, 0, 0);
            s[t][1] = __builtin_amdgcn_mfma_f32_32x32x16_bf16(k1, qr[d0], s[t][1], 0, 0, 0); }
    }
    if (PREF) {
#pragma unroll
        for (int d0 = 0; d0 < 4; ++d0) qr[d0] = *(const bf16x8*)(qnext + d0 * 16); }
    if (GENERAL) {
        const LAS float* btab = (const LAS float*)(L + LBT);
#pragma unroll
        for (int t = 0; t < 2; ++t) { float bv0[16], bv1[16];
#pragma unroll
            for (int r = 0; r < 16; ++r) { const int c = (r & 3) + 8 * (r >> 2); int i0 = ib - t * 64 - c, i1 = ib - t * 64 - 32 - c; i0 = i0 < 575 ? i0 : 575; i1 = i1 < 575 ? i1 : 575; bv0[r] = btab[i0]; bv1[r] = btab[i1]; }
            SBAR();
#pragma unroll
            for (int r = 0; r < 16; ++r) { s[t][0][r] += bv0[r]; s[t][1][r] += bv1[r]; } }
    }
    float pmax = fmaxf(s[0][0][0], s[1][0][0]);
#pragma unroll
    for (int r = 0; r < 16; ++r) pmax = fmaxf(pmax, fmaxf(fmaxf(s[0][0][r], s[0][1][r]), fmaxf(s[1][0][r], s[1][1][r])));
    { auto rr = __builtin_amdgcn_permlane32_swap(__float_as_uint(pmax), __float_as_uint(pmax), false, false); pmax = fmaxf(__uint_as_float(rr[0]), __uint_as_float(rr[1])); }
    pmax = fmaxf(pmax, -1e20f);
    const float mn = fmaxf(m_reg, pmax); const float alpha = __builtin_amdgcn_exp2f(m_reg - mn); m_reg = mn;
    float ps = 0.f;
#pragma unroll
    for (int t = 0; t < 2; ++t)
#pragma unroll
        for (int r = 0; r < 16; ++r) { s[t][0][r] = __builtin_amdgcn_exp2f(s[t][0][r] - mn); s[t][1][r] = __builtin_amdgcn_exp2f(s[t][1][r] - mn); ps += s[t][0][r] + s[t][1][r]; }
    { auto rr = __builtin_amdgcn_permlane32_swap(__float_as_uint(ps), __float_as_uint(ps), false, false); ps = __uint_as_float(rr[0]) + __uint_as_float(rr[1]); }
    l_reg = FIRST ? ps : (l_reg * alpha + ps);
    if (!FIRST) { if (__any(alpha < 1.f)) { if (hi == 0) wsf[r32] = alpha; LDS_WAIT();
#pragma unroll
        for (int r = 0; r < 16; ++r) { const float a = wsf[crow(r, hi)]; o[0][r] *= a; o[1][r] *= a; }
        LDS_WAIT(); } }
#define PK4(P, BASE, OUT) do { unsigned a0 = pk2(P[BASE + 0], P[BASE + 1]), a1 = pk2(P[BASE + 2], P[BASE + 3]); \
    unsigned b0 = pk2(P[BASE + 4], P[BASE + 5]), b1 = pk2(P[BASE + 6], P[BASE + 7]); \
    auto r0 = __builtin_amdgcn_permlane32_swap(a0, b0, false, false); auto r1 = __builtin_amdgcn_permlane32_swap(a1, b1, false, false); \
    v4u w = {r0[0], r1[0], r0[1], r1[1]}; OUT = __builtin_bit_cast(bf16x8, w); } while (0)
#pragma unroll
    for (int t = 0; t < 2; ++t) { bf16x8 pa0, pa1, pa2, pa3;
        PK4(s[t][0], 0, pa0); PK4(s[t][0], 8, pa1); PK4(s[t][1], 0, pa2); PK4(s[t][1], 8, pa3);
        const int vb = vb0 + (kt0 + t) * 8192;
        pv_one<0>(o[0], vb, pa0, pa1, pa2, pa3); pv_one<1>(o[1], vb, pa0, pa1, pa2, pa3); }
#undef PK4
}

struct MobaPre { bf16x8 k[4], v[4]; v2u lw; int c0, c1; };
__device__ __forceinline__ void moba_preload(Frame& F, int b, int h, int n, int sub, MobaPre& P) {
    int tid = F.tid; asm volatile("" : "+v"(tid));
    const size_t rowb = (size_t)b * SEQ; const int sr = tid >> 3, sc = (tid & 7) * 8;
    const bf16* Kg = (const bf16*)(F.ws + WS_K); const bf16* Vg = (const bf16*)(F.ws + WS_V);
#pragma unroll
    for (int t = 0; t < 4; ++t) { const size_t go = (rowb + n * 256 + t * 64 + sr) * ATTW + h * HD + sc; P.k[t] = *(const bf16x8*)(Kg + go); P.v[t] = *(const bf16x8*)(Vg + go); }
    const int* rc = (const int*)(F.ws + WS_RCNT) + (((size_t)(b * NH + h) * 16 + n) * 2 + sub) * 2;
    P.c0 = rc[0]; P.c1 = rc[1];
    const int hf = tid >> 8, e0 = (tid & 255) * 4;
    P.lw = *(const v2u*)((const unsigned short*)(F.ws + WS_RLIST) + ((((size_t)(b * NH + h) * 16 + n) * 2 + sub) * 2 + hf) * 1024 + e0);
}
__device__ __forceinline__ void moba_unit(Frame& F, int b, int h, int n, int sub, MobaPre& P) {
    const int tid = F.tid, lane = F.lane, wid = F.wave, r32 = lane & 31, hi = lane >> 5;
    LAS unsigned char* L = F.lds; const size_t rowb = (size_t)b * SEQ;
    LAS float* btab = (LAS float*)(L + LBT); LAS float* wsf = (LAS float*)(L + LWS) + wid * 64;
    LAS unsigned short* list = (LAS unsigned short*)(L + LLIST); LAS int* qctr = (LAS int*)(L + LKM + 64);
    const unsigned short* sel = (const unsigned short*)(F.ws + WS_SEL) + ((size_t)(b * NH + h)) * SEQ;
    __syncthreads();
    const int sr = tid >> 3, sc = (tid & 7) * 8; const int kst = KSWZ64(sr, sc * 2), vst = v_st(sr, sc);
    const int c0 = P.c0, c1 = P.c1;
    { const int hf = tid >> 8, e0 = (tid & 255) * 4; const int ch = hf ? c1 : c0, ob = hf ? c0 : 0; const v2u w = P.lw;
      if (e0 < ch) {
          list[ob + e0] = (unsigned short)(w.x & 0xffffu); if (e0 + 1 < ch) list[ob + e0 + 1] = (unsigned short)(w.x >> 16);
          if (e0 + 2 < ch) list[ob + e0 + 2] = (unsigned short)(w.y & 0xffffu); if (e0 + 3 < ch) list[ob + e0 + 3] = (unsigned short)(w.y >> 16); } }
    const int base = c0 + c1;
#pragma unroll
    for (int t = 0; t < 4; ++t) { *(LAS bf16x8*)(L + LK + t * 8192 + kst) = P.k[t]; *(LAS bf16x8*)(L + LV + t * 8192 + vst) = P.v[t]; }
    if (tid == 0) qctr[0] = 0;
    __syncthreads();
    const int count = base; const int ngroups = (count + 31) >> 5;
    const int nown = owned(n, sub) ? 8 : 0, nitems = nown + ngroups;
    const float b31 = btab[64 + 200];
    const int vb0 = (int)(unsigned)(uintptr_t)(L + LV) + v_rd_base(lane);
    const bf16* Qg = (const bf16*)(F.ws + WS_Q);
    unsigned char* PO8 = (unsigned char*)F.out; float* PL = (float*)(F.ws + WS_PL);
    typedef float f32x2_ __attribute__((ext_vector_type(2)));
    LAS unsigned char* stg = L + LSTG + wid * STG_WAVE;
#define PULL(v) do { int _v = 0; if (lane == 0) _v = __hip_atomic_fetch_add(qctr, 1, __ATOMIC_RELAXED, __HIP_MEMORY_SCOPE_WORKGROUP); v = __builtin_amdgcn_readfirstlane(_v); } while (0)
#define ITEM_ROW(it) (((it) < nown) ? (n * 256 + (7 - (it)) * 32 + r32) : (int)list[(((it) - nown) * 32 + r32) < count ? (((it) - nown) * 32 + r32) : count - 1])
    int cur; PULL(cur);
    bf16x8 qr[4]; int row = 0;
    if (cur < nitems) { row = ITEM_ROW(cur); const bf16* Qw = Qg + (rowb + row) * ATTW + h * HD + hi * 8;
#pragma unroll
        for (int d0 = 0; d0 < 4; ++d0) qr[d0] = *(const bf16x8*)(Qw + d0 * 16); }
    while (cur < nitems) {
        int nxt; PULL(nxt);
        const int rown = ITEM_ROW(nxt < nitems ? nxt : cur);
        const bf16* Qn = Qg + (rowb + rown) * ATTW + h * HD + hi * 8;
        float m_reg = -1e30f, l_reg = 0.f; f32x16 o[2]; o[0] = f32x16{}; o[1] = f32x16{};
        const unsigned msk = sel[row];
        if (cur < nown) {
            const int rg = 7 - cur; const int nkt = (rg >> 1) + 1;
            const size_t pi = ((rowb + row) * NH + h) * 3;
            float lsraw[3];
#pragma unroll
            for (int s = 0; s < 3; ++s) lsraw[s] = PL[pi + s];
            for (int kt = 0; kt < nkt; ++kt) tile_step<true>(L, kt, qr, 0.f, 64 + (rg * 32 + r32) - kt * 64 - 4 * hi, m_reg, l_reg, o, wsf, r32, hi, vb0);
            const int nv = __builtin_popcount(msk);
            const float lse_own = m_reg + __builtin_amdgcn_logf(l_reg);
            float ls[3]; float M = lse_own;
#pragma unroll
            for (int s = 0; s < 3; ++s) { ls[s] = (s < nv) ? lsraw[s] : -1e30f; M = fmaxf(M, ls[s]); }
            float wown = __builtin_amdgcn_exp2f(lse_own - M), ws_[3], W = wown;
#pragma unroll
            for (int s = 0; s < 3; ++s) { ws_[s] = __builtin_amdgcn_exp2f(ls[s] - M); W += ws_[s]; }
            const float rW = __builtin_amdgcn_rcpf(W);
            if (hi == 0) wsf[32 + r32] = wown * rW * __builtin_amdgcn_rcpf(l_reg); LDS_WAIT();
#pragma unroll
            for (int r = 0; r < 16; ++r) { const int orow = crow(r, hi); const float cf = wsf[32 + orow];
                *(LAS bf16*)(stg + orow * STG_ROW + r32 * 2) = (bf16)(pk2(o[0][r] * cf, 0.f) & 0xffffu); *(LAS bf16*)(stg + orow * STG_ROW + 64 + r32 * 2) = (bf16)(pk2(o[1][r] * cf, 0.f) & 0xffffu); }
            LDS_WAIT();
            float acc[32];
            { const LAS v4u* src = (const LAS v4u*)(stg + r32 * STG_ROW + hi * 64);
#pragma unroll
              for (int i = 0; i < 4; ++i) { const v4u w = src[i]; acc[8 * i] = bflo(w.x); acc[8 * i + 1] = bfhi(w.x); acc[8 * i + 2] = bflo(w.y); acc[8 * i + 3] = bfhi(w.y); acc[8 * i + 4] = bflo(w.z); acc[8 * i + 5] = bfhi(w.z); acc[8 * i + 6] = bflo(w.w); acc[8 * i + 7] = bfhi(w.w); } }
#pragma unroll
            for (int s = 0; s < 3; ++s) if (s < nv) { const float cs = ws_[s] * rW * (1.0f / A8_SCALE); const v4u* src = (const v4u*)(PO8 + (pi + s) * 64) + hi * 2;
#pragma unroll
                for (int i = 0; i < 2; ++i) { const v4u w = src[i]; const unsigned ww[4] = {w.x, w.y, w.z, w.w};
#pragma unroll
                    for (int q = 0; q < 4; ++q) { const f32x2_ lo = __builtin_amdgcn_cvt_pk_f32_fp8((int)ww[q], false), hi2 = __builtin_amdgcn_cvt_pk_f32_fp8((int)ww[q], true);
                        acc[16 * i + 4 * q] += cs * lo.x; acc[16 * i + 4 * q + 1] += cs * lo.y; acc[16 * i + 4 * q + 2] += cs * hi2.x; acc[16 * i + 4 * q + 3] += cs * hi2.y; } }
                asm volatile("" ::: "memory"); }
            { v4u* dst = (v4u*)(F.ws + WS_ATT + (rowb + row) * ATTW + h * HD) + hi * 2;
#pragma unroll
              for (int i = 0; i < 2; ++i) { v4u w; const float* a = acc + 16 * i;
                  w.x = pk4_fp8(a[0] * A8_SCALE, a[1] * A8_SCALE, a[2] * A8_SCALE, a[3] * A8_SCALE); w.y = pk4_fp8(a[4] * A8_SCALE, a[5] * A8_SCALE, a[6] * A8_SCALE, a[7] * A8_SCALE);
                  w.z = pk4_fp8(a[8] * A8_SCALE, a[9] * A8_SCALE, a[10] * A8_SCALE, a[11] * A8_SCALE); w.w = pk4_fp8(a[12] * A8_SCALE, a[13] * A8_SCALE, a[14] * A8_SCALE, a[15] * A8_SCALE); dst[i] = w; } }
            LDS_WAIT();
#pragma unroll
            for (int d0 = 0; d0 < 4; ++d0) qr[d0] = *(const bf16x8*)(Qn + d0 * 16);
        } else {
            const bool valid = ((cur - nown) * 32 + r32) < count;
            const bool adj = __any((row >> 8) == n + 1);
            if (adj) { const int ib = 64 + row - n * 256 - 4 * hi;
                tile_pair<true, true, false>(L, 0, qr, 0.f, ib, m_reg, l_reg, o, wsf, r32, hi, vb0, Qn); tile_pair<true, false, true>(L, 2, qr, 0.f, ib - 128, m_reg, l_reg, o, wsf, r32, hi, vb0, Qn); }
            else { tile_pair<false, true, false>(L, 0, qr, b31, 0, m_reg, l_reg, o, wsf, r32, hi, vb0, Qn); tile_pair<false, false, true>(L, 2, qr, b31, 0, m_reg, l_reg, o, wsf, r32, hi, vb0, Qn); }
            if (hi == 0) wsf[32 + r32] = l_reg; LDS_WAIT();
#pragma unroll
            for (int r = 0; r < 16; ++r) { const int orow = crow(r, hi); const float rl = __builtin_amdgcn_rcpf(wsf[32 + orow]);
                *(LAS bf16*)(stg + orow * STG_ROW + r32 * 2) = (bf16)(pk2(o[0][r] * rl, 0.f) & 0xffffu); *(LAS bf16*)(stg + orow * STG_ROW + 64 + r32 * 2) = (bf16)(pk2(o[1][r] * rl, 0.f) & 0xffffu); }
            LDS_WAIT();
            if (valid) {
                const int slot = __builtin_popcount(msk & ((1u << n) - 1u));
                const size_t pi = ((rowb + row) * NH + h) * 3 + slot;
                v4u* dst = (v4u*)(PO8 + pi * 64) + hi * 2; const LAS v4u* src = (const LAS v4u*)(stg + r32 * STG_ROW + hi * 64);
#pragma unroll
                for (int i = 0; i < 2; ++i) { const v4u a = src[2 * i], c = src[2 * i + 1]; v4u w;
                    w.x = pk4_fp8(bflo(a.x) * A8_SCALE, bfhi(a.x) * A8_SCALE, bflo(a.y) * A8_SCALE, bfhi(a.y) * A8_SCALE); w.y = pk4_fp8(bflo(a.z) * A8_SCALE, bfhi(a.z) * A8_SCALE, bflo(a.w) * A8_SCALE, bfhi(a.w) * A8_SCALE);
                    w.z = pk4_fp8(bflo(c.x) * A8_SCALE, bfhi(c.x) * A8_SCALE, bflo(c.y) * A8_SCALE, bfhi(c.y) * A8_SCALE); w.w = pk4_fp8(bflo(c.z) * A8_SCALE, bfhi(c.z) * A8_SCALE, bflo(c.w) * A8_SCALE, bfhi(c.w) * A8_SCALE); dst[i] = w; }
                if (hi == 0) PL[pi] = m_reg + __builtin_amdgcn_logf(l_reg);
            }
            LDS_WAIT();
        }
        cur = nxt; row = rown;
    }
#undef PULL
#undef ITEM_ROW
    asm volatile("" ::: "memory"); __builtin_amdgcn_sched_barrier(0);
    moba_preload(F, b, h, n + 1 < 16 ? n + 1 : 15, sub, P);
}
#undef SBAR
}

namespace ssm {
constexpr int LW = 0, LX = 65536, XSTR = 136, LT = 100352, LT2 = RING_BYTES + 2048;
static_assert(LX + 128 * XSTR * 2 <= LT && LT + 30 * 1024 <= RING_BYTES && LT2 >= TILEE_OFF && LT2 + 2048 <= LDS_BYTES, "SSM LDS map");
__device__ __forceinline__ float gelu_tanh(float x) {
    const float a = 0.7978845608028654f * (x + 0.044715f * x * x * x);
    const float e = __builtin_amdgcn_exp2f(2.0f * LOG2E * a);
    const float th = 1.0f - 2.0f * __builtin_amdgcn_rcpf(1.0f + e);
    return 0.5f * x * (1.0f + th);
}
__device__ __forceinline__ void ssm_unit(Frame& F, int b, int g) {
    const int lane = F.lane, w = F.wave, m = lane & 15, kq = lane >> 4;
    LAS unsigned char* L = F.lds;
    const bf16* Ug = (const bf16*)(F.ws + WS_U); unsigned char* Zg = F.ws + WS_Z;
    const unsigned char* gb = F.ws + WS_SSMTAB + (size_t)g * SSM_GRP_BYTES;
    const bf16x8* Wf = (const bf16x8*)(gb + SSM_W_OFF) + lane; const bf16x8* Sf = (const bf16x8*)(gb + SSM_S_OFF) + lane;
    const size_t rowb = (size_t)b * SEQ;
    bf16x8 A[16];
    { const bf16* up = Ug + (rowb + (size_t)(16 * w + m) * 32 + (kq >> 1)) * SSMW + g * 16 + 8 * (kq & 1);
#pragma unroll
      for (int ks = 0; ks < 16; ++ks) A[ks] = *(const bf16x8*)(up + (size_t)(2 * ks) * SSMW); }
    LAS float* Wl = (LAS float*)(L + LW);
    bf16x8 Bq[16], Bn[16];
#pragma unroll
    for (int ks = 0; ks < 16; ++ks) Bq[ks] = Wf[(ks * 8) * 64];
#define SSM_S1(BC, BN, nt_) do { const int ntn_ = (nt_) + 1 < 8 ? (nt_) + 1 : 7; \
        _Pragma("unroll") for (int ks = 0; ks < 16; ++ks) BN[ks] = Wf[(ks * 8 + ntn_) * 64]; \
        __builtin_amdgcn_sched_barrier(0); \
        pg8::f32x4 acc = {0.f, 0.f, 0.f, 0.f}, ac1 = acc, ac2 = acc, ac3 = acc;     \
        _Pragma("unroll") for (int ks = 0; ks < 16; ks += 4) { acc = __builtin_amdgcn_mfma_f32_16x16x32_bf16(A[ks], BC[ks], acc, 0, 0, 0); ac1 = __builtin_amdgcn_mfma_f32_16x16x32_bf16(A[ks + 1], BC[ks + 1], ac1, 0, 0, 0); \
            ac2 = __builtin_amdgcn_mfma_f32_16x16x32_bf16(A[ks + 2], BC[ks + 2], ac2, 0, 0, 0); ac3 = __builtin_amdgcn_mfma_f32_16x16x32_bf16(A[ks + 3], BC[ks + 3], ac3, 0, 0, 0); } \
        acc = (acc + ac1) + (ac2 + ac3); \
        _Pragma("unroll") for (int r = 0; r < 4; ++r) Wl[(16 * w + 4 * kq + r) * 128 + 16 * (nt_) + m] = acc[r]; } while (0)
#pragma unroll 1
    for (int nt = 0; nt < 8; nt += 2) { SSM_S1(Bq, Bn, nt); SSM_S1(Bn, Bq, nt + 1); }
#undef SSM_S1
    __syncthreads();
    bf16x8 tst[4];
#pragma unroll
    for (int i = 0; i < 4; ++i) tst[i] = *((const bf16x8*)(gb + SSM_T_OFF) + F.tid + 512 * i);
    LAS bf16* Xl = (LAS bf16*)(L + LX);
    if (F.tid < 64) {
        const int p = F.tid; const float* aL = (const float*)(F.ws + WS_SSMAL) + (g * 64 + p) * 2; const float ar = aL[0], ai = aL[1];
        float xr = 0.f, xi = 0.f;
#pragma unroll 8
        for (int c = 0; c < SSM_NCH; ++c) {
            Xl[c * XSTR + p] = (bf16)(pk2(xr, 0.f) & 0xffffu); Xl[c * XSTR + 64 + p] = (bf16)(pk2(xi, 0.f) & 0xffffu);
            const float wr_ = Wl[c * 128 + p], wi_ = Wl[c * 128 + 64 + p];
            const float nr = ar * xr - ai * xi + wr_, ni = ar * xi + ai * xr + wi_; xr = nr; xi = ni;
        }
    }
    bf16x8 Bs[4];
#pragma unroll
    for (int ks = 0; ks < 4; ++ks) Bs[ks] = Sf[(ks * 32) * 64];
#pragma unroll
    for (int i = 0; i < 4; ++i) { const int p = F.tid + 512 * i, e = p >> 6; *(LAS bf16x8*)(L + (e < 30 ? LT + e * 1024 : LT2 + (e - 30) * 1024) + (p & 63) * 16) = tst[i]; }
    __syncthreads();
    bf16x8 Xf[4];
#pragma unroll
    for (int ks = 0; ks < 4; ++ks) Xf[ks] = *(const LAS bf16x8*)(Xl + (16 * w + m) * XSTR + 32 * ks + 8 * kq);
#pragma unroll 1
    for (int par = 0; par < 2; ++par) {
        const bf16x8 zf = {0, 0, 0, 0, 0, 0, 0, 0};
        bf16x8 R[17], Bs1[4];
#pragma unroll
        for (int k = 0; k < 17; ++k) R[k] = zf;
#pragma unroll 1
        for (int tt0 = 0; tt0 < 16; tt0 += 2) {
#pragma unroll
            for (int k = 14; k >= 0; --k) { R[k + 2] = R[k]; asm volatile("" : "+v"(R[k + 2])); }
#pragma unroll
            for (int j4 = 0; j4 < 2; ++j4) { const int e = par + 2 * (tt0 + j4); R[1 - j4] = *(const LAS bf16x8*)(L + (e < 30 ? LT + e * 1024 : LT2 + (e - 30) * 1024) + lane * 16); }
#define SSM_STEP(j4, SC, SN) do { const int tt = tt0 + (j4), t = 2 * tt + par; \
                pg8::f32x4 acc = {0.f, 0.f, 0.f, 0.f}, ac1 = acc, ac2 = acc, ac3 = acc;     \
                { const int tn = tt + 1 < 16 ? t + 2 : (par == 0 ? 1 : 31);     \
                  _Pragma("unroll") for (int ks = 0; ks < 4; ++ks) SN[ks] = Sf[(ks * 32 + tn) * 64]; } \
                __builtin_amdgcn_sched_barrier(0); \
                acc = __builtin_amdgcn_mfma_f32_16x16x32_bf16(Xf[0], SC[0], acc, 0, 0, 0); ac1 = __builtin_amdgcn_mfma_f32_16x16x32_bf16(Xf[1], SC[1], ac1, 0, 0, 0); \
                ac2 = __builtin_amdgcn_mfma_f32_16x16x32_bf16(Xf[2], SC[2], ac2, 0, 0, 0); ac3 = __builtin_amdgcn_mfma_f32_16x16x32_bf16(Xf[3], SC[3], ac3, 0, 0, 0); \
                _Pragma("unroll") for (int ks = 0; ks < 16; ks += 4) if (ks <= tt) { \
                    acc = __builtin_amdgcn_mfma_f32_16x16x32_bf16(A[ks], R[ks + 1 - (j4)], acc, 0, 0, 0); \
                    if (ks + 1 <= tt) ac1 = __builtin_amdgcn_mfma_f32_16x16x32_bf16(A[ks + 1], R[ks + 2 - (j4)], ac1, 0, 0, 0); \
                    if (ks + 2 <= tt) ac2 = __builtin_amdgcn_mfma_f32_16x16x32_bf16(A[ks + 2], R[ks + 3 - (j4)], ac2, 0, 0, 0); \
                    if (ks + 3 <= tt) ac3 = __builtin_amdgcn_mfma_f32_16x16x32_bf16(A[ks + 3], R[ks + 4 - (j4)], ac3, 0, 0, 0); } \
                acc = (acc + ac1) + (ac2 + ac3); \
                _Pragma("unroll") for (int r = 0; r < 4; ++r) { const size_t tok = rowb + (size_t)(16 * w + 4 * kq + r) * 32 + t; const size_t o = tok * SSMW + g * 16 + m; \
                    Zg[o] = (unsigned char)(__builtin_amdgcn_cvt_pk_fp8_f32(clamp8(gelu_tanh(acc[r]) * A8_SCALE), 0.f, 0, false) & 0xff); } } while (0)
            SSM_STEP(0, Bs, Bs1); SSM_STEP(1, Bs1, Bs);
#undef SSM_STEP
        }
    }
    __syncthreads();
}
}

__device__ __forceinline__ void p3a_select_ssm(Frame& F) {
    const int bh = F.vcu >> 1;
    att::select_rows(F, bh >> 3, bh & 7, F.vcu & 1);
    ssm::ssm_unit(F, F.vcu >> 4, F.vcu & 15);
}
__device__ __forceinline__ void p3b_moba(Frame& F) {
    const int bh = F.vcu >> 1, sub = F.vcu & 1;
    { LAS float* btab = (LAS float*)(F.lds + att::LBT); const float* bt = (const float*)(F.ws + WS_BTAB) + (bh & 7) * 576; for (int i = F.tid; i < 576; i += 512) btab[i] = bt[i]; }
    att::MobaPre P; att::moba_preload(F, bh >> 3, bh & 7, 0, sub, P);
#pragma unroll 1
    for (int n = 0; n < 16; ++n) att::moba_unit(F, bh >> 3, bh & 7, n, sub, P);
}

__device__ __forceinline__ void p7_rows(Frame& F) {
    const int gw = F.vcu * NWAVES + F.wave; const int row0 = gw * 32, b = row0 >> 12;
    const float* mod = (const float*)(F.ws + WS_MOD) + b * 6144;
    f32x4 A1[4], A2[4], A3[4];
#pragma unroll
    for (int j = 0; j < 4; ++j) { const int c = 4 * F.lane + 256 * j;
        A1[j] = *(const f32x4*)(mod + 2048 + c) * *(const f32x4*)(F.in[I_GPOSTMIX] + c);
        A2[j] = *(const f32x4*)(F.in[I_GPREFFN] + c) * (*(const f32x4*)(mod + 4096 + c) + 1.0f);
        A3[j] = *(const f32x4*)(mod + 3072 + c); }
    const bf16* YM = (const bf16*)(F.ws + WS_YMIX); const float* ssq = (const float*)(F.ws + WS_SSQ);
    f32x4 nx[4]; unsigned ny[4]; float nq;
    { const f32x4* xr = (const f32x4*)(F.in[I_X] + (size_t)row0 * 1024) + F.lane; const unsigned* yr = (const unsigned*)((const unsigned char*)YM + (size_t)row0 * 2048) + F.lane;
#pragma unroll
      for (int j = 0; j < 4; ++j) { nx[j] = __builtin_nontemporal_load(xr + 64 * j); ny[j] = __builtin_nontemporal_load(yr + 64 * j); }
      nq = ssq[(size_t)row0 * 16 + (F.lane & 15)]; }
    for (int r = 0; r < 32; ++r) {
        const size_t row = (size_t)(row0 + r);
        f32x4 xv[4]; unsigned yv[4]; float q = nq;
#pragma unroll
        for (int j = 0; j < 4; ++j) { xv[j] = nx[j]; yv[j] = ny[j]; }
        { const size_t rn = row + (r < 31 ? 1 : 0);
          const f32x4* xr = (const f32x4*)(F.in[I_X] + rn * 1024) + F.lane; const unsigned* yr = (const unsigned*)((const unsigned char*)YM + rn * 2048) + F.lane;
#pragma unroll
          for (int j = 0; j < 4; ++j) { nx[j] = __builtin_nontemporal_load(xr + 64 * j); ny[j] = __builtin_nontemporal_load(yr + 64 * j); }
          nq = ssq[rn * 16 + (F.lane & 15)]; }
        q += __shfl_xor(q, 1); q += __shfl_xor(q, 2); q += __shfl_xor(q, 4); q += __shfl_xor(q, 8);
        const float rstd1 = rsqrtf(q * (1.0f / 1024.0f) + RMS_EPS) * 0.125f;
        v2u* xo = (v2u*)(row < (size_t)X1_SPLIT ? F.ws + WS_X1A + row * 2048 : F.ws + WS_X1B + (row - X1_SPLIT) * 2048) + F.lane;
        f32x4 v[4]; float s = 0.f;
#pragma unroll
        for (int j = 0; j < 4; ++j) { const pg8::f32x2_ ylo = __builtin_amdgcn_cvt_pk_f32_fp8((int)yv[j], false), yhi = __builtin_amdgcn_cvt_pk_f32_fp8((int)yv[j], true); const f32x4 y = {ylo.x, ylo.y, yhi.x, yhi.y};
            v[j] = xv[j] + A1[j] * (y * rstd1); { v2u xw; xw.x = pk2(v[j].x, v[j].y); xw.y = pk2(v[j].z, v[j].w); xo[64 * j] = xw; }
            s += (v[j].x * v[j].x + v[j].y * v[j].y) + (v[j].z * v[j].z + v[j].w * v[j].w); }
        const float rstd2 = rsqrtf(wave_sum(s) * (1.0f / 1024.0f) + RMS_EPS);
        unsigned* o8 = (unsigned*)(F.ws + WS_H2F8 + row * 1024) + F.lane;
        if (F.lane == 0) ((LAS float*)(F.lds + 122880))[F.wave * 32 + r] = rstd2;
#pragma unroll
        for (int j = 0; j < 4; ++j) { const f32x4 hs = (v[j] * rstd2 * A2[j] + A3[j]) * A8_SCALE; o8[64 * j] = pk4_fp8(hs.x, hs.y, hs.z, hs.w); }
    }
}

__device__ __forceinline__ void p8_router(Frame& F) {
    LAS unsigned char* L = F.lds;
    const int b = (F.vcu * 256) >> 12;
    LAS float* cb = (LAS float*)(L + 123904);
    { const v4u* src = (const v4u*)(F.ws + WS_ROUTW + (size_t)b * 98304); LAS v4u* dst = (LAS v4u*)L; for (int i = F.tid; i < 6144; i += 512) dst[i] = src[i];
      if (F.tid < 48) cb[F.tid] = ((const float*)(F.ws + WS_ROUTC))[b * 48 + F.tid]; }
    __syncthreads();
    const int lane = F.lane, m = lane & 15, kq = lane >> 4;
    LAS float* lg = (LAS float*)(L + 98304 + F.wave * 3072);
    const LAS float* rs2 = (const LAS float*)(L + 122880) + F.wave * 32;
    int* list = (int*)(F.ws + WS_LIST); float* wgt = (float*)(F.ws + WS_WGT);
    const int gw = F.vcu * NWAVES + F.wave;
    for (int tile = gw * 2; tile < gw * 2 + 2; ++tile) {
        const size_t arow = (size_t)(tile * 16 + m);
        const bf16* ap = (const bf16*)(arow < (size_t)X1_SPLIT ? F.ws + WS_X1A + arow * 2048 : F.ws + WS_X1B + (arow - X1_SPLIT) * 2048) + 8 * kq;
        pg8::f32x4 a0 = {0.f, 0.f, 0.f, 0.f}, a1 = a0, a2 = a0;
#pragma unroll 8
        for (int ks = 0; ks < 32; ++ks) { const bf16x8 av = *(const bf16x8*)(ap + 32 * ks);
            const LAS bf16x8* bp = (const LAS bf16x8*)L + (ks * 3) * 64 + lane;
            a0 = __builtin_amdgcn_mfma_f32_16x16x32_bf16(av, bp[0], a0, 0, 0, 0);
            a1 = __builtin_amdgcn_mfma_f32_16x16x32_bf16(av, bp[64], a1, 0, 0, 0);
            a2 = __builtin_amdgcn_mfma_f32_16x16x32_bf16(av, bp[128], a2, 0, 0, 0); }
#pragma unroll
        for (int r = 0; r < 4; ++r) { lg[(4 * kq + r) * 48 + m] = a0[r]; lg[(4 * kq + r) * 48 + 16 + m] = a1[r]; lg[(4 * kq + r) * 48 + 32 + m] = a2[r]; }
        LDS_WAIT(); asm volatile("" ::: "memory");
        if (lane < 16) {
            const LAS float* q = lg + lane * 48; const int tok = tile * 16 + lane; const float r2 = rs2[(tile & 1) * 16 + lane];
            float gl[4]; int gi = 0; float gm;
#pragma unroll
            for (int i = 0; i < 4; ++i) gl[i] = q[i] * r2 + cb[i];
            gm = gl[0];
#pragma unroll
            for (int i = 1; i < 4; ++i) if (gl[i] > gm) { gm = gl[i]; gi = i; }
            float gs = 0.f;
#pragma unroll
            for (int i = 0; i < 4; ++i) gs += __expf(gl[i] - gm);
            const float gp = 1.0f / gs;
            float e1 = -3.0e38f, e2 = -3.0e38f; int i1 = 0, i2 = 0;
#pragma unroll
            for (int i = 0; i < 8; ++i) { const float v = q[4 + gi * 8 + i] * r2 + cb[4 + gi * 8 + i];
                if (v > e1) { e2 = e1; i2 = i1; e1 = v; i1 = i; } else if (v > e2) { e2 = v; i2 = i; } }
            const float t = __expf(e2 - e1), w1 = gp / (1.0f + t), w2 = gp * t / (1.0f + t);
            const int x1 = gi * 8 + i1, x2 = gi * 8 + i2;
            const int p1 = (int)__hip_atomic_fetch_add(F.ctl + CW_CNT + 64 * x1, 1u, RLX_AGENT);
            const int p2 = (int)__hip_atomic_fetch_add(F.ctl + CW_CNT + 64 * x2, 1u, RLX_AGENT);
            list[(size_t)x1 * NTOK + p1] = tok * 2; list[(size_t)x2 * NTOK + p2] = tok * 2 + 1;
            wgt[tok * 2] = w1; wgt[tok * 2 + 1] = w2;
        }
        LDS_WAIT(); asm volatile("" ::: "memory");
    }
}

__device__ __forceinline__ int moe_layout(Frame& F) {
    LAS int* te = (LAS int*)(F.lds + TILEE_OFF);
    if (F.tid == 0) { int start = 0;
        for (int e = 0; e < NEXP; ++e) { const int c = (int)__hip_atomic_load(F.ctl + CW_CNT + 64 * e, RLX_AGENT); const int nt = (c + MOEB - 1) / MOEB;
            te[600 + e] = start * MOEB; te[640 + e] = c; for (int t = 0; t < nt; ++t) te[start + t] = e; start += nt; }
        te[600 + NEXP] = start * MOEB; }
    __syncthreads();
    return te[600 + NEXP] / MOEB;
}

__device__ __forceinline__ void moe_rowmap(Frame& F, int ntiles) {
    LAS int* te = (LAS int*)(F.lds + TILEE_OFF);
    const int nrows = ntiles * MOEB;
    const int* list = (const int*)(F.ws + WS_LIST); const float* wgt = (const float*)(F.ws + WS_WGT); int* rowmap = (int*)(F.ws + WS_ROWMAP); float* rw = (float*)(F.ws + WS_RW);
    for (int r = F.vcu * 512 + F.tid; r < nrows; r += F.G * 512) {
        const int e = te[r >> 8]; const int i = r - te[600 + e];
        if (i < te[640 + e]) { const int tk = list[(size_t)e * NTOK + i]; rowmap[tk] = r; rw[r] = wgt[tk]; } else rw[r] = 0.f;
    }
}

__device__ __forceinline__ void p12_combine(Frame& F) {
    const int gw = F.vcu * NWAVES + F.wave; const int row0 = gw * 32, b = row0 >> 12;
    const float* mod = (const float*)(F.ws + WS_MOD) + b * 6144;
    f32x4 A1[4];
#pragma unroll
    for (int j = 0; j < 4; ++j) { const int c = 4 * F.lane + 256 * j; A1[j] = *(const f32x4*)(mod + 5120 + c) * *(const f32x4*)(F.in[I_GPOSTFFN] + c); }
    const unsigned char* YR = F.ws + WS_XS; const int* rowmap = (const int*)(F.ws + WS_ROWMAP);
    typedef float f32x2_ __attribute__((ext_vector_type(2)));
    const int myrm = rowmap[(size_t)row0 * 2 + F.lane];
    unsigned na[4], nc[4]; v2u nxw[4];
#define CMB_LOAD(r_) do { const int r0_ = __shfl(myrm, 2 * (r_)), r1_ = __shfl(myrm, 2 * (r_) + 1); const size_t rw_ = (size_t)(row0 + (r_)); \
        const unsigned* y0_ = (const unsigned*)(YR + (size_t)r0_ * 1024) + F.lane; const unsigned* y1_ = (const unsigned*)(YR + (size_t)r1_ * 1024) + F.lane; \
        const v2u* xi_ = (const v2u*)(rw_ < (size_t)X1_SPLIT ? F.ws + WS_X1A + rw_ * 2048 : F.ws + WS_X1B + (rw_ - X1_SPLIT) * 2048) + F.lane; \
        _Pragma("unroll") for (int j = 0; j < 4; ++j) { na[j] = __builtin_nontemporal_load(y0_ + 64 * j); nc[j] = __builtin_nontemporal_load(y1_ + 64 * j); nxw[j] = __builtin_nontemporal_load(xi_ + 64 * j); } } while (0)
    CMB_LOAD(0);
    for (int r = 0; r < 32; ++r) {
        const size_t row = (size_t)(row0 + r);
        unsigned ca[4], cc[4]; v2u cx[4];
#pragma unroll
        for (int j = 0; j < 4; ++j) { ca[j] = na[j]; cc[j] = nc[j]; cx[j] = nxw[j]; }
        { const int rn = r < 31 ? r + 1 : r; CMB_LOAD(rn); }
        f32x4 f[4]; float s = 0.f;
#pragma unroll
        for (int j = 0; j < 4; ++j) { const int a = (int)ca[j], c = (int)cc[j];
            const f32x2_ al = __builtin_amdgcn_cvt_pk_f32_fp8(a, false), ah = __builtin_amdgcn_cvt_pk_f32_fp8(a, true), cl = __builtin_amdgcn_cvt_pk_f32_fp8(c, false), ch = __builtin_amdgcn_cvt_pk_f32_fp8(c, true);
            f[j] = (f32x4){al.x + cl.x, al.y + cl.y, ah.x + ch.x, ah.y + ch.y} * (1.0f / 256.0f);
            s += (f[j].x * f[j].x + f[j].y * f[j].y) + (f[j].z * f[j].z + f[j].w * f[j].w); }
        const float rstd = rsqrtf(wave_sum(s) * (1.0f / 1024.0f) + RMS_EPS);
        f32x4* xo = (f32x4*)(F.out + row * 1024) + F.lane;
#pragma unroll
        for (int j = 0; j < 4; ++j) { const v2u xw = cx[j]; const f32x4 x1 = {bflo(xw.x), bfhi(xw.x), bflo(xw.y), bfhi(xw.y)}; xo[64 * j] = x1 + A1[j] * (f[j] * rstd); }
    }
#undef CMB_LOAD
}

struct Args { const float* in[29]; float* out; unsigned char* ws; int ph_lo, ph_hi; };
#if defined(SPLIT5)
constexpr int N_PHASES = 10;
#else
constexpr int N_PHASES = 9;
#endif
#ifndef MK_N_LAUNCHES
#define MK_N_LAUNCHES 1
#endif

__global__ void __launch_bounds__(NWAVES * 64, 2) layer_fwd(Args args) {
    extern __shared__ __attribute__((aligned(16))) unsigned char lds[];
    Frame F;
    F.lds = (LAS unsigned char*)lds; F.MISC = (volatile LAS unsigned*)(F.lds + MISC_OFF);
    F.tid = threadIdx.x; F.lane = F.tid & 63; F.wave = __builtin_amdgcn_readfirstlane(F.tid >> 6);
    F.G = gridDim.x; { const int bx = blockIdx.x; F.vcu = (F.G % 8 == 0) ? (bx % 8) * (F.G / 8) + bx / 8 : bx; }
    F.ws = args.ws; F.ctl = (gu32*)(args.ws + WS_CTL); F.out = args.out;
#pragma unroll
    for (int i = 0; i < 29; ++i) F.in[i] = args.in[i];
    for (int u = F.tid; u < (LDS_BYTES - LDSCTL_OFF) / 4; u += NWAVES * 64) ((LAS unsigned*)(F.lds + LDSCTL_OFF))[u] = 0u;
    __syncthreads();
    XcdBarrier bar; bar.bar = (unsigned*)(F.ctl + CW_BAR); bar.x = 0; bar.st = nullptr;
    if (MK_N_LAUNCHES == 1) bar = xcd_barrier_post((unsigned*)(F.ctl + CW_BAR), F.MISC + 8);
    const int lo = args.ph_lo, hi = args.ph_hi;
#ifndef ONLYP
#define ONLYP -1
#endif
#define IN(k) ((ONLYP < 0 || ONLYP == (k)) && lo <= (k) && (k) < hi)
#define SEAM(k) do { if (IN(k) && IN((k) + 1)) xcd_barrier(bar); } while (0)
#define REFRESH() do { int t_ = threadIdx.x; asm volatile("" : "+v"(t_)); F.tid = t_; F.lane = t_ & 63; F.wave = __builtin_amdgcn_readfirstlane(t_ >> 6); } while (0)
    bf16* const RA = (bf16*)(F.ws + WS_RA); bf16* const RB = (bf16*)(F.ws + WS_RB);

    if (IN(0)) { REFRESH(); p0_mod(F); } SEAM(0);
    if (IN(1)) { REFRESH(); p1_xn(F); p0_tables(F); p0_weights(F, 0, WI_EXPERT); } SEAM(1);
    if (IN(2)) { REFRESH();
        pg8::Gemm g{RA, (const bf16*)(F.ws + WS_WIN), NTOK, NPROJ, DM / 2}; pg8::StaticOrder S; S.init(NTOK, NPROJ, F.G, (int)blockIdx.x);
        pg8::EpiProj E{(bf16*)(F.ws + WS_Q), (bf16*)(F.ws + WS_K), (bf16*)(F.ws + WS_V), (bf16*)(F.ws + WS_U), (bf16*)(F.ws + WS_GA), (bf16*)(F.ws + WS_GS), (float*)(F.ws + WS_KPART)};
        pg8::gemm_phase<pg8::EpiProj, pg8::StaticOrder, true, true, true>(F.lds, g, S, E, A8_E8, W8_E8);
    } SEAM(2);
    if (IN(3)) { REFRESH(); p3a_select_ssm(F); } SEAM(3);
    if (IN(4)) { REFRESH(); p3b_moba(F); } SEAM(4);
    if (IN(5)) { REFRESH();
        const int pm = F.vcu;
        if ((pm & 1) == 0) { p0_weights(F, WI_EXPERT, WI_END); VM_WAIT(); __syncthreads(); REFRESH(); }
        { pg8::Gemm g{(const bf16*)(F.ws + WS_Z), (const bf16*)(F.ws + WS_WGLU), NTOK, 2048, SSMW / 2}; pg8::PanelOrder S{pm, 8, pm & 7};
          pg8::EpiGlu E{(const bf16*)(F.ws + WS_GS), RA};
          pg8::gemm_phase<pg8::EpiGlu, pg8::PanelOrder, true, true, true>(F.lds, g, S, E, A8_E8, W8_E8); }
        VM_WAIT(); __syncthreads();
        { pg8::Gemm g{(const bf16*)(F.ws + WS_ATT), (const bf16*)(F.ws + WS_WO), NTOK, DM, ATTW / 2}; pg8::PanelOrder S{pm, 4, pm & 3};
          pg8::EpiAttOut E{F.ws + WS_GA, F.ws + WS_GS, RA, (unsigned char*)RB};
          pg8::gemm_phase<pg8::EpiAttOut, pg8::PanelOrder, true, true, true>(F.lds, g, S, E, A8_E8, W8_E8); }
        VM_WAIT(); __syncthreads();
        { pg8::Gemm g{RB, (const bf16*)(F.ws + WS_WMIX), NTOK, DM, DM / 2}; pg8::PanelOrder S{pm, 4, pm & 3};
          pg8::EpiMix E{(bf16*)(F.ws + WS_YMIX), (float*)(F.ws + WS_SSQ)};
          pg8::gemm_phase<pg8::EpiMix, pg8::PanelOrder, true, true, true>(F.lds, g, S, E, A8_E8, W8_E8); }
        VM_WAIT(); __syncthreads();
        REFRESH(); p7_rows(F);
        VM_WAIT(); __syncthreads();
#if !defined(SPLIT5)
        REFRESH(); p8_router(F);
        if ((F.vcu & 1) != 0) { REFRESH(); p0_weights(F, WI_EXPERT, WI_END); }
    } SEAM(5);
#else
        if ((F.vcu & 1) != 0) { REFRESH(); p0_weights(F, WI_EXPERT, WI_END); }
    } SEAM(5);
    if (IN(9)) { REFRESH(); p8_router(F); } if (IN(9) && IN(6)) xcd_barrier(bar);
#endif
    if (IN(6)) { REFRESH();
        const int ntiles = moe_layout(F);
        moe_rowmap(F, ntiles);
        pg8::Gemm g{(const bf16*)(F.ws + WS_H2F8), (const bf16*)(F.ws + WS_WGU), ntiles * MOEB, DM, DM / 2};
        pg8::MoeOrder S{(const LAS int*)(F.lds + TILEE_OFF), (const int*)(F.ws + WS_LIST), ntiles, F.G, F.vcu};
        pg8::EpiMoe1 E{(unsigned char*)RA};
        pg8::gemm_phase_g<pg8::EpiMoe1, pg8::MoeOrder, true>(F.lds, g, S, E, A8_E8, W8_E8);
    } SEAM(6);
    if (IN(7)) { REFRESH();
        const int ntiles = moe_layout(F);
        pg8::Gemm g{RA, (const bf16*)(F.ws + WS_WDN), ntiles * MOEB, DM, DEXP / 2};
        pg8::MoeOrder S{(const LAS int*)(F.lds + TILEE_OFF), (const int*)(F.ws + WS_LIST), ntiles, F.G, F.vcu};
        pg8::EpiMoe2 E{F.ws + WS_XS, (const float*)(F.ws + WS_RW)};
        pg8::gemm_phase<pg8::EpiMoe2, pg8::MoeOrder, true, true, true>(F.lds, g, S, E, 124, W8_E8);
    } SEAM(7);
    if (IN(8)) { REFRESH(); p12_combine(F); }
#undef IN
#undef SEAM
}

extern "C" void kernel_launch(void* const* d_in, const int* in_sizes, int n_in, void* d_out, int out_size, void* d_ws, size_t ws_size, hipStream_t stream) {
    static int grid = 0;
    if (grid == 0) {
        if (n_in != 29 || in_sizes[0] != NTOK * DM || out_size != NTOK * DM || ws_size < WS_END) {
            fprintf(stderr, "kernel_launch: unexpected problem (n_in %d, in0 %d, out %d, ws %zu); nothing launched\n", n_in, n_in > 0 ? in_sizes[0] : -1, out_size, ws_size); grid = -1; return; }
        int dev = 0, cus = 0, per_cu = 0;
        if (hipGetDevice(&dev) != hipSuccess || hipDeviceGetAttribute(&cus, hipDeviceAttributeMultiprocessorCount, dev) != hipSuccess) { grid = -1; return; }
        if (hipFuncSetAttribute((const void*)layer_fwd, hipFuncAttributeMaxDynamicSharedMemorySize, LDS_BYTES) != hipSuccess) { fprintf(stderr, "kernel_launch: hipFuncSetAttribute failed\n"); grid = -1; return; }
        if (hipOccupancyMaxActiveBlocksPerMultiprocessor(&per_cu, (const void*)layer_fwd, NWAVES * 64, LDS_BYTES) != hipSuccess || per_cu < 1) fprintf(stderr, "kernel_launch: occupancy query says %d\n", per_cu);
        (void)hipGetLastError();
        grid = cus;
        if (grid != 256) { fprintf(stderr, "kernel_launch: this kernel is built for a 256-CU device (got %d)\n", grid); grid = -1; return; }
    }
    if (grid < 0) return;
    (void)hipMemsetAsync((char*)d_ws + WS_CTL, 0, CTL_ZERO_BYTES, stream);
    Args a{};
    for (int i = 0; i < 29; ++i) a.in[i] = (const float*)d_in[i];
    a.out = (float*)d_out; a.ws = (unsigned char*)d_ws;
#if MK_N_LAUNCHES == 1
    void* kargs[] = {&a};
#if defined(PROBE_A)
    a.ph_lo = 0; a.ph_hi = PROBE_A;
    (void)hipLaunchCooperativeKernel((const void*)layer_fwd, dim3(grid), dim3(NWAVES * 64), kargs, LDS_BYTES, stream);
    (void)hipMemsetAsync((char*)d_ws + WS_CTL + CW_BAR * 4, 0, XCD_BAR_WORDS * 4, stream);
    a.ph_lo = PROBE_B; a.ph_hi = N_PHASES;
    (void)hipLaunchCooperativeKernel((const void*)layer_fwd, dim3(grid), dim3(NWAVES * 64), kargs, LDS_BYTES, stream);
#else
    a.ph_lo = 0; a.ph_hi = N_PHASES;
    hipError_t e = hipLaunchCooperativeKernel((const void*)layer_fwd, dim3(grid), dim3(NWAVES * 64), kargs, LDS_BYTES, stream);
    if (e != hipSuccess) fprintf(stderr, "kernel_launch: cooperative launch failed: %s\n", hipGetErrorString(e));
#endif
#else
    for (int p = 0; p < N_PHASES; ++p) { a.ph_lo = p; a.ph_hi = p + 1; hipLaunchKernelGGL(layer_fwd, dim3(grid), dim3(NWAVES * 64), LDS_BYTES, stream, a); }
#endif
}
```

```cpp
#include <hip/hip_runtime.h>
#include <cstdio>
#include <cstdint>
#include <cmath>
namespace pg8 {
#define PG8_LAS __attribute__((address_space(3)))
typedef unsigned short bf16_t;
typedef short bf16x8 __attribute__((ext_vector_type(8)));
typedef float f32x4 __attribute__((ext_vector_type(4)));
typedef unsigned u32x4 __attribute__((ext_vector_type(4)));
typedef int i32x4 __attribute__((ext_vector_type(4)));
typedef int i32x8 __attribute__((ext_vector_type(8)));
constexpr int BM = 256, BK = 64, HALF = 128, HTB = HALF * BK * 2  , STAGE_BYTES = 8 * HTB, NXCD = 8, WGM = 8;

__host__ __device__ __forceinline__ int lds_byte(int r, int c) { const int st = (r >> 4) * 2 + (c >> 5), rr = r & 15, cc = c & 31, ob = rr * 64 + cc * 2; return st * 1024 + (ob ^ (((ob >> 9) & 1) << 5)); }
__host__ __device__ __forceinline__ void stage_rc(int b, int& R, int& C) { const int st = b / 1024, sb = b % 1024, swz = sb ^ (((sb >> 9) & 1) << 5); R = (st >> 1) * 16 + swz / 64; C = (st & 1) * 32 + (swz % 64) / 2; }
__host__ __device__ __forceinline__ int perm32(int rho) { const int n = rho >> 4, i = rho & 15; return 8 * (i >> 2) + 4 * n + (i & 3); }

struct Unit { int pm, pn; };
struct Gemm { const bf16_t* A; const bf16_t* Bt; int M, N, K; };

struct StaticOrder {
    int nM, nN, nwg, G, c;
    __host__ __device__ void init(int M, int N, int G_, int c_) { nM = M / BM; nN = N / BM; nwg = nM * nN; G = G_; c = c_; }
    __host__ __device__ bool next(int i, Unit& u) const {
        const long L = (long)i * G + c; if (L >= nwg) return false;
        int wgid = (int)L; { const int q = nwg / NXCD, r = nwg % NXCD, xcd = wgid % NXCD, off = wgid / NXCD; wgid = (xcd < r ? xcd * (q + 1) : r * (q + 1) + (xcd - r) * q) + off; }
        const int nig = WGM * nN, gid = wgid / nig, fm = gid * WGM, gsz = (nM - fm) < WGM ? (nM - fm) : WGM;
        u.pm = fm + ((wgid % nig) % gsz); u.pn = (wgid % nig) / gsz; return true;
    }
    __device__ __forceinline__ void a_ready(const Unit&) const {}
    __device__ __forceinline__ void done(const Unit&) const {}
};

__device__ __forceinline__ unsigned cvt_pk_bf16(float lo, float hi) { unsigned r; asm volatile("v_cvt_pk_bf16_f32 %0, %1, %2" : "=v"(r) : "v"(lo), "v"(hi)); return r; }
typedef unsigned u32x2 __attribute__((ext_vector_type(2)));
__device__ __forceinline__ float bf_lo(unsigned w) { return __uint_as_float(w << 16); }
__device__ __forceinline__ float bf_hi(unsigned w) { return __uint_as_float(w & 0xffff0000u); }
__device__ __forceinline__ float sigmoidf_(float x) { return __builtin_amdgcn_rcpf(1.0f + __builtin_amdgcn_exp2f(-1.4426950408889634f * x)); }

typedef float f32x2_ __attribute__((ext_vector_type(2)));
__device__ __forceinline__ unsigned sig_u8x4(const f32x4 v) {
    const f32x2_ ya = (f32x2_){v[0], v[1]} * -1.4426950408889634f, yb = (f32x2_){v[2], v[3]} * -1.4426950408889634f;
    const f32x2_ da = (f32x2_){__builtin_amdgcn_exp2f(ya.x), __builtin_amdgcn_exp2f(ya.y)} + 1.0f, db = (f32x2_){__builtin_amdgcn_exp2f(yb.x), __builtin_amdgcn_exp2f(yb.y)} + 1.0f;
    const f32x2_ qa = (f32x2_){__builtin_amdgcn_rcpf(da.x), __builtin_amdgcn_rcpf(da.y)} * 255.0f + 8388608.0f, qb = (f32x2_){__builtin_amdgcn_rcpf(db.x), __builtin_amdgcn_rcpf(db.y)} * 255.0f + 8388608.0f;
    unsigned t01, t23, w;
    asm("v_perm_b32 %0, %1, %2, %3" : "=v"(t01) : "v"(qa.y), "v"(qa.x), "s"(0x0c0c0400u));
    asm("v_perm_b32 %0, %1, %2, %3" : "=v"(t23) : "v"(qb.y), "v"(qb.x), "s"(0x0c0c0400u));
    asm("v_perm_b32 %0, %1, %2, %3" : "=v"(w) : "v"(t23), "v"(t01), "s"(0x05040100u));
    return w;
}
__device__ __forceinline__ f32x2_ vsig2(const f32x2_ v, const f32x2_ g) {
    const f32x2_ y = g * -1.4426950408889634f;
    const f32x2_ d = (f32x2_){__builtin_amdgcn_exp2f(y.x), __builtin_amdgcn_exp2f(y.y)} + 1.0f;
    return v * (f32x2_){__builtin_amdgcn_rcpf(d.x), __builtin_amdgcn_rcpf(d.y)};
}
constexpr float QSCALE = 0.125f * 1.4426950408889634f;

struct EpiProj {
    static constexpr bool PERM = true, AFTER_DRAIN = false;
    bf16_t *Q, *K, *V, *U, *GA, *GS; float* kpart;
    __device__ __forceinline__ void operator()(const f32x4 (&acc)[2][2][4][2], const Unit& u, int wr, int wc, int fr, int fq) const {
        const int pn = u.pn; const int row0 = u.pm * BM + wr * 64 + fr;
        bf16_t* base; int ld, colt, mode;
        if (pn < 2) { base = Q; ld = 512; colt = pn * 256; mode = 1; }
        else if (pn < 4) { base = K; ld = 512; colt = (pn - 2) * 256; mode = 0; }
        else if (pn < 6) { base = V; ld = 512; colt = (pn - 4) * 256; mode = 0; }
        else if (pn == 6) { base = U; ld = 256; colt = 0; mode = 0; }
        else if (pn < 11) { base = GA; ld = 1024; colt = (pn - 7) * 256; mode = 2; }
        else { base = GS; ld = 1024; colt = (pn - 11) * 256; mode = 2; }
        const int col0 = colt + wc * 32 + 8 * fq;
#pragma unroll
        for (int ai = 0; ai < 2; ++ai)
#pragma unroll
            for (int m = 0; m < 4; ++m) { bf16_t* rowp = base + (size_t)(row0 + ai * HALF + m * 16) * ld + col0;
#pragma unroll
                for (int bj = 0; bj < 2; ++bj) { f32x4 v0 = acc[ai][bj][m][0], v1 = acc[ai][bj][m][1];
                    if (mode == 2) {
                        u32x2 w; w.x = sig_u8x4(v0); w.y = sig_u8x4(v1);
                        *(u32x2*)((unsigned char*)base + (size_t)(row0 + ai * HALF + m * 16) * 1024 + col0 + bj * HALF) = w;
                    } else {
                        if (mode == 1) { v0 = v0 * QSCALE; v1 = v1 * QSCALE; }
                        u32x4 w; w.x = cvt_pk_bf16(v0[0], v0[1]); w.y = cvt_pk_bf16(v0[2], v0[3]); w.z = cvt_pk_bf16(v1[0], v1[1]); w.w = cvt_pk_bf16(v1[2], v1[3]);
                        *(u32x4*)(rowp + bj * HALF) = w; } } }
        if (pn == 2 || pn == 3) {
#pragma unroll
            for (int bj = 0; bj < 2; ++bj)
#pragma unroll
                for (int n = 0; n < 2; ++n) { f32x4 s = (f32x4){0.f, 0.f, 0.f, 0.f};
#pragma unroll
                    for (int ai = 0; ai < 2; ++ai)
#pragma unroll
                        for (int m = 0; m < 4; ++m) s += acc[ai][bj][m][n];
#pragma unroll
                    for (int i = 0; i < 4; ++i) { float t = s[i]; t += __shfl_xor(t, 1); t += __shfl_xor(t, 2); t += __shfl_xor(t, 4); t += __shfl_xor(t, 8); s[i] = t; }
                    if (fr == 0) *(f32x4*)(kpart + (size_t)(u.pm * 2 + wr) * 512 + (pn - 2) * 256 + bj * HALF + wc * 32 + 8 * fq + 4 * n) = s; }
        }
    }
};

struct EpiGlu {
    static constexpr bool PERM = true, AFTER_DRAIN = false;
    const bf16_t* GS; bf16_t* SG;
    __device__ __forceinline__ void operator()(const f32x4 (&acc)[2][2][4][2], const Unit& u, int wr, int wc, int fr, int fq) const {
        const int row0 = u.pm * BM + wr * 64 + fr; const int col0 = u.pn * 128 + wc * 32 + 8 * fq;
#pragma unroll
        for (int ai = 0; ai < 2; ++ai)
#pragma unroll
            for (int m = 0; m < 4; ++m) { const size_t ro = (size_t)(row0 + ai * HALF + m * 16) * 1024 + col0;
                const f32x4 v0 = acc[ai][0][m][0], v1 = acc[ai][0][m][1], g0 = acc[ai][1][m][0], g1 = acc[ai][1][m][1];
                u32x2 w;
                { const f32x2_ a = vsig2((f32x2_){v0[0], v0[1]}, (f32x2_){g0[0], g0[1]}) * 16.0f, b = vsig2((f32x2_){v0[2], v0[3]}, (f32x2_){g0[2], g0[3]}) * 16.0f;
                  const f32x2_ c = vsig2((f32x2_){v1[0], v1[1]}, (f32x2_){g1[0], g1[1]}) * 16.0f, d = vsig2((f32x2_){v1[2], v1[3]}, (f32x2_){g1[2], g1[3]}) * 16.0f;
                  int t = __builtin_amdgcn_cvt_pk_fp8_f32(__builtin_amdgcn_fmed3f(a.x, -440.f, 440.f), __builtin_amdgcn_fmed3f(a.y, -440.f, 440.f), 0, false);
                  t = __builtin_amdgcn_cvt_pk_fp8_f32(__builtin_amdgcn_fmed3f(b.x, -440.f, 440.f), __builtin_amdgcn_fmed3f(b.y, -440.f, 440.f), t, true); w.x = (unsigned)t;
                  t = __builtin_amdgcn_cvt_pk_fp8_f32(__builtin_amdgcn_fmed3f(c.x, -440.f, 440.f), __builtin_amdgcn_fmed3f(c.y, -440.f, 440.f), 0, false);
                  t = __builtin_amdgcn_cvt_pk_fp8_f32(__builtin_amdgcn_fmed3f(d.x, -440.f, 440.f), __builtin_amdgcn_fmed3f(d.y, -440.f, 440.f), t, true); w.y = (unsigned)t; }
                *(u32x2*)((unsigned char*)SG + ro + (size_t)(row0 + ai * HALF + m * 16) * 1024) = w;
                asm volatile("" ::: "memory"); }
    }
};

struct EpiAttOut {
    static constexpr bool PERM = true, AFTER_DRAIN = false;
    const unsigned char* GA; const unsigned char* GS; const bf16_t* SG; unsigned char* MG;
    __device__ __forceinline__ void operator()(const f32x4 (&acc)[2][2][4][2], const Unit& u, int wr, int wc, int fr, int fq) const {
        const int row0 = u.pm * BM + wr * 64 + fr; const int col0 = u.pn * BM + wc * 32 + 8 * fq;
        u32x2 nga[2], ngs[2]; u32x2 nsg[2];
#define EAO_LOAD(idx) do { const size_t ro_ = (size_t)(row0 + ((idx) >> 2) * HALF + ((idx) & 3) * 16) * 1024 + col0; \
        _Pragma("unroll") for (int bj = 0; bj < 2; ++bj) { nga[bj] = *(const u32x2*)(GA + ro_ + bj * HALF); nsg[bj] = *(const u32x2*)((const unsigned char*)SG + 2 * ro_ - col0 + bj * HALF); ngs[bj] = *(const u32x2*)(GS + ro_ + bj * HALF); } } while (0)
#define U8F(w, i) ((float)(((w) >> (8 * (i))) & 0xffu))
        EAO_LOAD(0);
#pragma unroll
        for (int idx = 0; idx < 8; ++idx) { const int ai = idx >> 2, m = idx & 3; const size_t ro = (size_t)(row0 + ai * HALF + m * 16) * 1024 + col0;
            u32x2 cga[2], cgs[2]; u32x2 csg[2];
#pragma unroll
            for (int bj = 0; bj < 2; ++bj) { cga[bj] = nga[bj]; csg[bj] = nsg[bj]; cgs[bj] = ngs[bj]; }
            if (idx < 7) EAO_LOAD(idx + 1);
#pragma unroll
            for (int bj = 0; bj < 2; ++bj) { const f32x4 v0 = acc[ai][bj][m][0], v1 = acc[ai][bj][m][1]; const u32x2 ga = cga[bj], gs = cgs[bj]; const u32x2 sg = csg[bj];
                constexpr float C = 16.0f / 255.0f, CS = 1.0f / 255.0f;
                float o[8];
#define EAO_PAIR(i, gaw, gsw, b0, va, vb, sgw, hi_) do { const f32x2_ s_ = __builtin_amdgcn_cvt_pk_f32_fp8((int)(sgw), hi_); \
                    const f32x2_ r_ = (f32x2_){U8F(gaw, b0), U8F(gaw, b0 + 1)} * (f32x2_){va, vb} * C + (f32x2_){U8F(gsw, b0), U8F(gsw, b0 + 1)} * s_ * CS; \
                    o[i] = __builtin_amdgcn_fmed3f(r_.x, -440.f, 440.f); o[i + 1] = __builtin_amdgcn_fmed3f(r_.y, -440.f, 440.f); } while (0)
                EAO_PAIR(0, ga.x, gs.x, 0, v0[0], v0[1], sg.x, false); EAO_PAIR(2, ga.x, gs.x, 2, v0[2], v0[3], sg.x, true);
                EAO_PAIR(4, ga.y, gs.y, 0, v1[0], v1[1], sg.y, false); EAO_PAIR(6, ga.y, gs.y, 2, v1[2], v1[3], sg.y, true);
#undef EAO_PAIR
                u32x2 w; int t = __builtin_amdgcn_cvt_pk_fp8_f32(o[0], o[1], 0, false); t = __builtin_amdgcn_cvt_pk_fp8_f32(o[2], o[3], t, true); w.x = (unsigned)t;
                t = __builtin_amdgcn_cvt_pk_fp8_f32(o[4], o[5], 0, false); t = __builtin_amdgcn_cvt_pk_fp8_f32(o[6], o[7], t, true); w.y = (unsigned)t;
                *(u32x2*)(MG + ro + bj * HALF) = w; }
            asm volatile("" ::: "memory"); }
#undef U8F
#undef EAO_LOAD
    }
};

struct EpiMix {
    static constexpr bool PERM = true, AFTER_DRAIN = false;
    bf16_t* Y; float* ssq;
    __device__ __forceinline__ void operator()(const f32x4 (&acc)[2][2][4][2], const Unit& u, int wr, int wc, int fr, int fq) const {
        const int row0 = u.pm * BM + wr * 64 + fr; const int col0 = u.pn * BM + wc * 32 + 8 * fq;
#pragma unroll
        for (int ai = 0; ai < 2; ++ai)
#pragma unroll
            for (int m = 0; m < 4; ++m) { const int row = row0 + ai * HALF + m * 16; const size_t ro = (size_t)row * 1024 + col0; float q = 0.f;
#pragma unroll
                for (int bj = 0; bj < 2; ++bj) { const f32x4 v0 = acc[ai][bj][m][0], v1 = acc[ai][bj][m][1];
                    q += (v0[0] * v0[0] + v0[1] * v0[1]) + (v0[2] * v0[2] + v0[3] * v0[3]) + (v1[0] * v1[0] + v1[1] * v1[1]) + (v1[2] * v1[2] + v1[3] * v1[3]);
                    u32x2 w; int t = __builtin_amdgcn_cvt_pk_fp8_f32(__builtin_amdgcn_fmed3f(v0[0] * 8.0f, -440.f, 440.f), __builtin_amdgcn_fmed3f(v0[1] * 8.0f, -440.f, 440.f), 0, false);
                    t = __builtin_amdgcn_cvt_pk_fp8_f32(__builtin_amdgcn_fmed3f(v0[2] * 8.0f, -440.f, 440.f), __builtin_amdgcn_fmed3f(v0[3] * 8.0f, -440.f, 440.f), t, true); w.x = (unsigned)t;
                    t = __builtin_amdgcn_cvt_pk_fp8_f32(__builtin_amdgcn_fmed3f(v1[0] * 8.0f, -440.f, 440.f), __builtin_amdgcn_fmed3f(v1[1] * 8.0f, -440.f, 440.f), 0, false);
                    t = __builtin_amdgcn_cvt_pk_fp8_f32(__builtin_amdgcn_fmed3f(v1[2] * 8.0f, -440.f, 440.f), __builtin_amdgcn_fmed3f(v1[3] * 8.0f, -440.f, 440.f), t, true); w.y = (unsigned)t;
                    *(u32x2*)((unsigned char*)Y + (size_t)row * 2048 + col0 + bj * HALF) = w; }
                q += __shfl_xor(q, 16); q += __shfl_xor(q, 32);
                if (fq == 0) ssq[(size_t)row * 16 + u.pn * 4 + wc] = q; }
    }
};

constexpr float HID8_SCALE = 8.0f;
struct EpiMoe1 {
    static constexpr bool PERM = true, AFTER_DRAIN = false;
    unsigned char* HID;
    __device__ __forceinline__ void operator()(const f32x4 (&acc)[2][2][4][2], const Unit& u, int wr, int wc, int fr, int fq) const {
        const int row0 = u.pm * BM + wr * 64 + fr; const int col0 = (u.pn & 3) * 128 + wc * 32 + 8 * fq;
#pragma unroll
        for (int ai = 0; ai < 2; ++ai)
#pragma unroll
            for (int m = 0; m < 4; ++m) { const size_t ro = (size_t)(row0 + ai * HALF + m * 16) * 512 + col0;
                float h[8];
#pragma unroll
                for (int n = 0; n < 2; ++n) { const f32x4 g = acc[ai][0][m][n], v = acc[ai][1][m][n];
#pragma unroll
                    for (int i = 0; i < 4; i += 2) { const f32x2_ gg = {g[i], g[i + 1]}; const f32x2_ hh = vsig2(gg, gg) * ((f32x2_){v[i], v[i + 1]} * HID8_SCALE);
                        h[4 * n + i] = __builtin_amdgcn_fmed3f(hh.x, -440.f, 440.f); h[4 * n + i + 1] = __builtin_amdgcn_fmed3f(hh.y, -440.f, 440.f); } }
                u32x2 w; int t = __builtin_amdgcn_cvt_pk_fp8_f32(h[0], h[1], 0, false); t = __builtin_amdgcn_cvt_pk_fp8_f32(h[2], h[3], t, true); w.x = (unsigned)t;
                t = __builtin_amdgcn_cvt_pk_fp8_f32(h[4], h[5], 0, false); t = __builtin_amdgcn_cvt_pk_fp8_f32(h[6], h[7], t, true); w.y = (unsigned)t;
                *(u32x2*)(HID + ro) = w; }
    }
};

constexpr float YR8_SCALE = 256.0f;
struct EpiMoe2 {
    static constexpr bool PERM = true, AFTER_DRAIN = false;
    unsigned char* YR; const float* rw;
    __device__ __forceinline__ void operator()(const f32x4 (&acc)[2][2][4][2], const Unit& u, int wr, int wc, int fr, int fq) const {
        const int row0 = u.pm * BM + wr * 64 + fr; const int col0 = (u.pn & 3) * BM + wc * 32 + 8 * fq;
#pragma unroll
        for (int ai = 0; ai < 2; ++ai)
#pragma unroll
            for (int m = 0; m < 4; ++m) { const int row = row0 + ai * HALF + m * 16; const size_t ro = (size_t)row * 1024 + col0; const float s = rw[row] * YR8_SCALE;
#pragma unroll
                for (int bj = 0; bj < 2; ++bj) { f32x4 v0 = acc[ai][bj][m][0] * s, v1 = acc[ai][bj][m][1] * s;
#pragma unroll
                    for (int i = 0; i < 4; ++i) { v0[i] = fminf(fmaxf(v0[i], -440.f), 440.f); v1[i] = fminf(fmaxf(v1[i], -440.f), 440.f); }
                    u32x2 w; int t = __builtin_amdgcn_cvt_pk_fp8_f32(v0[0], v0[1], 0, false); t = __builtin_amdgcn_cvt_pk_fp8_f32(v0[2], v0[3], t, true); w.x = (unsigned)t;
                    t = __builtin_amdgcn_cvt_pk_fp8_f32(v1[0], v1[1], 0, false); t = __builtin_amdgcn_cvt_pk_fp8_f32(v1[2], v1[3], t, true); w.y = (unsigned)t;
                    *(u32x2*)(YR + ro + bj * HALF) = w; } }
    }
};

struct MoeOrder {
    const PG8_LAS int* tile_e; const int* list; int ntiles, G, c;
    __device__ __forceinline__ bool next(int i, Unit& u) const {
        const int L = i * G + c; if (L >= ntiles * 4) return false;
        const int t = L >> 2; u.pm = t; u.pn = tile_e[t] * 4 + (L & 3); return true;
    }
    __device__ __forceinline__ unsigned a_row(const Unit& u, int lr) const {
        const int e = u.pn >> 2, i = u.pm * 256 + lr - tile_e[600 + e];
        return (i < tile_e[640 + e]) ? (unsigned)(list[(size_t)e * 65536 + i] >> 1) : 0u;
    }
    __device__ __forceinline__ void a_ready(const Unit&) const {}
    __device__ __forceinline__ void done(const Unit&) const {}
};

struct PanelOrder {
    int pm, n, rot;
    __device__ __forceinline__ bool next(int i, Unit& u) const { if (i >= n) return false; int p = pm; asm volatile("" : "+s"(p));
        u.pm = p; u.pn = (i + rot) % n; return true; }
    __device__ __forceinline__ void a_ready(const Unit&) const {}
    __device__ __forceinline__ void done(const Unit&) const {}
};
template <class Epi, class Sched, bool ALIGN_EPI = false, bool SP2 = false, bool F8 = false>
__device__ __forceinline__ void gemm_phase(PG8_LAS unsigned char* lds, const Gemm g, const Sched& S, const Epi& E, int sclA = 127, int sclB = 127) {
    int tid_ = threadIdx.x; asm volatile("" : "+v"(tid_));
    const int tid = tid_, wid = __builtin_amdgcn_readfirstlane(tid >> 6), lane = tid & 63, wr = wid >> 2, wc = wid & 3, fr = lane & 15, fq = lane >> 4;
    const int K = g.K, nt = K / BK;
    unsigned voffA[2], voffB[2];
#pragma unroll
    for (int i = 0; i < 2; ++i) { int R, C; stage_rc(tid * 16 + i * 8192, R, C); const int Rb = Epi::PERM ? ((R & ~31) + perm32(R & 31)) : R;
        voffA[i] = (unsigned)(R * K + C) * 2u; voffB[i] = (unsigned)(Rb * K + C) * 2u; }
    const size_t kstep = (size_t)(BK * 2);
    const size_t hstep = (size_t)HALF * K * 2;
    const size_t tstep = 2 * hstep;
    const unsigned ldsw = (unsigned)wid * 1024u;
    const int aoff = lds_byte(wr * 64 + fr, fq * 8), boff = lds_byte(wc * 32 + fr, fq * 8);
#define PG8_SA(b, h) (((b) * 2 + (h)) * HTB)
#define PG8_SB(b, h) ((4 + (b) * 2 + (h)) * HTB)
#define PG8_STAGE(bufoff, gbase, voff) do { _Pragma("unroll") for (int _i = 0; _i < 2; ++_i) \
        __builtin_amdgcn_global_load_lds((const unsigned*)((const char*)(gbase) + (voff)[_i]), (PG8_LAS unsigned*)(lds + (bufoff) + ldsw + _i * 8192), 16, 0, 0); } while (0)
#define PG8_LDA(dst, b, h) do { _Pragma("unroll") for (int m = 0; m < 4; ++m) _Pragma("unroll") for (int k = 0; k < 2; ++k) dst[m][k] = *(const PG8_LAS bf16x8*)(lds + PG8_SA(b, h) + aoff + m * 2048 + k * 1024); } while (0)
#define PG8_LDB(dst, b, h) do { _Pragma("unroll") for (int n = 0; n < 2; ++n) _Pragma("unroll") for (int k = 0; k < 2; ++k) dst[n][k] = *(const PG8_LAS bf16x8*)(lds + PG8_SB(b, h) + boff + n * 2048 + k * 1024); } while (0)
#define PG8_MMA(ai, bj, At, Bt) do { __builtin_amdgcn_s_setprio(1); _Pragma("unroll") for (int m = 0; m < 4; ++m) _Pragma("unroll") for (int n = 0; n < 2; ++n) { \
        if constexpr (F8) { const i32x4 b0_ = __builtin_bit_cast(i32x4, Bt[n][0]), b1_ = __builtin_bit_cast(i32x4, Bt[n][1]), a0_ = __builtin_bit_cast(i32x4, At[m][0]), a1_ = __builtin_bit_cast(i32x4, At[m][1]); \
            const i32x8 b8_ = __builtin_shufflevector(b0_, b1_, 0, 1, 2, 3, 4, 5, 6, 7), a8_ = __builtin_shufflevector(a0_, a1_, 0, 1, 2, 3, 4, 5, 6, 7); \
            asm volatile("v_mfma_scale_f32_16x16x128_f8f6f4 %0, %1, %2, %0, %3, %4 op_sel_hi:[0,0,0]" : "+v"(acc[ai][bj][m][n]) : "v"(b8_), "v"(a8_), "v"(sclB), "v"(sclA)); } \
        else { _Pragma("unroll") for (int k = 0; k < 2; ++k) acc[ai][bj][m][n] = __builtin_amdgcn_mfma_f32_16x16x32_bf16(Bt[n][k], At[m][k], acc[ai][bj][m][n], 0, 0, 0); } } \
        __builtin_amdgcn_s_setprio(0); } while (0)
#define PG8_WAIT_V(n) asm volatile("s_waitcnt vmcnt(" #n ")" ::: "memory")
#define PG8_WAIT_L(n) asm volatile("s_waitcnt lgkmcnt(" #n ")" ::: "memory")
#define PG8_BAR __builtin_amdgcn_s_barrier()
#define PG8_SCHED __builtin_amdgcn_sched_barrier(0)
    Unit cur, nxt; int ui = 0;
    if (!S.next(0, cur)) return;
    f32x4 acc[2][2][4][2];
#pragma unroll
    for (int a = 0; a < 2; ++a)
#pragma unroll
        for (int b = 0; b < 2; ++b)
#pragma unroll
            for (int m = 0; m < 4; ++m)
#pragma unroll
                for (int n = 0; n < 2; ++n) acc[a][b][m][n] = (f32x4){0.f, 0.f, 0.f, 0.f};
    bf16x8 At[4][2], B0[2][2], B1[2][2];
    const char* cA = (const char*)g.A + (size_t)cur.pm * tstep; const char* cB = (const char*)g.Bt + (size_t)cur.pn * tstep;
    S.a_ready(cur);
    if constexpr (SP2) {
        PG8_STAGE(PG8_SB(0, 0), cB, voffB); PG8_STAGE(PG8_SB(0, 1), cB + hstep, voffB); PG8_STAGE(PG8_SA(0, 0), cA, voffA); PG8_STAGE(PG8_SA(0, 1), cA + hstep, voffA);
        if (wr == 1) PG8_BAR;
        PG8_WAIT_V(2); PG8_BAR;
        PG8_STAGE(PG8_SB(1, 0), cB + kstep, voffB); PG8_STAGE(PG8_SA(1, 0), cA + kstep, voffA); PG8_STAGE(PG8_SB(1, 1), cB + hstep + kstep, voffB);
        PG8_WAIT_V(6); PG8_BAR;
    } else {
        PG8_STAGE(PG8_SB(0, 0), cB, voffB); PG8_STAGE(PG8_SA(0, 0), cA, voffA); PG8_STAGE(PG8_SB(0, 1), cB + hstep, voffB); PG8_STAGE(PG8_SA(0, 1), cA + hstep, voffA);
        if (wr == 1) PG8_BAR;
        PG8_WAIT_V(4); PG8_BAR;
        PG8_STAGE(PG8_SB(1, 0), cB + kstep, voffB); PG8_STAGE(PG8_SA(1, 0), cA + kstep, voffA); PG8_STAGE(PG8_SB(1, 1), cB + hstep + kstep, voffB);
        PG8_WAIT_V(6); PG8_BAR;
    }
    for (;;) {
        const bool has_next = S.next(ui + 1, nxt);
        const char* nA = has_next ? (const char*)g.A + (size_t)nxt.pm * tstep : cA; const char* nB = has_next ? (const char*)g.Bt + (size_t)nxt.pn * tstep : cB;
        for (int t = 0; t < nt; t += 2) {
            const bool last = (t == nt - 2);
            const char* a1 = cA + (size_t)(t + 1) * kstep;
            const char* a2 = last ? nA : cA + (size_t)(t + 2) * kstep; const char* b2 = last ? nB : cB + (size_t)(t + 2) * kstep;
            const char* a3 = a2 + kstep; const char* b3 = b2 + kstep;
            if (last && has_next) S.a_ready(nxt);
            if constexpr (SP2) {
            PG8_LDB(B0, 0, 0); PG8_LDB(B1, 0, 1); PG8_SCHED; PG8_LDA(At, 0, 0); PG8_STAGE(PG8_SA(1, 1), a1 + hstep, voffA);
            PG8_WAIT_V(8); PG8_WAIT_L(0); PG8_BAR; PG8_MMA(0, 0, At, B0); PG8_MMA(0, 1, At, B1); PG8_BAR; PG8_SCHED;
            PG8_LDA(At, 0, 1); PG8_STAGE(PG8_SB(0, 0), b2, voffB); PG8_STAGE(PG8_SB(0, 1), b2 + hstep, voffB); PG8_STAGE(PG8_SA(0, 0), a2, voffA);
            PG8_WAIT_V(8); PG8_WAIT_L(0); PG8_BAR; PG8_MMA(1, 0, At, B0); PG8_MMA(1, 1, At, B1); PG8_BAR; PG8_SCHED;
            PG8_LDB(B0, 1, 0); PG8_LDB(B1, 1, 1); PG8_SCHED; PG8_LDA(At, 1, 0); PG8_STAGE(PG8_SA(0, 1), a2 + hstep, voffA);
            PG8_WAIT_V(8); PG8_WAIT_L(0); PG8_BAR; PG8_MMA(0, 0, At, B0); PG8_MMA(0, 1, At, B1); PG8_BAR; PG8_SCHED;
            PG8_LDA(At, 1, 1); PG8_STAGE(PG8_SB(1, 0), b3, voffB); PG8_STAGE(PG8_SB(1, 1), b3 + hstep, voffB); PG8_STAGE(PG8_SA(1, 0), a3, voffA);
            PG8_WAIT_V(8); PG8_WAIT_L(0); PG8_BAR; PG8_MMA(1, 0, At, B0); PG8_MMA(1, 1, At, B1); PG8_BAR; PG8_SCHED;
            } else {
            PG8_LDB(B0, 0, 0); PG8_SCHED; PG8_LDA(At, 0, 0); PG8_STAGE(PG8_SA(1, 1), a1 + hstep, voffA);
            PG8_WAIT_L(8); PG8_BAR; PG8_WAIT_L(0); PG8_MMA(0, 0, At, B0); PG8_BAR; PG8_SCHED;
            PG8_LDB(B1, 0, 1); PG8_STAGE(PG8_SB(0, 0), b2, voffB);
            PG8_BAR; PG8_WAIT_L(0); PG8_MMA(0, 1, At, B1); PG8_BAR;
            PG8_LDA(At, 0, 1); PG8_STAGE(PG8_SA(0, 0), a2, voffA);
            PG8_BAR; PG8_WAIT_L(0); PG8_MMA(1, 0, At, B0); PG8_BAR; PG8_SCHED;
            PG8_STAGE(PG8_SB(0, 1), b2 + hstep, voffB);
            PG8_WAIT_V(6); PG8_BAR; PG8_MMA(1, 1, At, B1); PG8_BAR;
            PG8_LDB(B0, 1, 0); PG8_SCHED; PG8_LDA(At, 1, 0); PG8_STAGE(PG8_SA(0, 1), a2 + hstep, voffA);
            PG8_WAIT_L(8); PG8_BAR; PG8_WAIT_L(0); PG8_MMA(0, 0, At, B0); PG8_BAR; PG8_SCHED;
            PG8_LDB(B1, 1, 1); PG8_STAGE(PG8_SB(1, 0), b3, voffB);
            PG8_BAR; PG8_WAIT_L(0); PG8_MMA(0, 1, At, B1); PG8_BAR;
            PG8_LDA(At, 1, 1); PG8_STAGE(PG8_SA(1, 0), a3, voffA);
            PG8_BAR; PG8_WAIT_L(0); PG8_MMA(1, 0, At, B0); PG8_BAR; PG8_SCHED;
            PG8_STAGE(PG8_SB(1, 1), b3 + hstep, voffB);
            PG8_WAIT_V(6); PG8_BAR; PG8_MMA(1, 1, At, B1); PG8_BAR;
            }
        }
        if constexpr (ALIGN_EPI) { if (wr == 0) PG8_BAR; }
        if constexpr (F8) asm volatile("s_nop 15\n\ts_nop 15" ::: "memory");
        if constexpr (!Epi::AFTER_DRAIN) { E(acc, cur, wr, wc, fr, fq); S.done(cur); }
        if (!has_next) break;
#pragma unroll
        for (int a = 0; a < 2; ++a)
#pragma unroll
            for (int b = 0; b < 2; ++b)
#pragma unroll
                for (int m = 0; m < 4; ++m)
#pragma unroll
                    for (int n = 0; n < 2; ++n) acc[a][b][m][n] = (f32x4){0.f, 0.f, 0.f, 0.f};
        cur = nxt; cA = nA; cB = nB; ++ui;
        if constexpr (ALIGN_EPI) { if (wr == 1) PG8_BAR; }
    }
    PG8_WAIT_V(0);
    if constexpr (!ALIGN_EPI) { if (wr == 0) PG8_BAR; }
    PG8_BAR;
    if constexpr (Epi::AFTER_DRAIN) { E.fused(acc, cur, wr, wc, fr, fq, lds, wid, lane); S.done(cur); }
#undef PG8_SA
#undef PG8_SB
#undef PG8_STAGE
#undef PG8_LDA
#undef PG8_LDB
#undef PG8_MMA
#undef PG8_WAIT_V
#undef PG8_WAIT_L
#undef PG8_BAR
#undef PG8_SCHED
}
template <class Epi, class Sched, bool F8 = false>
__device__ __forceinline__ void gemm_phase_g(PG8_LAS unsigned char* lds, const Gemm g, const Sched& S, const Epi& E, int sclA = 127, int sclB = 127) {
    int tid_ = threadIdx.x; asm volatile("" : "+v"(tid_));
    const int tid = tid_, wid = __builtin_amdgcn_readfirstlane(tid >> 6), lane = tid & 63, wr = wid >> 2, wc = wid & 3, fr = lane & 15, fq = lane >> 4;
    const int K = g.K, nt = K / BK;
    unsigned voffB[2]; int Rr[2], Cc[2];
#pragma unroll
    for (int i = 0; i < 2; ++i) { int R, C; stage_rc(tid * 16 + i * 8192, R, C); const int Rb = Epi::PERM ? ((R & ~31) + perm32(R & 31)) : R; Rr[i] = R; Cc[i] = C; voffB[i] = (unsigned)(Rb * K + C) * 2u; }
    const size_t kstep = (size_t)(BK * 2); const size_t hstep = (size_t)HALF * K * 2; const size_t tstep = 2 * hstep;
    const unsigned ldsw = (unsigned)wid * 1024u;
    const int aoff = lds_byte(wr * 64 + fr, fq * 8), boff = lds_byte(wc * 32 + fr, fq * 8);
#define PG8_SA(b, h) (((b) * 2 + (h)) * HTB)
#define PG8_SB(b, h) ((4 + (b) * 2 + (h)) * HTB)
#define PG8_STAGE(bufoff, gbase, voff) do { _Pragma("unroll") for (int _i = 0; _i < 2; ++_i) \
        __builtin_amdgcn_global_load_lds((const unsigned*)((const char*)(gbase) + (voff)[_i]), (PG8_LAS unsigned*)(lds + (bufoff) + ldsw + _i * 8192), 16, 0, 0); } while (0)
#define PG8_LDA(dst, b, h) do { _Pragma("unroll") for (int m = 0; m < 4; ++m) _Pragma("unroll") for (int k = 0; k < 2; ++k) dst[m][k] = *(const PG8_LAS bf16x8*)(lds + PG8_SA(b, h) + aoff + m * 2048 + k * 1024); } while (0)
#define PG8_LDB(dst, b, h) do { _Pragma("unroll") for (int n = 0; n < 2; ++n) _Pragma("unroll") for (int k = 0; k < 2; ++k) dst[n][k] = *(const PG8_LAS bf16x8*)(lds + PG8_SB(b, h) + boff + n * 2048 + k * 1024); } while (0)
#define PG8_MMA(ai, bj, At, Bt) do { __builtin_amdgcn_s_setprio(1); _Pragma("unroll") for (int m = 0; m < 4; ++m) _Pragma("unroll") for (int n = 0; n < 2; ++n) { \
        if constexpr (F8) { const i32x4 b0_ = __builtin_bit_cast(i32x4, Bt[n][0]), b1_ = __builtin_bit_cast(i32x4, Bt[n][1]), a0_ = __builtin_bit_cast(i32x4, At[m][0]), a1_ = __builtin_bit_cast(i32x4, At[m][1]); \
            const i32x8 b8_ = __builtin_shufflevector(b0_, b1_, 0, 1, 2, 3, 4, 5, 6, 7), a8_ = __builtin_shufflevector(a0_, a1_, 0, 1, 2, 3, 4, 5, 6, 7); \
            asm volatile("v_mfma_scale_f32_16x16x128_f8f6f4 %0, %1, %2, %0, %3, %4 op_sel_hi:[0,0,0]" : "+v"(acc[ai][bj][m][n]) : "v"(b8_), "v"(a8_), "v"(sclB), "v"(sclA)); } \
        else { _Pragma("unroll") for (int k = 0; k < 2; ++k) acc[ai][bj][m][n] = __builtin_amdgcn_mfma_f32_16x16x32_bf16(Bt[n][k], At[m][k], acc[ai][bj][m][n], 0, 0, 0); } } \
        __builtin_amdgcn_s_setprio(0); } while (0)
#define PG8_WAIT_V(n) asm volatile("s_waitcnt vmcnt(" #n ")" ::: "memory")
#define PG8_WAIT_L(n) asm volatile("s_waitcnt lgkmcnt(" #n ")" ::: "memory")
#define PG8_BAR __builtin_amdgcn_s_barrier()
#define PG8_SCHED __builtin_amdgcn_sched_barrier(0)
#define PG8_ROWS(dst, u) do { _Pragma("unroll") for (int _h = 0; _h < 2; ++_h) _Pragma("unroll") for (int _i = 0; _i < 2; ++_i) dst[_h][_i] = S.a_row(u, _h * HALF + Rr[_i]) * (unsigned)(K * 2) + (unsigned)(Cc[_i] * 2); } while (0)
    Unit cur, nxt; int ui = 0;
    if (!S.next(0, cur)) return;
    f32x4 acc[2][2][4][2];
#pragma unroll
    for (int a = 0; a < 2; ++a)
#pragma unroll
        for (int b = 0; b < 2; ++b)
#pragma unroll
            for (int m = 0; m < 4; ++m)
#pragma unroll
                for (int n = 0; n < 2; ++n) acc[a][b][m][n] = (f32x4){0.f, 0.f, 0.f, 0.f};
    bf16x8 At[4][2], B0[2][2], B1[2][2];
    unsigned gC[2][2], gN[2][2];
    PG8_ROWS(gC, cur);
    const char* const A0 = (const char*)g.A;
    const char* cB = (const char*)g.Bt + (size_t)cur.pn * tstep;
    PG8_STAGE(PG8_SB(0, 0), cB, voffB); PG8_STAGE(PG8_SB(0, 1), cB + hstep, voffB); PG8_STAGE(PG8_SA(0, 0), A0, gC[0]); PG8_STAGE(PG8_SA(0, 1), A0, gC[1]);
    if (wr == 1) PG8_BAR;
    PG8_WAIT_V(2); PG8_BAR;
    PG8_STAGE(PG8_SB(1, 0), cB + kstep, voffB); PG8_STAGE(PG8_SA(1, 0), A0 + kstep, gC[0]); PG8_STAGE(PG8_SB(1, 1), cB + hstep + kstep, voffB);
    PG8_WAIT_V(6); PG8_BAR;
    for (;;) {
        const bool has_next = S.next(ui + 1, nxt);
        const char* nB = has_next ? (const char*)g.Bt + (size_t)nxt.pn * tstep : cB;
        if (has_next) { PG8_ROWS(gN, nxt); } else {
#pragma unroll
            for (int _h = 0; _h < 2; ++_h)
#pragma unroll
                for (int _i = 0; _i < 2; ++_i) gN[_h][_i] = gC[_h][_i]; }
        for (int t = 0; t < nt; t += 2) {
            const bool last = (t == nt - 2);
            const char* a1 = A0 + (size_t)(t + 1) * kstep;
            const char* a2 = last ? A0 : A0 + (size_t)(t + 2) * kstep; const char* b2 = last ? nB : cB + (size_t)(t + 2) * kstep;
            const char* a3 = a2 + kstep; const char* b3 = b2 + kstep;
            unsigned gX[2][2];
#pragma unroll
            for (int _h = 0; _h < 2; ++_h)
#pragma unroll
                for (int _i = 0; _i < 2; ++_i) gX[_h][_i] = last ? gN[_h][_i] : gC[_h][_i];
            PG8_LDB(B0, 0, 0); PG8_LDB(B1, 0, 1); PG8_SCHED; PG8_LDA(At, 0, 0); PG8_STAGE(PG8_SA(1, 1), a1, gC[1]);
            PG8_WAIT_V(8); PG8_WAIT_L(0); PG8_BAR; PG8_MMA(0, 0, At, B0); PG8_MMA(0, 1, At, B1); PG8_BAR; PG8_SCHED;
            PG8_LDA(At, 0, 1); PG8_STAGE(PG8_SB(0, 0), b2, voffB); PG8_STAGE(PG8_SB(0, 1), b2 + hstep, voffB); PG8_STAGE(PG8_SA(0, 0), a2, gX[0]);
            PG8_WAIT_V(8); PG8_WAIT_L(0); PG8_BAR; PG8_MMA(1, 0, At, B0); PG8_MMA(1, 1, At, B1); PG8_BAR; PG8_SCHED;
            PG8_LDB(B0, 1, 0); PG8_LDB(B1, 1, 1); PG8_SCHED; PG8_LDA(At, 1, 0); PG8_STAGE(PG8_SA(0, 1), a2, gX[1]);
            PG8_WAIT_V(8); PG8_WAIT_L(0); PG8_BAR; PG8_MMA(0, 0, At, B0); PG8_MMA(0, 1, At, B1); PG8_BAR; PG8_SCHED;
            PG8_LDA(At, 1, 1); PG8_STAGE(PG8_SB(1, 0), b3, voffB); PG8_STAGE(PG8_SB(1, 1), b3 + hstep, voffB); PG8_STAGE(PG8_SA(1, 0), a3, gX[0]);
            PG8_WAIT_V(8); PG8_WAIT_L(0); PG8_BAR; PG8_MMA(1, 0, At, B0); PG8_MMA(1, 1, At, B1); PG8_BAR; PG8_SCHED;
        }
        if (wr == 0) PG8_BAR;
        if constexpr (F8) asm volatile("s_nop 15\n\ts_nop 15" ::: "memory");
        E(acc, cur, wr, wc, fr, fq); S.done(cur);
        if (!has_next) break;
#pragma unroll
        for (int a = 0; a < 2; ++a)
#pragma unroll
            for (int b = 0; b < 2; ++b)
#pragma unroll
                for (int m = 0; m < 4; ++m)
#pragma unroll
                    for (int n = 0; n < 2; ++n) acc[a][b][m][n] = (f32x4){0.f, 0.f, 0.f, 0.f};
        cur = nxt; cB = nB; ++ui;
#pragma unroll
        for (int _h = 0; _h < 2; ++_h)
#pragma unroll
            for (int _i = 0; _i < 2; ++_i) gC[_h][_i] = gN[_h][_i];
        if (wr == 1) PG8_BAR;
    }
    PG8_WAIT_V(0);
    PG8_BAR;
#undef PG8_SA
#undef PG8_SB
#undef PG8_STAGE
#undef PG8_LDA
#undef PG8_LDB
#undef PG8_MMA
#undef PG8_WAIT_V
#undef PG8_WAIT_L
#undef PG8_BAR
#undef PG8_SCHED
#undef PG8_ROWS
}
}

constexpr int NWAVES = 8;
constexpr int BATCH = 16, SEQ = 4096, DM = 1024, NTOK = BATCH * SEQ;
constexpr int NH = 8, HD = 64, ATTW = 512, SSMW = 256, NPROJ = 3840;
constexpr int NEXP = 32, DEXP = 512, MOEB = 256;
constexpr int NROWS_PAD = NTOK * 2 + NEXP * MOEB;
constexpr int MAXTILES = NROWS_PAD / MOEB;
constexpr float RMS_EPS = 1e-6f;
constexpr float LOG2E = 1.4426950408889634f;
constexpr float W8_SCALE = 256.0f, A8_SCALE = 16.0f;
constexpr int W8_E8 = 119, A8_E8 = 123;
constexpr int SSM_L = 32, SSM_NCH = SEQ / SSM_L;

constexpr size_t MiB = 1u << 20;
constexpr size_t WS_CTL = 0, CTL_ZERO_BYTES = 1 * MiB;
constexpr size_t WS_MOD = 1 * MiB;
constexpr size_t WS_BTAB = WS_MOD + 512 * 1024;
constexpr size_t WS_KPART = 2 * MiB;
constexpr size_t WS_SSMTAB = 3 * MiB;
constexpr size_t SSM_GRP_BYTES = 294912, SSM_T_OFF = 0, SSM_W_OFF = 32768, SSM_S_OFF = 163840;
constexpr size_t WS_SSMAL = WS_SSMTAB + 16 * SSM_GRP_BYTES;
constexpr size_t WS_ROUTW = 1009 * MiB;
constexpr size_t WS_ROUTC = 1011 * MiB;
constexpr size_t WS_WIN = 9 * MiB;
constexpr size_t WS_WO = 17 * MiB;
constexpr size_t WS_WGLU = 18 * MiB;
constexpr size_t WS_WMIX = 19 * MiB;
constexpr size_t WS_WGU = 21 * MiB;
constexpr size_t WS_WDN = 85 * MiB;
constexpr size_t WS_RA = 120 * MiB;
constexpr size_t WS_RB = 256 * MiB;
constexpr size_t WS_Q = WS_RB, WS_K = WS_RB + 64 * MiB;
constexpr size_t WS_V = 384 * MiB, WS_U = 448 * MiB, WS_GA = 480 * MiB, WS_GS = 608 * MiB, WS_ATT = 736 * MiB, WS_Z = 800 * MiB;
constexpr size_t WS_H2F8 = 320 * MiB;
constexpr size_t WS_XS = 480 * MiB;
constexpr size_t WS_LIST = 832 * MiB;
constexpr size_t WS_WGT = 840 * MiB;
constexpr size_t WS_ROWMAP = 841 * MiB;
constexpr size_t WS_RW = 842 * MiB;
constexpr size_t WS_SSQ = 844 * MiB;
constexpr size_t WS_SEL = 848 * MiB;
constexpr size_t WS_PL = 850 * MiB;
constexpr size_t WS_RLIST = 860 * MiB;
constexpr size_t WS_RCNT = 876 * MiB;
constexpr size_t WS_YMIX = WS_RA;
constexpr size_t WS_H2 = 880 * MiB;
constexpr size_t WS_X1A = 384 * MiB, WS_X1B = 768 * MiB; constexpr int X1_SPLIT = 49152;
constexpr size_t WS_END = 1012 * MiB;
static_assert(WS_SSMAL + 16 * 64 * 2 * 4 <= WS_ROUTW && WS_WIN + (size_t)NPROJ * DM * 2 <= WS_WO && WS_WDN + (size_t)NEXP * DM * DEXP * 2 <= WS_RA, "ws map 1");
static_assert(WS_RA + (size_t)NROWS_PAD * DEXP * 2 <= WS_RB && WS_XS + (size_t)NROWS_PAD * DM * 2 <= WS_LIST && WS_Z + (size_t)NTOK * SSMW * 2 <= WS_LIST, "ws map 2");
constexpr int CW_BAR = 4096;
constexpr int CW_CNT = 16384;

constexpr int RING_BYTES = 131072;
constexpr int LDSCTL_OFF = RING_BYTES, MISC_OFF = LDSCTL_OFF + 320;
constexpr int TILEE_OFF = RING_BYTES + 1024;
constexpr int LDS_BYTES = 147456;
static_assert(TILEE_OFF + 4 * 1024 <= LDS_BYTES, "LDS map");

#define GAS __attribute__((address_space(1)))
#define LAS __attribute__((address_space(3)))
typedef unsigned short bf16;
typedef unsigned v4u __attribute__((ext_vector_type(4)));
typedef unsigned v2u __attribute__((ext_vector_type(2)));
typedef float f32x4 __attribute__((ext_vector_type(4)));
typedef float f32x16 __attribute__((ext_vector_type(16)));
typedef short bf16x8 __attribute__((ext_vector_type(8)));
typedef short s16x4 __attribute__((ext_vector_type(4)));
typedef GAS unsigned gu32;
#define RLX_AGENT __ATOMIC_RELAXED, __HIP_MEMORY_SCOPE_AGENT
#define LDS_WAIT() asm volatile("s_waitcnt lgkmcnt(0)" ::: "memory")
#define VM_WAIT() asm volatile("s_waitcnt vmcnt(0)" ::: "memory")
__device__ __forceinline__ unsigned pk2(float lo, float hi) { return pg8::cvt_pk_bf16(lo, hi); }
__device__ __forceinline__ float bflo(unsigned w) { return __uint_as_float(w << 16); }
__device__ __forceinline__ float bfhi(unsigned w) { return __uint_as_float(w & 0xffff0000u); }
__device__ __forceinline__ float bf2f(bf16 h) { return __uint_as_float(((unsigned)h) << 16); }
#define XB_TMO      128
#define XB_XCNT(j)  (256  + 64 * (j))
#define XB_XSUB(j)  (1280 + 64 * (j))
#define XB_XGEN(j)  (2304 + 64 * (j))
#define XB_TOP      3328
#define XB_TOPGEN   3392
#define XCD_BAR_WORDS 3456
#define XB_SPIN_CAP (1u << 18)

__device__ __forceinline__ unsigned xb_ld(unsigned* p)              { return __hip_atomic_load(p, __ATOMIC_RELAXED, __HIP_MEMORY_SCOPE_AGENT); }
__device__ __forceinline__ unsigned xb_add(unsigned* p, unsigned v) { return __hip_atomic_fetch_add(p, v, __ATOMIC_RELAXED, __HIP_MEMORY_SCOPE_AGENT); }
__device__ __forceinline__ unsigned xb_xcc_id() { return (unsigned)__builtin_amdgcn_s_getreg((3 << 11) | 20) & 0xFu; }
#define XB_SPIN(cond, bar) do { unsigned _sp = 0; while (cond) { __builtin_amdgcn_s_sleep(1); \
    if ((++_sp & 255u) == 0u) { if (xb_ld(&(bar)[XB_TMO])) break; if (_sp > XB_SPIN_CAP) { atomicAdd(&(bar)[XB_TMO], 1u); break; } } } } while (0)

struct XcdBarrier {
    unsigned* bar; unsigned x;
    volatile LAS unsigned* st;
};

__device__ __forceinline__ XcdBarrier xcd_barrier_post(unsigned* bar, volatile LAS unsigned* st) {
    XcdBarrier b; b.bar = bar; b.x = xb_xcc_id(); b.st = st;
    if (threadIdx.x == 0) (void)xb_add(&bar[XB_XCNT(b.x)], 1u);
    return b;
}
__device__ __forceinline__ void xcd_barrier_complete(unsigned* bar, unsigned x, unsigned& nloc, unsigned& nx) {
    const unsigned G = gridDim.x * gridDim.y * gridDim.z;
    unsigned sum, cnt, mine, sp = 0u;
    for (;;) {
        sum = 0u; cnt = 0u; mine = 0u;
#pragma unroll
        for (unsigned j = 0; j < 16; ++j) { const unsigned c = xb_ld(&bar[XB_XCNT(j)]); sum += c; cnt += (c > 0u) ? 1u : 0u; mine = (j == x) ? c : mine; }
        if (sum == G) break;
        __builtin_amdgcn_s_sleep(1);
        if ((++sp & 255u) == 0u) { if (xb_ld(&bar[XB_TMO])) break; if (sp > XB_SPIN_CAP) { atomicAdd(&bar[XB_TMO], 1u); break; } }
    }
    nloc = mine > 0u ? mine : 1u; nx = cnt > 0u ? cnt : 1u;
}

__device__ __forceinline__ void xcd_barrier(const XcdBarrier& b) {
    asm volatile("s_waitcnt vmcnt(0)" ::: "memory");
    __syncthreads();
    if (threadIdx.x == 0) {
        unsigned* bar = b.bar;
        __builtin_amdgcn_s_waitcnt(0);
        unsigned nloc = b.st[0], nx = b.st[1];
        if (nloc == 0u) { xcd_barrier_complete(bar, b.x, nloc, nx); b.st[0] = nloc; b.st[1] = nx; }
        const unsigned old = xb_add(&bar[XB_XSUB(b.x)], 1u);
        const unsigned gen = old / nloc;
        if (old + 1u == (gen + 1u) * nloc) {
            __builtin_amdgcn_fence(__ATOMIC_RELEASE, "agent");
            asm volatile("s_waitcnt vmcnt(0)" ::: "memory");
            const unsigned og = xb_add(&bar[XB_TOP], 1u);
            const unsigned tg = og / nx;
            if (og + 1u == (tg + 1u) * nx) xb_add(&bar[XB_TOPGEN], 1u);
            else XB_SPIN(xb_ld(&bar[XB_TOPGEN]) == tg, bar);
            __builtin_amdgcn_fence(__ATOMIC_ACQUIRE, "agent");
            xb_add(&bar[XB_XGEN(b.x)], 1u);
            asm volatile("s_waitcnt vmcnt(0)" ::: "memory");
        } else {
            XB_SPIN(xb_ld(&bar[XB_XGEN(b.x)]) == gen, bar);
            __builtin_amdgcn_fence(__ATOMIC_ACQUIRE, "agent");
            asm volatile("s_waitcnt vmcnt(0)" ::: "memory");
        }
    }
    __syncthreads();
}

struct Frame {
    LAS unsigned char* lds; volatile LAS unsigned* MISC; gu32* ctl; unsigned char* ws;
    int tid, lane, wave, vcu, G;
    const float* in[29]; float* out;
};
enum { I_X = 0, I_C, I_RELB, I_WADA, I_BADA, I_GPREMIX, I_GPOSTMIX, I_WIN, I_WATT, I_LRE, I_LIM, I_LOGDT, I_BRE, I_BIM, I_CRE, I_CIM, I_SSMD, I_WGLUV, I_WGLUG, I_WMIX,
       I_GPREFFN, I_GPOSTFFN, I_WRG, I_BRG, I_WRE, I_BRE2, I_WEG, I_WEU, I_WED };
__device__ __forceinline__ float wave_sum(float v) {
#pragma unroll
    for (int o = 1; o < 64; o <<= 1) v += __shfl_xor(v, o);
    return v;
}

__device__ __forceinline__ void p0_mod(Frame& F) {
    LAS float* cact = (LAS float*)F.lds;
    LAS float* red = (LAS float*)(F.lds + 65536);
    const float* c = F.in[I_C]; const float* w = F.in[I_WADA]; const float* bb = F.in[I_BADA];
    float* mod = (float*)(F.ws + WS_MOD);
    for (int i = F.tid; i < 16 * 1024; i += 512) { const int b = i >> 10, k = i & 1023; const float v = c[i]; cact[k * 16 + b] = v / (1.0f + __expf(-v)); }
    __syncthreads();
    const int blk = blockIdx.x, c4 = F.tid % 6, bg = (F.tid / 6) % 4, ks = F.tid / 24;
    float acc[4][4];
#pragma unroll
    for (int i = 0; i < 4; ++i)
#pragma unroll
        for (int j = 0; j < 4; ++j) acc[i][j] = 0.f;
    if (F.tid < 504) {
        for (int k = ks; k < 1024; k += 21) {
            const f32x4 wv = *(const f32x4*)(w + (size_t)k * 6144 + 24 * blk + 4 * c4);
            const f32x4 av = *(const LAS f32x4*)(cact + k * 16 + 4 * bg);
#pragma unroll
            for (int i = 0; i < 4; ++i)
#pragma unroll
                for (int j = 0; j < 4; ++j) acc[i][j] += av[i] * wv[j];
        }
#pragma unroll
        for (int i = 0; i < 4; ++i)
#pragma unroll
            for (int j = 0; j < 4; ++j) red[(ks * 24 + bg * 6 + c4) * 16 + i * 4 + j] = acc[i][j];
    }
    __syncthreads();
    if (F.tid < 384) {
        const int b = F.tid / 24, cc = F.tid % 24, cq = cc >> 2, j = cc & 3, g = b >> 2, bi = b & 3;
        float s = bb[24 * blk + cc];
        for (int q = 0; q < 21; ++q) s += red[(q * 24 + g * 6 + cq) * 16 + bi * 4 + j];
        mod[b * 6144 + 24 * blk + cc] = s;
    }
    __syncthreads();
}

__device__ __forceinline__ int t5_bucket(int d) {
    if (d < 16) return d;
    const float v = logf((float)d / 16.0f) / 2.0794415416798357f * 16.0f;
    const int b = 16 + (int)v; return b < 31 ? b : 31;
}
__device__ __forceinline__ void p0_tables(Frame& F) {
    { float* bt = (float*)(F.ws + WS_BTAB); const float* rb = F.in[I_RELB];
      for (int i = blockIdx.x * 512 + F.tid; i < 8 * 576; i += F.G * 512) { const int h = i / 576, d = i % 576 - 64;
          bt[i] = d < 0 ? -1e30f : rb[t5_bucket(d) * 8 + h] * LOG2E; } }
    { bf16* rw = (bf16*)(F.ws + WS_ROUTW); float* rcb = (float*)(F.ws + WS_ROUTC); const float* wg = F.in[I_WRG]; const float* we = F.in[I_WRE]; const float* mod = (const float*)(F.ws + WS_MOD);
      for (int i = blockIdx.x * 512 + F.tid; i < 16 * 49152; i += F.G * 512) {
          const int b = i / 49152, r = i % 49152, j = r & 7, ln = (r >> 3) & 63, nt = (r >> 9) % 3, ks = r / 1536;
          const int k = 32 * ks + 8 * (ln >> 4) + j, col = 16 * nt + (ln & 15);
          const float v = col < 4 ? wg[k * 4 + col] : (col < 36 ? we[k * 32 + col - 4] : 0.f);
          rw[i] = (bf16)(pk2(v * F.in[I_GPREFFN][k] * (1.0f + mod[b * 6144 + 4096 + k]), 0.f) & 0xffffu); }
      for (int i = blockIdx.x * 512 + F.tid; i < 16 * 48 * 8; i += F.G * 512) {
          const int sl = i & 7, col = (i >> 3) % 48, b = i / 384; float sm = 0.f;
          if (col < 36) for (int k = sl * 128; k < sl * 128 + 128; ++k) sm += mod[b * 6144 + 3072 + k] * (col < 4 ? wg[k * 4 + col] : we[k * 32 + col - 4]);
          sm += __shfl_xor(sm, 1); sm += __shfl_xor(sm, 2); sm += __shfl_xor(sm, 4);
          if (sl == 0) rcb[b * 48 + col] = col < 36 ? sm + (col < 4 ? F.in[I_BRG][col] : F.in[I_BRE2][col - 4]) : 0.f; } }
    {
        const int g = blockIdx.x & 15, part = blockIdx.x >> 4;
        LAS float* Apow = (LAS float*)F.lds;
        LAS float* Bb = Apow + 64 * 33 * 2;
        LAS float* Cc = Bb + 64 * 16 * 2;
        if (F.tid < 64) {
            const int p = F.tid; const float lr = F.in[I_LRE][g * 64 + p], li = F.in[I_LIM][g * 64 + p], dt = expf(F.in[I_LOGDT][g]);
            const float zr = lr * dt, zi = li * dt;
            for (int e = 0; e <= 32; ++e) { float sn, cs; sincosf(zi * (float)e, &sn, &cs); const float mg = expf(zr * (float)e); Apow[(p * 33 + e) * 2] = mg * cs; Apow[(p * 33 + e) * 2 + 1] = mg * sn; }
            float sn, cs, sh; sincosf(zi, &sn, &cs); sh = sinf(0.5f * zi);
            const float nr = expm1f(zr) * cs - 2.0f * sh * sh, ni = expf(zr) * sn, den = lr * lr + li * li;
            const float fr_ = (nr * lr + ni * li) / den, fi_ = (ni * lr - nr * li) / den;
            for (int ch = 0; ch < 16; ++ch) { const float br = F.in[I_BRE][(g * 64 + p) * 16 + ch], bi = F.in[I_BIM][(g * 64 + p) * 16 + ch];
                Bb[(p * 16 + ch) * 2] = fr_ * br - fi_ * bi; Bb[(p * 16 + ch) * 2 + 1] = fr_ * bi + fi_ * br; }
            if (part == 0) { float* aL = (float*)(F.ws + WS_SSMAL) + (g * 64 + p) * 2; aL[0] = Apow[(p * 33 + 32) * 2]; aL[1] = Apow[(p * 33 + 32) * 2 + 1]; }
        }
        for (int i = F.tid; i < 1024; i += 512) { const int co = i >> 6, p = i & 63; Cc[i * 2] = F.in[I_CRE][(g * 16 + co) * 64 + p]; Cc[i * 2 + 1] = F.in[I_CIM][(g * 16 + co) * 64 + p]; }
        __syncthreads();
        unsigned char* gb = F.ws + WS_SSMTAB + (size_t)g * SSM_GRP_BYTES;
        bf16* Tf = (bf16*)(gb + SSM_T_OFF); bf16* Wf = (bf16*)(gb + SSM_W_OFF); bf16* Sf = (bf16*)(gb + SSM_S_OFF);
        for (int q = F.tid; q < 1024; q += 512) {
            const int idx = part * 1024 + q, j = idx & 7, ln = (idx >> 3) & 63, dj = idx >> 9, kq = ln >> 4, co = ln & 15, lag = dj - (kq >> 1), ch = 8 * (kq & 1) + j;
            float s = 0.f;
            if (lag >= 0) for (int p = 0; p < 64; ++p) {
                const float cr = Cc[(co * 64 + p) * 2], ci = Cc[(co * 64 + p) * 2 + 1], ar = Apow[(p * 33 + lag) * 2], ai = Apow[(p * 33 + lag) * 2 + 1], br = Bb[(p * 16 + ch) * 2], bi = Bb[(p * 16 + ch) * 2 + 1];
                const float tr = cr * ar - ci * ai, ti = cr * ai + ci * ar; s += tr * br - ti * bi; }
            if (lag == 0 && co == ch) s += F.in[I_SSMD][g * 16 + co];
            Tf[idx] = (bf16)(pk2(s, 0.f) & 0xffffu);
        }
        for (int q = F.tid; q < 4096; q += 512) {
            const int idx = part * 4096 + q, j = idx & 7, ln = (idx >> 3) & 63, nt = (idx >> 9) & 7, ks = idx >> 12, kq = ln >> 4;
            const int s_ = 2 * ks + (kq >> 1), ch = 8 * (kq & 1) + j, n = 16 * nt + (ln & 15), p = n & 63, e = 31 - s_;
            const float ar = Apow[(p * 33 + e) * 2], ai = Apow[(p * 33 + e) * 2 + 1], br = Bb[(p * 16 + ch) * 2], bi = Bb[(p * 16 + ch) * 2 + 1];
            const float v = (n < 64) ? (ar * br - ai * bi) : (ar * bi + ai * br);
            Wf[idx] = (bf16)(pk2(v, 0.f) & 0xffffu);
        }
        for (int q = F.tid; q < 4096; q += 512) {
            const int idx = part * 4096 + q, j = idx & 7, ln = (idx >> 3) & 63, t = (idx >> 9) & 31, ks = idx >> 14, kq = ln >> 4;
            const int k = 32 * ks + 8 * kq + j, p = k & 63, co = ln & 15;
            const float cr = Cc[(co * 64 + p) * 2], ci = Cc[(co * 64 + p) * 2 + 1], ar = Apow[(p * 33 + t + 1) * 2], ai = Apow[(p * 33 + t + 1) * 2 + 1];
            const float v = (k < 64) ? (cr * ar - ci * ai) : -(cr * ai + ci * ar);
            Sf[idx] = (bf16)(pk2(v, 0.f) & 0xffffu);
        }
        __syncthreads();
    }
}

__device__ __forceinline__ void transpose_item(const float* W, int K, int N, bf16* WT, int mode, LAS float* scr, int item, int lane) {
    const int nblk = N / 32, kb = item / nblk, nb = item % nblk, k0 = 64 * kb, n0 = 32 * nb;
    float tv[32];
#pragma unroll
    for (int i = 0; i < 32; ++i) { const int kk = 2 * i + (lane >> 5); tv[i] = W[(size_t)(k0 + kk) * N + n0 + (lane & 31)]; }
#pragma unroll
    for (int i = 0; i < 32; ++i) { const int kk = 2 * i + (lane >> 5); scr[kk * 33 + (lane & 31)] = tv[i]; }
    LDS_WAIT(); asm volatile("" ::: "memory");
    const int c = lane & 7;
#pragma unroll
    for (int j = 0; j < 4; ++j) { const int n = (lane >> 3) + 8 * j; const LAS float* s = scr + (8 * c) * 33 + n;
        v4u o; o.x = pk2(s[0 * 33], s[1 * 33]); o.y = pk2(s[2 * 33], s[3 * 33]); o.z = pk2(s[4 * 33], s[5 * 33]); o.w = pk2(s[6 * 33], s[7 * 33]);
        const int ng = n0 + n; const int drow = mode == 0 ? ng : (256 * (ng >> 7) + (ng & 127) + (mode == 2 ? 128 : 0));
        *(GAS v4u*)(WT + (size_t)drow * K + k0 + 8 * c) = o; }
    LDS_WAIT(); asm volatile("" ::: "memory");
}
__device__ __forceinline__ float clamp8(float v) { return __builtin_amdgcn_fmed3f(v, -440.f, 440.f); }
__device__ __forceinline__ unsigned pk4_fp8(float a, float b, float c, float d) { int w = __builtin_amdgcn_cvt_pk_fp8_f32(clamp8(a), clamp8(b), 0, false); w = __builtin_amdgcn_cvt_pk_fp8_f32(clamp8(c), clamp8(d), w, true); return (unsigned)w; }
__device__ __forceinline__ void transpose_item_f8(const float* W, int K, int N, unsigned char* WT, int mode, float scale, LAS float* scr, int item, int lane) {
    const int nblk = N / 32, kb = item / nblk, nb = item % nblk, k0 = 64 * kb, n0 = 32 * nb;
    const int g = lane >> 3, c = lane & 7;
    f32x4 tv[8];
    const float* wp = W + (size_t)(k0 + 8 * g) * N + n0 + 4 * c;
#pragma unroll
    for (int i = 0; i < 8; ++i) tv[i] = *(const f32x4*)(wp + (size_t)i * N);
#pragma unroll
    for (int j = 0; j < 4; ++j) {
        v2u o; o.x = pk4_fp8(tv[0][j] * scale, tv[1][j] * scale, tv[2][j] * scale, tv[3][j] * scale); o.y = pk4_fp8(tv[4][j] * scale, tv[5][j] * scale, tv[6][j] * scale, tv[7][j] * scale);
        const int ng = n0 + 4 * c + j; const int drow = mode == 0 ? ng : (256 * (ng >> 7) + (ng & 127) + (mode == 2 ? 128 : 0));
        *(GAS v2u*)(WT + (size_t)drow * K + k0 + 8 * g) = o; }
    (void)scr;
}
#define WDESC(it, S) const float* W##S; unsigned char* D##S; int K##S, N##S, M##S, I##S; do { const int it_ = (it); \
        if (it_ < I0) { W##S = F.in[I_WIN]; D##S = F.ws + WS_WIN; K##S = 1024; N##S = NPROJ; M##S = 0; I##S = it_; } \
        else if (it_ < I1) { W##S = F.in[I_WATT]; D##S = F.ws + WS_WO; K##S = 512; N##S = 1024; M##S = 0; I##S = it_ - I0; } \
        else if (it_ < I2) { W##S = F.in[I_WGLUV]; D##S = F.ws + WS_WGLU; K##S = 256; N##S = 1024; M##S = 1; I##S = it_ - I1; } \
        else if (it_ < I3) { W##S = F.in[I_WGLUG]; D##S = F.ws + WS_WGLU; K##S = 256; N##S = 1024; M##S = 2; I##S = it_ - I2; } \
        else if (it_ < I4) { W##S = F.in[I_WMIX]; D##S = F.ws + WS_WMIX; K##S = 1024; N##S = 1024; M##S = 0; I##S = it_ - I3; } \
        else if (it_ < I5) { const int r_ = it_ - I4, e_ = r_ >> 8; W##S = F.in[I_WEG] + (size_t)e_ * 1024 * 512; D##S = F.ws + WS_WGU + (size_t)e_ * 1024 * 1024; K##S = 1024; N##S = 512; M##S = 1; I##S = r_ & 255; } \
        else if (it_ < I6) { const int r_ = it_ - I5, e_ = r_ >> 8; W##S = F.in[I_WEU] + (size_t)e_ * 1024 * 512; D##S = F.ws + WS_WGU + (size_t)e_ * 1024 * 1024; K##S = 1024; N##S = 512; M##S = 2; I##S = r_ & 255; } \
        else { const int r_ = it_ - I6, e_ = r_ >> 8; W##S = F.in[I_WED] + (size_t)e_ * 512 * 1024; D##S = F.ws + WS_WDN + (size_t)e_ * 1024 * 512; K##S = 512; N##S = 1024; M##S = 0; I##S = r_ & 255; } } while (0)
#define WLOAD(S, tv) do { const int nblk_ = N##S / 32, kb_ = I##S / nblk_, nb_ = I##S % nblk_; const float* wp_ = W##S + (size_t)(64 * kb_ + 8 * (lane >> 3)) * N##S + 32 * nb_ + 4 * (lane & 7); \
        _Pragma("unroll") for (int i = 0; i < 8; ++i) tv[i] = __builtin_nontemporal_load((const f32x4*)(wp_ + (size_t)i * N##S)); } while (0)
#define WSTORE(S, tv) do { const int nblk_ = N##S / 32, kb_ = I##S / nblk_, nb_ = I##S % nblk_, k0_ = 64 * kb_, n0_ = 32 * nb_, g_ = lane >> 3, c_ = lane & 7; \
        _Pragma("unroll") for (int j = 0; j < 4; ++j) { v2u o; o.x = pk4_fp8(tv[0][j] * W8_SCALE, tv[1][j] * W8_SCALE, tv[2][j] * W8_SCALE, tv[3][j] * W8_SCALE); o.y = pk4_fp8(tv[4][j] * W8_SCALE, tv[5][j] * W8_SCALE, tv[6][j] * W8_SCALE, tv[7][j] * W8_SCALE); \
            const int ng = n0_ + 4 * c_ + j; const int drow = M##S == 0 ? ng : (256 * (ng >> 7) + (ng & 127) + (M##S == 2 ? 128 : 0)); \
            *(GAS v2u*)(D##S + (size_t)drow * K##S + k0_ + 8 * g_) = o; } } while (0)
constexpr int WI_EXPERT = 16 * 120 + 8 * 32 + 4 * 32 + 4 * 32 + 16 * 32, WI_END = WI_EXPERT + 3 * 32 * 256;
__device__ __forceinline__ void p0_weights(Frame& F, const int lo, const int hi) {
    const int lane = F.lane; const int gw = F.vcu * NWAVES + F.wave, NGW = F.G * NWAVES;
    constexpr int I0 = 16 * 120, I1 = I0 + 8 * 32, I2 = I1 + 4 * 32, I3 = I2 + 4 * 32, I4 = I3 + 16 * 32, I5 = I4 + 32 * 256, I6 = I5 + 32 * 256, I7 = I6 + 32 * 256;
    static_assert(I4 == WI_EXPERT && I7 == WI_END, "item ranges");
    f32x4 nv[8];
    if (lo + gw < hi) { WDESC(lo + gw, a); WLOAD(a, nv); }
    for (int it = lo + gw; it < hi; it += NGW) {
        f32x4 cv[8];
#pragma unroll
        for (int i = 0; i < 8; ++i) cv[i] = nv[i];
        const int nit = it + NGW < hi ? it + NGW : it;
        { WDESC(nit, n); WLOAD(n, nv); }
        { WDESC(it, c); WSTORE(c, cv); }
    }
}
#undef WDESC
#undef WLOAD
#undef WSTORE

__device__ __forceinline__ void p1_xn(Frame& F) {
    const int gw = F.vcu * NWAVES + F.wave; const int row0 = gw * 32, b = row0 >> 12;
    const float* mod = (const float*)(F.ws + WS_MOD) + b * 6144; const float* g = F.in[I_GPREMIX];
    f32x4 A1[4], A3[4];
#pragma unroll
    for (int j = 0; j < 4; ++j) { const int c = 4 * F.lane + 256 * j; const f32x4 gg = *(const f32x4*)(g + c), sc = *(const f32x4*)(mod + 1024 + c); A1[j] = gg * (sc + 1.0f); A3[j] = *(const f32x4*)(mod + c); }
    unsigned char* XN = F.ws + WS_RA;
    f32x4 nx[4];
    { const f32x4* xr = (const f32x4*)(F.in[I_X] + (size_t)row0 * 1024) + F.lane;
#pragma unroll
      for (int j = 0; j < 4; ++j) nx[j] = __builtin_nontemporal_load(xr + 64 * j); }
    for (int r = 0; r < 32; ++r) {
        const size_t row = (size_t)(row0 + r);
        f32x4 v[4]; float s = 0.f;
#pragma unroll
        for (int j = 0; j < 4; ++j) v[j] = nx[j];
        { const f32x4* xr = (const f32x4*)(F.in[I_X] + (row + (r < 31 ? 1 : 0)) * 1024) + F.lane;
#pragma unroll
          for (int j = 0; j < 4; ++j) nx[j] = __builtin_nontemporal_load(xr + 64 * j); }
#pragma unroll
        for (int j = 0; j < 4; ++j) s += (v[j].x * v[j].x + v[j].y * v[j].y) + (v[j].z * v[j].z + v[j].w * v[j].w);
        const float rstd = rsqrtf(wave_sum(s) * (1.0f / 1024.0f) + RMS_EPS);
        unsigned* o = (unsigned*)(XN + row * 1024) + F.lane;
#pragma unroll
        for (int j = 0; j < 4; ++j) { const f32x4 h = (v[j] * rstd * A1[j] + A3[j]) * A8_SCALE; o[64 * j] = pk4_fp8(h.x, h.y, h.z, h.w); }
    }
}

namespace att {
constexpr int LK = 0, LV = 32768, LBT = 65536, LKM = 67840, LWS = 72192, LSTG = 74240, LLIST = 111104;
constexpr int STG_ROW = 144, STG_WAVE = 32 * STG_ROW;
#define KSWZ64(row, colB) ((row) * 128 + ((colB) ^ ((((row) >> 1) & 7) << 4)))
__device__ __forceinline__ int crow(int r, int hi) { return (r & 3) + 8 * (r >> 2) + 4 * hi; }
__device__ __forceinline__ int v_st(int k, int c) { const int kk = (k & ~0xC) | ((k & 4) << 1) | ((k & 8) >> 1); return ((kk >> 3) * 2 + (c >> 5)) * 512 + ((kk & 7) * 32 + (c & 31)) * 2; }
__device__ __forceinline__ int v_rd_base(int lane) { return ((lane & 3) << 3) | (((lane >> 2) & 3) << 6) | (((lane >> 4) & 1) << 5) | (((lane >> 5) & 1) << 8); }
constexpr int v_rd_off(int d0, int ks, int half) { return d0 * 512 + ks * 2048 + half * 1024; }
template <int OFF> __device__ __forceinline__ s16x4 tr_read(int vb) { s16x4 r; asm volatile("ds_read_b64_tr_b16 %0, %1 offset:%2" : "=&v"(r) : "v"(vb), "i"(OFF) : "memory"); return r; }
#define SBAR() __builtin_amdgcn_sched_barrier(0)
template <int D0> __device__ __forceinline__ void pv_one(f32x16& od, int vb, bf16x8 pa0, bf16x8 pa1, bf16x8 pa2, bf16x8 pa3) {
    const s16x4 l0 = tr_read<v_rd_off(D0, 0, 0)>(vb), h0 = tr_read<v_rd_off(D0, 0, 1)>(vb), l1 = tr_read<v_rd_off(D0, 1, 0)>(vb), h1 = tr_read<v_rd_off(D0, 1, 1)>(vb);
    const s16x4 l2 = tr_read<v_rd_off(D0, 2, 0)>(vb), h2 = tr_read<v_rd_off(D0, 2, 1)>(vb), l3 = tr_read<v_rd_off(D0, 3, 0)>(vb), h3 = tr_read<v_rd_off(D0, 3, 1)>(vb);
    asm volatile("s_waitcnt lgkmcnt(0)" ::: "memory"); SBAR();
#define PK(L, H) (bf16x8){L[0], L[1], L[2], L[3], H[0], H[1], H[2], H[3]}
    od = __builtin_amdgcn_mfma_f32_32x32x16_bf16(pa0, PK(l0, h0), od, 0, 0, 0);
    od = __builtin_amdgcn_mfma_f32_32x32x16_bf16(pa1, PK(l1, h1), od, 0, 0, 0);
    od = __builtin_amdgcn_mfma_f32_32x32x16_bf16(pa2, PK(l2, h2), od, 0, 0, 0);
    od = __builtin_amdgcn_mfma_f32_32x32x16_bf16(pa3, PK(l3, h3), od, 0, 0, 0);
#undef PK
}
__device__ __forceinline__ void pv_two(f32x16 (&o)[2], int vb, bf16x8 pa0, bf16x8 pa1, bf16x8 pa2, bf16x8 pa3) {
    const s16x4 l0 = tr_read<v_rd_off(0, 0, 0)>(vb), h0 = tr_read<v_rd_off(0, 0, 1)>(vb), l1 = tr_read<v_rd_off(0, 1, 0)>(vb), h1 = tr_read<v_rd_off(0, 1, 1)>(vb);
    const s16x4 l2 = tr_read<v_rd_off(0, 2, 0)>(vb), h2 = tr_read<v_rd_off(0, 2, 1)>(vb), l3 = tr_read<v_rd_off(0, 3, 0)>(vb), h3 = tr_read<v_rd_off(0, 3, 1)>(vb);
    const s16x4 m0 = tr_read<v_rd_off(1, 0, 0)>(vb), g0 = tr_read<v_rd_off(1, 0, 1)>(vb), m1 = tr_read<v_rd_off(1, 1, 0)>(vb), g1 = tr_read<v_rd_off(1, 1, 1)>(vb);
    const s16x4 m2 = tr_read<v_rd_off(1, 2, 0)>(vb), g2 = tr_read<v_rd_off(1, 2, 1)>(vb), m3 = tr_read<v_rd_off(1, 3, 0)>(vb), g3 = tr_read<v_rd_off(1, 3, 1)>(vb);
    asm volatile("s_waitcnt lgkmcnt(8)" ::: "memory"); SBAR();
#define PK(L, H) (bf16x8){L[0], L[1], L[2], L[3], H[0], H[1], H[2], H[3]}
    o[0] = __builtin_amdgcn_mfma_f32_32x32x16_bf16(pa0, PK(l0, h0), o[0], 0, 0, 0);
    o[0] = __builtin_amdgcn_mfma_f32_32x32x16_bf16(pa1, PK(l1, h1), o[0], 0, 0, 0);
    o[0] = __builtin_amdgcn_mfma_f32_32x32x16_bf16(pa2, PK(l2, h2), o[0], 0, 0, 0);
    o[0] = __builtin_amdgcn_mfma_f32_32x32x16_bf16(pa3, PK(l3, h3), o[0], 0, 0, 0);
    asm volatile("s_waitcnt lgkmcnt(0)" ::: "memory"); SBAR();
    o[1] = __builtin_amdgcn_mfma_f32_32x32x16_bf16(pa0, PK(m0, g0), o[1], 0, 0, 0);
    o[1] = __builtin_amdgcn_mfma_f32_32x32x16_bf16(pa1, PK(m1, g1), o[1], 0, 0, 0);
    o[1] = __builtin_amdgcn_mfma_f32_32x32x16_bf16(pa2, PK(m2, g2), o[1], 0, 0, 0);
    o[1] = __builtin_amdgcn_mfma_f32_32x32x16_bf16(pa3, PK(m3, g3), o[1], 0, 0, 0);
#undef PK
}
__device__ __forceinline__ void stage_kv(Frame& F, size_t rowb, int h, int key0, int ntile) {
    const bf16* Kg = (const bf16*)(F.ws + WS_K); const bf16* Vg = (const bf16*)(F.ws + WS_V);
    const int sr = F.tid >> 3, sc = (F.tid & 7) * 8; const int kst = KSWZ64(sr, sc * 2), vst = v_st(sr, sc);
    for (int t = 0; t < ntile; ++t) { const size_t go = (rowb + key0 + t * 64 + sr) * ATTW + h * HD + sc;
        const bf16x8 kv = *(const bf16x8*)(Kg + go), vv = *(const bf16x8*)(Vg + go);
        *(LAS bf16x8*)(F.lds + LK + t * 8192 + kst) = kv; *(LAS bf16x8*)(F.lds + LV + t * 8192 + vst) = vv; }
}
template <bool GENERAL> __device__ __forceinline__ void tile_step(LAS unsigned char* L, int kt, const bf16x8 (&qr)[4], float cinit, int ib, float& m_reg, float& l_reg, f32x16 (&o)[2],
                                                                  LAS float* wsf, int r32, int hi, int vb0) {
    f32x16 p0, p1;
#pragma unroll
    for (int r = 0; r < 16; ++r) { p0[r] = cinit; p1[r] = cinit; }
    const LAS unsigned char* Kt = L + LK + kt * 8192;
#pragma unroll
    for (int d0 = 0; d0 < 4; ++d0) { const int cb = (d0 * 16 + hi * 8) * 2;
        const bf16x8 k0 = *(const LAS bf16x8*)(Kt + KSWZ64(r32, cb)); const bf16x8 k1 = *(const LAS bf16x8*)(Kt + KSWZ64(32 + r32, cb));
        p0 = __builtin_amdgcn_mfma_f32_32x32x16_bf16(k0, qr[d0], p0, 0, 0, 0);
        p1 = __builtin_amdgcn_mfma_f32_32x32x16_bf16(k1, qr[d0], p1, 0, 0, 0); }
    if (GENERAL) {
        const LAS float* btab = (const LAS float*)(L + LBT);
        float bv0[16], bv1[16];
#pragma unroll
        for (int r = 0; r < 16; ++r) { const int c = (r & 3) + 8 * (r >> 2); bv0[r] = btab[ib - c]; bv1[r] = btab[ib - 32 - c]; }
        SBAR();
#pragma unroll
        for (int r = 0; r < 16; ++r) { p0[r] += bv0[r]; p1[r] += bv1[r]; }
    }
    float pmax = p0[0];
#pragma unroll
    for (int r = 1; r < 16; ++r) pmax = fmaxf(pmax, p0[r]);
#pragma unroll
    for (int r = 0; r < 16; ++r) pmax = fmaxf(pmax, p1[r]);
    { auto rr = __builtin_amdgcn_permlane32_swap(__float_as_uint(pmax), __float_as_uint(pmax), false, false); pmax = fmaxf(__uint_as_float(rr[0]), __uint_as_float(rr[1])); }
    pmax = fmaxf(pmax, -1e20f);
    const float mn = fmaxf(m_reg, pmax); const float alpha = __builtin_amdgcn_exp2f(m_reg - mn); m_reg = mn;
    float ps = 0.f;
#pragma unroll
    for (int r = 0; r < 16; ++r) { p0[r] = __builtin_amdgcn_exp2f(p0[r] - mn); p1[r] = __builtin_amdgcn_exp2f(p1[r] - mn); ps += p0[r] + p1[r]; }
    { auto rr = __builtin_amdgcn_permlane32_swap(__float_as_uint(ps), __float_as_uint(ps), false, false); ps = __uint_as_float(rr[0]) + __uint_as_float(rr[1]); }
    l_reg = l_reg * alpha + ps;
    bf16x8 pa0, pa1, pa2, pa3;
#define PK4(P, BASE, OUT) do { unsigned a0 = pk2(P[BASE + 0], P[BASE + 1]), a1 = pk2(P[BASE + 2], P[BASE + 3]); \
    unsigned b0 = pk2(P[BASE + 4], P[BASE + 5]), b1 = pk2(P[BASE + 6], P[BASE + 7]); \
    auto r0 = __builtin_amdgcn_permlane32_swap(a0, b0, false, false); auto r1 = __builtin_amdgcn_permlane32_swap(a1, b1, false, false); \
    v4u w = {r0[0], r1[0], r0[1], r1[1]}; OUT = __builtin_bit_cast(bf16x8, w); } while (0)
    PK4(p0, 0, pa0); PK4(p0, 8, pa1); PK4(p1, 0, pa2); PK4(p1, 8, pa3);
#undef PK4
    if (__any(alpha < 1.f)) { if (hi == 0) wsf[r32] = alpha; LDS_WAIT();
#pragma unroll
        for (int r = 0; r < 16; ++r) { const float a = wsf[crow(r, hi)]; o[0][r] *= a; o[1][r] *= a; }
        LDS_WAIT(); }
    const int vb = vb0 + kt * 8192;
    pv_one<0>(o[0], vb, pa0, pa1, pa2, pa3); pv_one<1>(o[1], vb, pa0, pa1, pa2, pa3);
}

__device__ __forceinline__ bool owned(int qb, int sub) { const int q = qb & 3; return sub ? (q == 1 || q == 2) : (q == 0 || q == 3); }
__device__ __forceinline__ void select_rows(Frame& F, int b, int h, int half) {
    LAS float* kmean = (LAS float*)(F.lds + LKM);
    LAS unsigned short* mloc = (LAS unsigned short*)(F.lds + LK);
    LAS int* lcnt = (LAS int*)(F.lds + LK + 4096);
    { const float* kp = (const float*)(F.ws + WS_KPART);
      for (int i = F.tid; i < 1024; i += 512) { const int n = i >> 6, d = i & 63; const size_t o = (size_t)((b * 16 + n) * 2) * 512 + h * 64 + d; kmean[i] = (kp[o] + kp[o + 512]) * (1.0f / 256.0f); }
      if (F.tid < 32) lcnt[F.tid] = 0; }
    __syncthreads();
    const bf16* Qg = (const bf16*)(F.ws + WS_Q); unsigned short* sel = (unsigned short*)(F.ws + WS_SEL);
    for (int c = 0; c < 4; ++c) {
        const int row = half * 2048 + c * 512 + F.tid, qb = row >> 8;
        const v4u* qp = (const v4u*)(Qg + ((size_t)b * SEQ + row) * ATTW + h * HD);
        float qf[64];
#pragma unroll
        for (int i = 0; i < 8; ++i) { const v4u w = qp[i]; qf[8 * i] = bflo(w.x); qf[8 * i + 1] = bfhi(w.x); qf[8 * i + 2] = bflo(w.y); qf[8 * i + 3] = bfhi(w.y); qf[8 * i + 4] = bflo(w.z); qf[8 * i + 5] = bfhi(w.z); qf[8 * i + 6] = bflo(w.w); qf[8 * i + 7] = bfhi(w.w); }
        float v0 = -3.0e38f, v1 = -3.0e38f, v2 = -3.0e38f; int i0 = -1, i1 = -1, i2 = -1;
        for (int n = 0; n < qb; ++n) {
            float g = 0.f;
#pragma unroll
            for (int d = 0; d < 64; ++d) g += qf[d] * kmean[n * 64 + d];
            if (g > v0) { v2 = v1; i2 = i1; v1 = v0; i1 = i0; v0 = g; i0 = n; }
            else if (g > v1) { v2 = v1; i2 = i1; v1 = g; i1 = n; }
            else if (g > v2) { v2 = g; i2 = n; }
        }
        unsigned m = 0u; if (i0 >= 0) m |= 1u << i0; if (i1 >= 0) m |= 1u << i1; if (i2 >= 0) m |= 1u << i2;
        sel[((size_t)(b * NH + h)) * SEQ + row] = (unsigned short)m; mloc[c * 512 + F.tid] = (unsigned short)m;
    }
    __syncthreads();
    unsigned short* rl = (unsigned short*)(F.ws + WS_RLIST) + ((size_t)(b * NH + h) * 16) * 4 * 1024;
    for (int qi = 0; qi < 8; ++qi) {
        const int qb = half * 8 + qi, sub = owned(qb, 0) ? 0 : 1;
        if (F.tid < 256) { const int lr = qi * 256 + F.tid; unsigned m = mloc[lr];
            while (m) { const int n = __builtin_ctz(m); m &= m - 1u; const int pos = __hip_atomic_fetch_add(lcnt + n * 2 + sub, 1, __ATOMIC_RELAXED, __HIP_MEMORY_SCOPE_WORKGROUP);
                rl[((size_t)(n * 2 + sub) * 2 + half) * 1024 + pos] = (unsigned short)(half * 2048 + lr); } }
        __syncthreads();
    }
    if (F.tid < 32) { int* rc = (int*)(F.ws + WS_RCNT) + ((size_t)(b * NH + h) * 16) * 4; rc[F.tid * 2 + half] = lcnt[F.tid]; }
    __syncthreads();
}

template <bool GENERAL, bool FIRST, bool PREF> __device__ __forceinline__ void tile_pair(LAS unsigned char* L, int kt0, bf16x8 (&qr)[4], float cinit, int ib, float& m_reg, float& l_reg, f32x16 (&o)[2],
                                                                             LAS float* wsf, int r32, int hi, int vb0, const bf16* qnext) {
    f32x16 s[2][2];
#pragma unroll
    for (int t = 0; t < 2; ++t) {
#pragma unroll
        for (int r = 0; r < 16; ++r) { s[t][0][r] = cinit; s[t][1][r] = cinit; }
        const LAS unsigned char* Kt = L + LK + (kt0 + t) * 8192;
#pragma unroll
        for (int d0 = 0; d0 < 4; ++d0) { const int cb = (d0 * 16 + hi * 8) * 2;
            const bf16x8 k0 = *(const LAS bf16x8*)(Kt + KSWZ64(r32, cb)); const bf16x8 k1 = *(const LAS bf16x8*)(Kt + KSWZ64(32 + r32, cb));
            s[t][0] = __builtin_amdgcn_mfma_f32_32x32x16_bf16(k0, qr[d0], s[t][0], 0, 0, 0);
            s[t][1] = __builtin_amdgcn_mfma_f32_32x32x16_bf16(k1, qr[d0], s[t][1], 0, 0, 0); }
    }
    if (PREF) {
#pragma unroll
        for (int d0 = 0; d0 < 4; ++d0) qr[d0] = *(const bf16x8*)(qnext + d0 * 16); }
    if (GENERAL) {
        const LAS float* btab = (const LAS float*)(L + LBT);
#pragma unroll
        for (int t = 0; t < 2; ++t) { float bv0[16], bv1[16];
#pragma unroll
            for (int r = 0; r < 16; ++r) { const int c = (r & 3) + 8 * (r >> 2); int i0 = ib - t * 64 - c, i1 = ib - t * 64 - 32 - c; i0 = i0 < 575 ? i0 : 575; i1 = i1 < 575 ? i1 : 575; bv0[r] = btab[i0]; bv1[r] = btab[i1]; }
            SBAR();
#pragma unroll
            for (int r = 0; r < 16; ++r) { s[t][0][r] += bv0[r]; s[t][1][r] += bv1[r]; } }
    }
    float pmax = fmaxf(s[0][0][0], s[1][0][0]);
#pragma unroll
    for (int r = 0; r < 16; ++r) pmax = fmaxf(pmax, fmaxf(fmaxf(s[0][0][r], s[0][1][r]), fmaxf(s[1][0][r], s[1][1][r])));
    { auto rr = __builtin_amdgcn_permlane32_swap(__float_as_uint(pmax), __float_as_uint(pmax), false, false); pmax = fmaxf(__uint_as_float(rr[0]), __uint_as_float(rr[1])); }
    pmax = fmaxf(pmax, -1e20f);
    const float mn = fmaxf(m_reg, pmax); const float alpha = __builtin_amdgcn_exp2f(m_reg - mn); m_reg = mn;
    float ps = 0.f;
#pragma unroll
    for (int t = 0; t < 2; ++t)
#pragma unroll
        for (int r = 0; r < 16; ++r) { s[t][0][r] = __builtin_amdgcn_exp2f(s[t][0][r] - mn); s[t][1][r] = __builtin_amdgcn_exp2f(s[t][1][r] - mn); ps += s[t][0][r] + s[t][1][r]; }
    { auto rr = __builtin_amdgcn_permlane32_swap(__float_as_uint(ps), __float_as_uint(ps), false, false); ps = __uint_as_float(rr[0]) + __uint_as_float(rr[1]); }
    l_reg = FIRST ? ps : (l_reg * alpha + ps);
    if (!FIRST) { if (__any(alpha < 1.f)) { if (hi == 0) wsf[r32] = alpha; LDS_WAIT();
#pragma unroll
        for (int r = 0; r < 16; ++r) { const float a = wsf[crow(r, hi)]; o[0][r] *= a; o[1][r] *= a; }
        LDS_WAIT(); } }
#define PK4(P, BASE, OUT) do { unsigned a0 = pk2(P[BASE + 0], P[BASE + 1]), a1 = pk2(P[BASE + 2], P[BASE + 3]); \
    unsigned b0 = pk2(P[BASE + 4], P[BASE + 5]), b1 = pk2(P[BASE + 6], P[BASE + 7]); \
    auto r0 = __builtin_amdgcn_permlane32_swap(a0, b0, false, false); auto r1 = __builtin_amdgcn_permlane32_swap(a1, b1, false, false); \
    v4u w = {r0[0], r1[0], r0[1], r1[1]}; OUT = __builtin_bit_cast(bf16x8, w); } while (0)
#pragma unroll
    for (int t = 0; t < 2; ++t) { bf16x8 pa0, pa1, pa2, pa3;
        PK4(s[t][0], 0, pa0); PK4(s[t][0], 8, pa1); PK4(s[t][1], 0, pa2); PK4(s[t][1], 8, pa3);
        const int vb = vb0 + (kt0 + t) * 8192;
        pv_one<0>(o[0], vb, pa0, pa1, pa2, pa3); pv_one<1>(o[1], vb, pa0, pa1, pa2, pa3); }
#undef PK4
}

struct MobaPre { bf16x8 k[4], v[4]; v2u lw; int c0, c1; };
__device__ __forceinline__ void moba_preload(Frame& F, int b, int h, int n, int sub, MobaPre& P) {
    int tid = F.tid; asm volatile("" : "+v"(tid));
    const size_t rowb = (size_t)b * SEQ; const int sr = tid >> 3, sc = (tid & 7) * 8;
    const bf16* Kg = (const bf16*)(F.ws + WS_K); const bf16* Vg = (const bf16*)(F.ws + WS_V);
#pragma unroll
    for (int t = 0; t < 4; ++t) { const size_t go = (rowb + n * 256 + t * 64 + sr) * ATTW + h * HD + sc; P.k[t] = *(const bf16x8*)(Kg + go); P.v[t] = *(const bf16x8*)(Vg + go); }
    const int* rc = (const int*)(F.ws + WS_RCNT) + (((size_t)(b * NH + h) * 16 + n) * 2 + sub) * 2;
    P.c0 = rc[0]; P.c1 = rc[1];
    const int hf = tid >> 8, e0 = (tid & 255) * 4;
    P.lw = *(const v2u*)((const unsigned short*)(F.ws + WS_RLIST) + ((((size_t)(b * NH + h) * 16 + n) * 2 + sub) * 2 + hf) * 1024 + e0);
}
__device__ __forceinline__ void moba_unit(Frame& F, int b, int h, int n, int sub, MobaPre& P) {
    const int tid = F.tid, lane = F.lane, wid = F.wave, r32 = lane & 31, hi = lane >> 5;
    LAS unsigned char* L = F.lds; const size_t rowb = (size_t)b * SEQ;
    LAS float* btab = (LAS float*)(L + LBT); LAS float* wsf = (LAS float*)(L + LWS) + wid * 64;
    LAS unsigned short* list = (LAS unsigned short*)(L + LLIST); LAS int* qctr = (LAS int*)(L + LKM + 64);
    const unsigned short* sel = (const unsigned short*)(F.ws + WS_SEL) + ((size_t)(b * NH + h)) * SEQ;
    __syncthreads();
    const int sr = tid >> 3, sc = (tid & 7) * 8; const int kst = KSWZ64(sr, sc * 2), vst = v_st(sr, sc);
    const int c0 = P.c0, c1 = P.c1;
    { const int hf = tid >> 8, e0 = (tid & 255) * 4; const int ch = hf ? c1 : c0, ob = hf ? c0 : 0; const v2u w = P.lw;
      if (e0 < ch) {
          list[ob + e0] = (unsigned short)(w.x & 0xffffu); if (e0 + 1 < ch) list[ob + e0 + 1] = (unsigned short)(w.x >> 16);
          if (e0 + 2 < ch) list[ob + e0 + 2] = (unsigned short)(w.y & 0xffffu); if (e0 + 3 < ch) list[ob + e0 + 3] = (unsigned short)(w.y >> 16); } }
    const int base = c0 + c1;
#pragma unroll
    for (int t = 0; t < 4; ++t) { *(LAS bf16x8*)(L + LK + t * 8192 + kst) = P.k[t]; *(LAS bf16x8*)(L + LV + t * 8192 + vst) = P.v[t]; }
    if (tid == 0) qctr[0] = 0;
    __syncthreads();
    const int count = base; const int ngroups = (count + 31) >> 5;
    const int nown = owned(n, sub) ? 8 : 0, nitems = nown + ngroups;
    const float b31 = btab[64 + 200];
    const int vb0 = (int)(unsigned)(uintptr_t)(L + LV) + v_rd_base(lane);
    const bf16* Qg = (const bf16*)(F.ws + WS_Q);
    unsigned char* PO8 = (unsigned char*)F.out; float* PL = (float*)(F.ws + WS_PL);
    typedef float f32x2_ __attribute__((ext_vector_type(2)));
    LAS unsigned char* stg = L + LSTG + wid * STG_WAVE;
#define PULL(v) do { int _v = 0; if (lane == 0) _v = __hip_atomic_fetch_add(qctr, 1, __ATOMIC_RELAXED, __HIP_MEMORY_SCOPE_WORKGROUP); v = __builtin_amdgcn_readfirstlane(_v); } while (0)
#define ITEM_ROW(it) (((it) < nown) ? (n * 256 + (7 - (it)) * 32 + r32) : (int)list[(((it) - nown) * 32 + r32) < count ? (((it) - nown) * 32 + r32) : count - 1])
    int cur; PULL(cur);
    bf16x8 qr[4]; int row = 0;
    if (cur < nitems) { row = ITEM_ROW(cur); const bf16* Qw = Qg + (rowb + row) * ATTW + h * HD + hi * 8;
#pragma unroll
        for (int d0 = 0; d0 < 4; ++d0) qr[d0] = *(const bf16x8*)(Qw + d0 * 16); }
    while (cur < nitems) {
        int nxt; PULL(nxt);
        const int rown = ITEM_ROW(nxt < nitems ? nxt : cur);
        const bf16* Qn = Qg + (rowb + rown) * ATTW + h * HD + hi * 8;
        float m_reg = -1e30f, l_reg = 0.f; f32x16 o[2]; o[0] = f32x16{}; o[1] = f32x16{};
        const unsigned msk = sel[row];
        if (cur < nown) {
            const int rg = 7 - cur; const int nkt = (rg >> 1) + 1;
            const size_t pi = ((rowb + row) * NH + h) * 3;
            float lsraw[3];
#pragma unroll
            for (int s = 0; s < 3; ++s) lsraw[s] = PL[pi + s];
            for (int kt = 0; kt < nkt; ++kt) tile_step<true>(L, kt, qr, 0.f, 64 + (rg * 32 + r32) - kt * 64 - 4 * hi, m_reg, l_reg, o, wsf, r32, hi, vb0);
            const int nv = __builtin_popcount(msk);
            const float lse_own = m_reg + __builtin_amdgcn_logf(l_reg);
            float ls[3]; float M = lse_own;
#pragma unroll
            for (int s = 0; s < 3; ++s) { ls[s] = (s < nv) ? lsraw[s] : -1e30f; M = fmaxf(M, ls[s]); }
            float wown = __builtin_amdgcn_exp2f(lse_own - M), ws_[3], W = wown;
#pragma unroll
            for (int s = 0; s < 3; ++s) { ws_[s] = __builtin_amdgcn_exp2f(ls[s] - M); W += ws_[s]; }
            const float rW = __builtin_amdgcn_rcpf(W);
            if (hi == 0) wsf[32 + r32] = wown * rW * __builtin_amdgcn_rcpf(l_reg); LDS_WAIT();
#pragma unroll
            for (int r = 0; r < 16; ++r) { const int orow = crow(r, hi); const float cf = wsf[32 + orow];
                *(LAS bf16*)(stg + orow * STG_ROW + r32 * 2) = (bf16)(pk2(o[0][r] * cf, 0.f) & 0xffffu); *(LAS bf16*)(stg + orow * STG_ROW + 64 + r32 * 2) = (bf16)(pk2(o[1][r] * cf, 0.f) & 0xffffu); }
            LDS_WAIT();
            float acc[32];
            { const LAS v4u* src = (const LAS v4u*)(stg + r32 * STG_ROW + hi * 64);
#pragma unroll
              for (int i = 0; i < 4; ++i) { const v4u w = src[i]; acc[8 * i] = bflo(w.x); acc[8 * i + 1] = bfhi(w.x); acc[8 * i + 2] = bflo(w.y); acc[8 * i + 3] = bfhi(w.y); acc[8 * i + 4] = bflo(w.z); acc[8 * i + 5] = bfhi(w.z); acc[8 * i + 6] = bflo(w.w); acc[8 * i + 7] = bfhi(w.w); } }
#pragma unroll
            for (int s = 0; s < 3; ++s) if (s < nv) { const float cs = ws_[s] * rW * (1.0f / A8_SCALE); const v4u* src = (const v4u*)(PO8 + (pi + s) * 64) + hi * 2;
#pragma unroll
                for (int i = 0; i < 2; ++i) { const v4u w = src[i]; const unsigned ww[4] = {w.x, w.y, w.z, w.w};
#pragma unroll
                    for (int q = 0; q < 4; ++q) { const f32x2_ lo = __builtin_amdgcn_cvt_pk_f32_fp8((int)ww[q], false), hi2 = __builtin_amdgcn_cvt_pk_f32_fp8((int)ww[q], true);
                        acc[16 * i + 4 * q] += cs * lo.x; acc[16 * i + 4 * q + 1] += cs * lo.y; acc[16 * i + 4 * q + 2] += cs * hi2.x; acc[16 * i + 4 * q + 3] += cs * hi2.y; } }
                asm volatile("" ::: "memory"); }
            { v4u* dst = (v4u*)(F.ws + WS_ATT + (rowb + row) * ATTW + h * HD) + hi * 2;
#pragma unroll
              for (int i = 0; i < 2; ++i) { v4u w; const float* a = acc + 16 * i;
                  w.x = pk4_fp8(a[0] * A8_SCALE, a[1] * A8_SCALE, a[2] * A8_SCALE, a[3] * A8_SCALE); w.y = pk4_fp8(a[4] * A8_SCALE, a[5] * A8_SCALE, a[6] * A8_SCALE, a[7] * A8_SCALE);
                  w.z = pk4_fp8(a[8] * A8_SCALE, a[9] * A8_SCALE, a[10] * A8_SCALE, a[11] * A8_SCALE); w.w = pk4_fp8(a[12] * A8_SCALE, a[13] * A8_SCALE, a[14] * A8_SCALE, a[15] * A8_SCALE); dst[i] = w; } }
            LDS_WAIT();
#pragma unroll
            for (int d0 = 0; d0 < 4; ++d0) qr[d0] = *(const bf16x8*)(Qn + d0 * 16);
        } else {
            const bool valid = ((cur - nown) * 32 + r32) < count;
            const bool adj = __any((row >> 8) == n + 1);
            if (adj) { const int ib = 64 + row - n * 256 - 4 * hi;
                tile_pair<true, true, false>(L, 0, qr, 0.f, ib, m_reg, l_reg, o, wsf, r32, hi, vb0, Qn); tile_pair<true, false, true>(L, 2, qr, 0.f, ib - 128, m_reg, l_reg, o, wsf, r32, hi, vb0, Qn); }
            else { tile_pair<false, true, false>(L, 0, qr, b31, 0, m_reg, l_reg, o, wsf, r32, hi, vb0, Qn); tile_pair<false, false, true>(L, 2, qr, b31, 0, m_reg, l_reg, o, wsf, r32, hi, vb0, Qn); }
            if (hi == 0) wsf[32 + r32] = l_reg; LDS_WAIT();
#pragma unroll
            for (int r = 0; r < 16; ++r) { const int orow = crow(r, hi); const float rl = __builtin_amdgcn_rcpf(wsf[32 + orow]);
                *(LAS bf16*)(stg + orow * STG_ROW + r32 * 2) = (bf16)(pk2(o[0][r] * rl, 0.f) & 0xffffu); *(LAS bf16*)(stg + orow * STG_ROW + 64 + r32 * 2) = (bf16)(pk2(o[1][r] * rl, 0.f) & 0xffffu); }
            LDS_WAIT();
            if (valid) {
                const int slot = __builtin_popcount(msk & ((1u << n) - 1u));
                const size_t pi = ((rowb + row) * NH + h) * 3 + slot;
                v4u* dst = (v4u*)(PO8 + pi * 64) + hi * 2; const LAS v4u* src = (const LAS v4u*)(stg + r32 * STG_ROW + hi * 64);
#pragma unroll
                for (int i = 0; i < 2; ++i) { const v4u a = src[2 * i], c = src[2 * i + 1]; v4u w;
                    w.x = pk4_fp8(bflo(a.x) * A8_SCALE, bfhi(a.x) * A8_SCALE, bflo(a.y) * A8_SCALE, bfhi(a.y) * A8_SCALE); w.y = pk4_fp8(bflo(a.z) * A8_SCALE, bfhi(a.z) * A8_SCALE, bflo(a.w) * A8_SCALE, bfhi(a.w) * A8_SCALE);
                    w.z = pk4_fp8(bflo(c.x) * A8_SCALE, bfhi(c.x) * A8_SCALE, bflo(c.y) * A8_SCALE, bfhi(c.y) * A8_SCALE); w.w = pk4_fp8(bflo(c.z) * A8_SCALE, bfhi(c.z) * A8_SCALE, bflo(c.w) * A8_SCALE, bfhi(c.w) * A8_SCALE); dst[i] = w; }
                if (hi == 0) PL[pi] = m_reg + __builtin_amdgcn_logf(l_reg);
            }
            LDS_WAIT();
        }
        cur = nxt; row = rown;
    }
#undef PULL
#undef ITEM_ROW
    asm volatile("" ::: "memory"); __builtin_amdgcn_sched_barrier(0);
    moba_preload(F, b, h, n + 1 < 16 ? n + 1 : 15, sub, P);
}
#undef SBAR
}

namespace ssm {
constexpr int LW = 0, LX = 65536, XSTR = 136, LT = 100352, LT2 = RING_BYTES + 2048;
static_assert(LX + 128 * XSTR * 2 <= LT && LT + 30 * 1024 <= RING_BYTES && LT2 >= TILEE_OFF && LT2 + 2048 <= LDS_BYTES, "SSM LDS map");
__device__ __forceinline__ float gelu_tanh(float x) {
    const float a = 0.7978845608028654f * (x + 0.044715f * x * x * x);
    const float e = __builtin_amdgcn_exp2f(2.0f * LOG2E * a);
    const float th = 1.0f - 2.0f * __builtin_amdgcn_rcpf(1.0f + e);
    return 0.5f * x * (1.0f + th);
}
__device__ __forceinline__ void ssm_unit(Frame& F, int b, int g) {
    const int lane = F.lane, w = F.wave, m = lane & 15, kq = lane >> 4;
    LAS unsigned char* L = F.lds;
    const bf16* Ug = (const bf16*)(F.ws + WS_U); unsigned char* Zg = F.ws + WS_Z;
    const unsigned char* gb = F.ws + WS_SSMTAB + (size_t)g * SSM_GRP_BYTES;
    const bf16x8* Wf = (const bf16x8*)(gb + SSM_W_OFF) + lane; const bf16x8* Sf = (const bf16x8*)(gb + SSM_S_OFF) + lane;
    const size_t rowb = (size_t)b * SEQ;
    bf16x8 A[16];
    { const bf16* up = Ug + (rowb + (size_t)(16 * w + m) * 32 + (kq >> 1)) * SSMW + g * 16 + 8 * (kq & 1);
#pragma unroll
      for (int ks = 0; ks < 16; ++ks) A[ks] = *(const bf16x8*)(up + (size_t)(2 * ks) * SSMW); }
    LAS float* Wl = (LAS float*)(L + LW);
    bf16x8 Bq[16], Bn[16];
#pragma unroll
    for (int ks = 0; ks < 16; ++ks) Bq[ks] = Wf[(ks * 8) * 64];
#define SSM_S1(BC, BN, nt_) do { const int ntn_ = (nt_) + 1 < 8 ? (nt_) + 1 : 7; \
        _Pragma("unroll") for (int ks = 0; ks < 16; ++ks) BN[ks] = Wf[(ks * 8 + ntn_) * 64]; \
        __builtin_amdgcn_sched_barrier(0); \
        pg8::f32x4 acc = {0.f, 0.f, 0.f, 0.f}, ac1 = acc, ac2 = acc, ac3 = acc;     \
        _Pragma("unroll") for (int ks = 0; ks < 16; ks += 4) { acc = __builtin_amdgcn_mfma_f32_16x16x32_bf16(A[ks], BC[ks], acc, 0, 0, 0); ac1 = __builtin_amdgcn_mfma_f32_16x16x32_bf16(A[ks + 1], BC[ks + 1], ac1, 0, 0, 0); \
            ac2 = __builtin_amdgcn_mfma_f32_16x16x32_bf16(A[ks + 2], BC[ks + 2], ac2, 0, 0, 0); ac3 = __builtin_amdgcn_mfma_f32_16x16x32_bf16(A[ks + 3], BC[ks + 3], ac3, 0, 0, 0); } \
        acc = (acc + ac1) + (ac2 + ac3); \
        _Pragma("unroll") for (int r = 0; r < 4; ++r) Wl[(16 * w + 4 * kq + r) * 128 + 16 * (nt_) + m] = acc[r]; } while (0)
#pragma unroll 1
    for (int nt = 0; nt < 8; nt += 2) { SSM_S1(Bq, Bn, nt); SSM_S1(Bn, Bq, nt + 1); }
#undef SSM_S1
    __syncthreads();
    bf16x8 tst[4];
#pragma unroll
    for (int i = 0; i < 4; ++i) tst[i] = *((const bf16x8*)(gb + SSM_T_OFF) + F.tid + 512 * i);
    LAS bf16* Xl = (LAS bf16*)(L + LX);
    if (F.tid < 64) {
        const int p = F.tid; const float* aL = (const float*)(F.ws + WS_SSMAL) + (g * 64 + p) * 2; const float ar = aL[0], ai = aL[1];
        float xr = 0.f, xi = 0.f;
#pragma unroll 8
        for (int c = 0; c < SSM_NCH; ++c) {
            Xl[c * XSTR + p] = (bf16)(pk2(xr, 0.f) & 0xffffu); Xl[c * XSTR + 64 + p] = (bf16)(pk2(xi, 0.f) & 0xffffu);
            const float wr_ = Wl[c * 128 + p], wi_ = Wl[c * 128 + 64 + p];
            const float nr = ar * xr - ai * xi + wr_, ni = ar * xi + ai * xr + wi_; xr = nr; xi = ni;
        }
    }
    bf16x8 Bs[4];
#pragma unroll
    for (int ks = 0; ks < 4; ++ks) Bs[ks] = Sf[(ks * 32) * 64];
#pragma unroll
    for (int i = 0; i < 4; ++i) { const int p = F.tid + 512 * i, e = p >> 6; *(LAS bf16x8*)(L + (e < 30 ? LT + e * 1024 : LT2 + (e - 30) * 1024) + (p & 63) * 16) = tst[i]; }
    __syncthreads();
    bf16x8 Xf[4];
#pragma unroll
    for (int ks = 0; ks < 4; ++ks) Xf[ks] = *(const LAS bf16x8*)(Xl + (16 * w + m) * XSTR + 32 * ks + 8 * kq);
#pragma unroll 1
    for (int par = 0; par < 2; ++par) {
        const bf16x8 zf = {0, 0, 0, 0, 0, 0, 0, 0};
        bf16x8 R[17], Bs1[4];
#pragma unroll
        for (int k = 0; k < 17; ++k) R[k] = zf;
#pragma unroll 1
        for (int tt0 = 0; tt0 < 16; tt0 += 2) {
#pragma unroll
            for (int k = 14; k >= 0; --k) { R[k + 2] = R[k]; asm volatile("" : "+v"(R[k + 2])); }
#pragma unroll
            for (int j4 = 0; j4 < 2; ++j4) { const int e = par + 2 * (tt0 + j4); R[1 - j4] = *(const LAS bf16x8*)(L + (e < 30 ? LT + e * 1024 : LT2 + (e - 30) * 1024) + lane * 16); }
#define SSM_STEP(j4, SC, SN) do { const int tt = tt0 + (j4), t = 2 * tt + par; \
                pg8::f32x4 acc = {0.f, 0.f, 0.f, 0.f}, ac1 = acc, ac2 = acc, ac3 = acc;     \
                { const int tn = tt + 1 < 16 ? t + 2 : (par == 0 ? 1 : 31);     \
                  _Pragma("unroll") for (int ks = 0; ks < 4; ++ks) SN[ks] = Sf[(ks * 32 + tn) * 64]; } \
                __builtin_amdgcn_sched_barrier(0); \
                acc = __builtin_amdgcn_mfma_f32_16x16x32_bf16(Xf[0], SC[0], acc, 0, 0, 0); ac1 = __builtin_amdgcn_mfma_f32_16x16x32_bf16(Xf[1], SC[1], ac1, 0, 0, 0); \
                ac2 = __builtin_amdgcn_mfma_f32_16x16x32_bf16(Xf[2], SC[2], ac2, 0, 0, 0); ac3 = __builtin_amdgcn_mfma_f32_16x16x32_bf16(Xf[3], SC[3], ac3, 0, 0, 0); \
                _Pragma("unroll") for (int ks = 0; ks < 16; ks += 4) if (ks <= tt) { \
                    acc = __builtin_amdgcn_mfma_f32_16x16x32_bf16(A[ks], R[ks + 1 - (j4)], acc, 0, 0, 0); \
                    if (ks + 1 <= tt) ac1 = __builtin_amdgcn_mfma_f32_16x16x32_bf16(A[ks + 1], R[ks + 2 - (j4)], ac1, 0, 0, 0); \
                    if (ks + 2 <= tt) ac2 = __builtin_amdgcn_mfma_f32_16x16x32_bf16(A[ks + 2], R[ks + 3 - (j4)], ac2, 0, 0, 0); \
                    if (ks + 3 <= tt) ac3 = __builtin_amdgcn_mfma_f32_16x16x32_bf16(A[ks + 3], R[ks + 4 - (j4)], ac3, 0, 0, 0); } \
                acc = (acc + ac1) + (ac2 + ac3); \
                _Pragma("unroll") for (int r = 0; r < 4; ++r) { const size_t tok = rowb + (size_t)(16 * w + 4 * kq + r) * 32 + t; const size_t o = tok * SSMW + g * 16 + m; \
                    Zg[o] = (unsigned char)(__builtin_amdgcn_cvt_pk_fp8_f32(clamp8(gelu_tanh(acc[r]) * A8_SCALE), 0.f, 0, false) & 0xff); } } while (0)
            SSM_STEP(0, Bs, Bs1); SSM_STEP(1, Bs1, Bs);
#undef SSM_STEP
        }
    }
    __syncthreads();
}
}

__device__ __forceinline__ void p3a_select_ssm(Frame& F) {
    const int bh = F.vcu >> 1;
    att::select_rows(F, bh >> 3, bh & 7, F.vcu & 1);
    ssm::ssm_unit(F, F.vcu >> 4, F.vcu & 15);
}
__device__ __forceinline__ void p3b_moba(Frame& F) {
    const int bh = F.vcu >> 1, sub = F.vcu & 1;
    { LAS float* btab = (LAS float*)(F.lds + att::LBT); const float* bt = (const float*)(F.ws + WS_BTAB) + (bh & 7) * 576; for (int i = F.tid; i < 576; i += 512) btab[i] = bt[i]; }
    att::MobaPre P; att::moba_preload(F, bh >> 3, bh & 7, 0, sub, P);
#pragma unroll 1
    for (int n = 0; n < 16; ++n) att::moba_unit(F, bh >> 3, bh & 7, n, sub, P);
}

__device__ __forceinline__ void p7_rows(Frame& F) {
    const int gw = F.vcu * NWAVES + F.wave; const int row0 = gw * 32, b = row0 >> 12;
    const float* mod = (const float*)(F.ws + WS_MOD) + b * 6144;
    f32x4 A1[4], A2[4], A3[4];
#pragma unroll
    for (int j = 0; j < 4; ++j) { const int c = 4 * F.lane + 256 * j;
        A1[j] = *(const f32x4*)(mod + 2048 + c) * *(const f32x4*)(F.in[I_GPOSTMIX] + c);
        A2[j] = *(const f32x4*)(F.in[I_GPREFFN] + c) * (*(const f32x4*)(mod + 4096 + c) + 1.0f);
        A3[j] = *(const f32x4*)(mod + 3072 + c); }
    const bf16* YM = (const bf16*)(F.ws + WS_YMIX); const float* ssq = (const float*)(F.ws + WS_SSQ);
    f32x4 nx[4]; unsigned ny[4]; float nq;
    { const f32x4* xr = (const f32x4*)(F.in[I_X] + (size_t)row0 * 1024) + F.lane; const unsigned* yr = (const unsigned*)((const unsigned char*)YM + (size_t)row0 * 2048) + F.lane;
#pragma unroll
      for (int j = 0; j < 4; ++j) { nx[j] = __builtin_nontemporal_load(xr + 64 * j); ny[j] = yr[64 * j]; }
      nq = ssq[(size_t)row0 * 16 + (F.lane & 15)]; }
    for (int r = 0; r < 32; ++r) {
        const size_t row = (size_t)(row0 + r);
        f32x4 xv[4]; unsigned yv[4]; float q = nq;
#pragma unroll
        for (int j = 0; j < 4; ++j) { xv[j] = nx[j]; yv[j] = ny[j]; }
        { const size_t rn = row + (r < 31 ? 1 : 0);
          const f32x4* xr = (const f32x4*)(F.in[I_X] + rn * 1024) + F.lane; const unsigned* yr = (const unsigned*)((const unsigned char*)YM + rn * 2048) + F.lane;
#pragma unroll
          for (int j = 0; j < 4; ++j) { nx[j] = __builtin_nontemporal_load(xr + 64 * j); ny[j] = yr[64 * j]; }
          nq = ssq[rn * 16 + (F.lane & 15)]; }
        q += __shfl_xor(q, 1); q += __shfl_xor(q, 2); q += __shfl_xor(q, 4); q += __shfl_xor(q, 8);
        const float rstd1 = rsqrtf(q * (1.0f / 1024.0f) + RMS_EPS) * 0.125f;
        v2u* xo = (v2u*)(row < (size_t)X1_SPLIT ? F.ws + WS_X1A + row * 2048 : F.ws + WS_X1B + (row - X1_SPLIT) * 2048) + F.lane;
        f32x4 v[4]; float s = 0.f;
#pragma unroll
        for (int j = 0; j < 4; ++j) { const pg8::f32x2_ ylo = __builtin_amdgcn_cvt_pk_f32_fp8((int)yv[j], false), yhi = __builtin_amdgcn_cvt_pk_f32_fp8((int)yv[j], true); const f32x4 y = {ylo.x, ylo.y, yhi.x, yhi.y};
            v[j] = xv[j] + A1[j] * (y * rstd1); { v2u xw; xw.x = pk2(v[j].x, v[j].y); xw.y = pk2(v[j].z, v[j].w); xo[64 * j] = xw; }
            s += (v[j].x * v[j].x + v[j].y * v[j].y) + (v[j].z * v[j].z + v[j].w * v[j].w); }
        const float rstd2 = rsqrtf(wave_sum(s) * (1.0f / 1024.0f) + RMS_EPS);
        unsigned* o8 = (unsigned*)(F.ws + WS_H2F8 + row * 1024) + F.lane;
        if (F.lane == 0) ((LAS float*)(F.lds + 122880))[F.wave * 32 + r] = rstd2;
#pragma unroll
        for (int j = 0; j < 4; ++j) { const f32x4 hs = (v[j] * rstd2 * A2[j] + A3[j]) * A8_SCALE; o8[64 * j] = pk4_fp8(hs.x, hs.y, hs.z, hs.w); }
    }
}

__device__ __forceinline__ void p8_router(Frame& F) {
    LAS unsigned char* L = F.lds;
    const int b = (F.vcu * 256) >> 12;
    LAS float* cb = (LAS float*)(L + 123904);
    { const v4u* src = (const v4u*)(F.ws + WS_ROUTW + (size_t)b * 98304); LAS v4u* dst = (LAS v4u*)L; for (int i = F.tid; i < 6144; i += 512) dst[i] = src[i];
      if (F.tid < 48) cb[F.tid] = ((const float*)(F.ws + WS_ROUTC))[b * 48 + F.tid]; }
    __syncthreads();
    const int lane = F.lane, m = lane & 15, kq = lane >> 4;
    LAS float* lg = (LAS float*)(L + 98304 + F.wave * 3072);
    const LAS float* rs2 = (const LAS float*)(L + 122880) + F.wave * 32;
    int* list = (int*)(F.ws + WS_LIST); float* wgt = (float*)(F.ws + WS_WGT);
    const int gw = F.vcu * NWAVES + F.wave;
    for (int tile = gw * 2; tile < gw * 2 + 2; ++tile) {
        const size_t arow = (size_t)(tile * 16 + m);
        const bf16* ap = (const bf16*)(arow < (size_t)X1_SPLIT ? F.ws + WS_X1A + arow * 2048 : F.ws + WS_X1B + (arow - X1_SPLIT) * 2048) + 8 * kq;
        pg8::f32x4 a0 = {0.f, 0.f, 0.f, 0.f}, a1 = a0, a2 = a0;
#pragma unroll 8
        for (int ks = 0; ks < 32; ++ks) { const bf16x8 av = *(const bf16x8*)(ap + 32 * ks);
            const LAS bf16x8* bp = (const LAS bf16x8*)L + (ks * 3) * 64 + lane;
            a0 = __builtin_amdgcn_mfma_f32_16x16x32_bf16(av, bp[0], a0, 0, 0, 0);
            a1 = __builtin_amdgcn_mfma_f32_16x16x32_bf16(av, bp[64], a1, 0, 0, 0);
            a2 = __builtin_amdgcn_mfma_f32_16x16x32_bf16(av, bp[128], a2, 0, 0, 0); }
#pragma unroll
        for (int r = 0; r < 4; ++r) { lg[(4 * kq + r) * 48 + m] = a0[r]; lg[(4 * kq + r) * 48 + 16 + m] = a1[r]; lg[(4 * kq + r) * 48 + 32 + m] = a2[r]; }
        LDS_WAIT(); asm volatile("" ::: "memory");
        if (lane < 16) {
            const LAS float* q = lg + lane * 48; const int tok = tile * 16 + lane; const float r2 = rs2[(tile & 1) * 16 + lane];
            float gl[4]; int gi = 0; float gm;
#pragma unroll
            for (int i = 0; i < 4; ++i) gl[i] = q[i] * r2 + cb[i];
            gm = gl[0];
#pragma unroll
            for (int i = 1; i < 4; ++i) if (gl[i] > gm) { gm = gl[i]; gi = i; }
            float gs = 0.f;
#pragma unroll
            for (int i = 0; i < 4; ++i) gs += __expf(gl[i] - gm);
            const float gp = 1.0f / gs;
            float e1 = -3.0e38f, e2 = -3.0e38f; int i1 = 0, i2 = 0;
#pragma unroll
            for (int i = 0; i < 8; ++i) { const float v = q[4 + gi * 8 + i] * r2 + cb[4 + gi * 8 + i];
                if (v > e1) { e2 = e1; i2 = i1; e1 = v; i1 = i; } else if (v > e2) { e2 = v; i2 = i; } }
            const float t = __expf(e2 - e1), w1 = gp / (1.0f + t), w2 = gp * t / (1.0f + t);
            const int x1 = gi * 8 + i1, x2 = gi * 8 + i2;
            const int p1 = (int)__hip_atomic_fetch_add(F.ctl + CW_CNT + 64 * x1, 1u, RLX_AGENT);
            const int p2 = (int)__hip_atomic_fetch_add(F.ctl + CW_CNT + 64 * x2, 1u, RLX_AGENT);
            list[(size_t)x1 * NTOK + p1] = tok * 2; list[(size_t)x2 * NTOK + p2] = tok * 2 + 1;
            wgt[tok * 2] = w1; wgt[tok * 2 + 1] = w2;
        }
        LDS_WAIT(); asm volatile("" ::: "memory");
    }
}

__device__ __forceinline__ int moe_layout(Frame& F) {
    LAS int* te = (LAS int*)(F.lds + TILEE_OFF);
    if (F.tid == 0) { int start = 0;
        for (int e = 0; e < NEXP; ++e) { const int c = (int)__hip_atomic_load(F.ctl + CW_CNT + 64 * e, RLX_AGENT); const int nt = (c + MOEB - 1) / MOEB;
            te[600 + e] = start * MOEB; te[640 + e] = c; for (int t = 0; t < nt; ++t) te[start + t] = e; start += nt; }
        te[600 + NEXP] = start * MOEB; }
    __syncthreads();
    return te[600 + NEXP] / MOEB;
}

__device__ __forceinline__ void moe_rowmap(Frame& F, int ntiles) {
    LAS int* te = (LAS int*)(F.lds + TILEE_OFF);
    const int nrows = ntiles * MOEB;
    const int* list = (const int*)(F.ws + WS_LIST); const float* wgt = (const float*)(F.ws + WS_WGT); int* rowmap = (int*)(F.ws + WS_ROWMAP); float* rw = (float*)(F.ws + WS_RW);
    for (int r = F.vcu * 512 + F.tid; r < nrows; r += F.G * 512) {
        const int e = te[r >> 8]; const int i = r - te[600 + e];
        if (i < te[640 + e]) { const int tk = list[(size_t)e * NTOK + i]; rowmap[tk] = r; rw[r] = wgt[tk]; } else rw[r] = 0.f;
    }
}

__device__ __forceinline__ void p12_combine(Frame& F) {
    const int gw = F.vcu * NWAVES + F.wave; const int row0 = gw * 32, b = row0 >> 12;
    const float* mod = (const float*)(F.ws + WS_MOD) + b * 6144;
    f32x4 A1[4];
#pragma unroll
    for (int j = 0; j < 4; ++j) { const int c = 4 * F.lane + 256 * j; A1[j] = *(const f32x4*)(mod + 5120 + c) * *(const f32x4*)(F.in[I_GPOSTFFN] + c); }
    const unsigned char* YR = F.ws + WS_XS; const int* rowmap = (const int*)(F.ws + WS_ROWMAP);
    typedef float f32x2_ __attribute__((ext_vector_type(2)));
    const int myrm = rowmap[(size_t)row0 * 2 + F.lane];
    unsigned na[4], nc[4]; v2u nxw[4];
#define CMB_LOAD(r_) do { const int r0_ = __shfl(myrm, 2 * (r_)), r1_ = __shfl(myrm, 2 * (r_) + 1); const size_t rw_ = (size_t)(row0 + (r_)); \
        const unsigned* y0_ = (const unsigned*)(YR + (size_t)r0_ * 1024) + F.lane; const unsigned* y1_ = (const unsigned*)(YR + (size_t)r1_ * 1024) + F.lane; \
        const v2u* xi_ = (const v2u*)(rw_ < (size_t)X1_SPLIT ? F.ws + WS_X1A + rw_ * 2048 : F.ws + WS_X1B + (rw_ - X1_SPLIT) * 2048) + F.lane; \
        _Pragma("unroll") for (int j = 0; j < 4; ++j) { na[j] = y0_[64 * j]; nc[j] = y1_[64 * j]; nxw[j] = xi_[64 * j]; } } while (0)
    CMB_LOAD(0);
    for (int r = 0; r < 32; ++r) {
        const size_t row = (size_t)(row0 + r);
        unsigned ca[4], cc[4]; v2u cx[4];
#pragma unroll
        for (int j = 0; j < 4; ++j) { ca[j] = na[j]; cc[j] = nc[j]; cx[j] = nxw[j]; }
        { const int rn = r < 31 ? r + 1 : r; CMB_LOAD(rn); }
        f32x4 f[4]; float s = 0.f;
#pragma unroll
        for (int j = 0; j < 4; ++j) { const int a = (int)ca[j], c = (int)cc[j];
            const f32x2_ al = __builtin_amdgcn_cvt_pk_f32_fp8(a, false), ah = __builtin_amdgcn_cvt_pk_f32_fp8(a, true), cl = __builtin_amdgcn_cvt_pk_f32_fp8(c, false), ch = __builtin_amdgcn_cvt_pk_f32_fp8(c, true);
            f[j] = (f32x4){al.x + cl.x, al.y + cl.y, ah.x + ch.x, ah.y + ch.y} * (1.0f / 256.0f);
            s += (f[j].x * f[j].x + f[j].y * f[j].y) + (f[j].z * f[j].z + f[j].w * f[j].w); }
        const float rstd = rsqrtf(wave_sum(s) * (1.0f / 1024.0f) + RMS_EPS);
        f32x4* xo = (f32x4*)(F.out + row * 1024) + F.lane;
#pragma unroll
        for (int j = 0; j < 4; ++j) { const v2u xw = cx[j]; const f32x4 x1 = {bflo(xw.x), bfhi(xw.x), bflo(xw.y), bfhi(xw.y)}; __builtin_nontemporal_store(x1 + A1[j] * (f[j] * rstd), xo + 64 * j); }
    }
#undef CMB_LOAD
}

struct Args { const float* in[29]; float* out; unsigned char* ws; int ph_lo, ph_hi; };
#if defined(SPLIT5)
constexpr int N_PHASES = 10;
#else
constexpr int N_PHASES = 9;
#endif
#ifndef MK_N_LAUNCHES
#define MK_N_LAUNCHES 1
#endif

__global__ void __launch_bounds__(NWAVES * 64, 2) layer_fwd(Args args) {
    extern __shared__ __attribute__((aligned(16))) unsigned char lds[];
    Frame F;
    F.lds = (LAS unsigned char*)lds; F.MISC = (volatile LAS unsigned*)(F.lds + MISC_OFF);
    F.tid = threadIdx.x; F.lane = F.tid & 63; F.wave = __builtin_amdgcn_readfirstlane(F.tid >> 6);
    F.G = gridDim.x; { const int bx = blockIdx.x; F.vcu = (F.G % 8 == 0) ? (bx % 8) * (F.G / 8) + bx / 8 : bx; }
    F.ws = args.ws; F.ctl = (gu32*)(args.ws + WS_CTL); F.out = args.out;
#pragma unroll
    for (int i = 0; i < 29; ++i) F.in[i] = args.in[i];
    for (int u = F.tid; u < (LDS_BYTES - LDSCTL_OFF) / 4; u += NWAVES * 64) ((LAS unsigned*)(F.lds + LDSCTL_OFF))[u] = 0u;
    __syncthreads();
    XcdBarrier bar; bar.bar = (unsigned*)(F.ctl + CW_BAR); bar.x = 0; bar.st = nullptr;
    if (MK_N_LAUNCHES == 1) bar = xcd_barrier_post((unsigned*)(F.ctl + CW_BAR), F.MISC + 8);
    const int lo = args.ph_lo, hi = args.ph_hi;
#ifndef ONLYP
#define ONLYP -1
#endif
#define IN(k) ((ONLYP < 0 || ONLYP == (k)) && lo <= (k) && (k) < hi)
#define SEAM(k) do { if (IN(k) && IN((k) + 1)) xcd_barrier(bar); } while (0)
#define REFRESH() do { int t_ = threadIdx.x; asm volatile("" : "+v"(t_)); F.tid = t_; F.lane = t_ & 63; F.wave = __builtin_amdgcn_readfirstlane(t_ >> 6); } while (0)
    bf16* const RA = (bf16*)(F.ws + WS_RA); bf16* const RB = (bf16*)(F.ws + WS_RB);

    if (IN(0)) { REFRESH(); p0_mod(F); } SEAM(0);
    if (IN(1)) { REFRESH(); p1_xn(F); p0_tables(F); p0_weights(F, 0, WI_EXPERT); } SEAM(1);
    if (IN(2)) { REFRESH();
        pg8::Gemm g{RA, (const bf16*)(F.ws + WS_WIN), NTOK, NPROJ, DM / 2}; pg8::StaticOrder S; S.init(NTOK, NPROJ, F.G, (int)blockIdx.x);
        pg8::EpiProj E{(bf16*)(F.ws + WS_Q), (bf16*)(F.ws + WS_K), (bf16*)(F.ws + WS_V), (bf16*)(F.ws + WS_U), (bf16*)(F.ws + WS_GA), (bf16*)(F.ws + WS_GS), (float*)(F.ws + WS_KPART)};
        pg8::gemm_phase<pg8::EpiProj, pg8::StaticOrder, true, true, true>(F.lds, g, S, E, A8_E8, W8_E8);
    } SEAM(2);
    if (IN(3)) { REFRESH(); p3a_select_ssm(F); } SEAM(3);
    if (IN(4)) { REFRESH(); p3b_moba(F); } SEAM(4);
    if (IN(5)) { REFRESH();
        const int pm = F.vcu;
        if ((pm & 1) == 0) { p0_weights(F, WI_EXPERT, WI_END); VM_WAIT(); __syncthreads(); REFRESH(); }
        { pg8::Gemm g{(const bf16*)(F.ws + WS_Z), (const bf16*)(F.ws + WS_WGLU), NTOK, 2048, SSMW / 2}; pg8::PanelOrder S{pm, 8, pm & 7};
          pg8::EpiGlu E{(const bf16*)(F.ws + WS_GS), RA};
          pg8::gemm_phase<pg8::EpiGlu, pg8::PanelOrder, true, true, true>(F.lds, g, S, E, A8_E8, W8_E8); }
        VM_WAIT(); __syncthreads();
        { pg8::Gemm g{(const bf16*)(F.ws + WS_ATT), (const bf16*)(F.ws + WS_WO), NTOK, DM, ATTW / 2}; pg8::PanelOrder S{pm, 4, pm & 3};
          pg8::EpiAttOut E{F.ws + WS_GA, F.ws + WS_GS, RA, (unsigned char*)RB};
          pg8::gemm_phase<pg8::EpiAttOut, pg8::PanelOrder, true, true, true>(F.lds, g, S, E, A8_E8, W8_E8); }
        VM_WAIT(); __syncthreads();
        { pg8::Gemm g{RB, (const bf16*)(F.ws + WS_WMIX), NTOK, DM, DM / 2}; pg8::PanelOrder S{pm, 4, pm & 3};
          pg8::EpiMix E{(bf16*)(F.ws + WS_YMIX), (float*)(F.ws + WS_SSQ)};
          pg8::gemm_phase<pg8::EpiMix, pg8::PanelOrder, true, true, true>(F.lds, g, S, E, A8_E8, W8_E8); }
        VM_WAIT(); __syncthreads();
        REFRESH(); p7_rows(F);
        VM_WAIT(); __syncthreads();
#if !defined(SPLIT5)
        REFRESH(); p8_router(F);
        if ((F.vcu & 1) != 0) { REFRESH(); p0_weights(F, WI_EXPERT, WI_END); }
    } SEAM(5);
#else
        if ((F.vcu & 1) != 0) { REFRESH(); p0_weights(F, WI_EXPERT, WI_END); }
    } SEAM(5);
    if (IN(9)) { REFRESH(); p8_router(F); } if (IN(9) && IN(6)) xcd_barrier(bar);
#endif
    if (IN(6)) { REFRESH();
        const int ntiles = moe_layout(F);
        moe_rowmap(F, ntiles);
        pg8::Gemm g{(const bf16*)(F.ws + WS_H2F8), (const bf16*)(F.ws + WS_WGU), ntiles * MOEB, DM, DM / 2};
        pg8::MoeOrder S{(const LAS int*)(F.lds + TILEE_OFF), (const int*)(F.ws + WS_LIST), ntiles, F.G, F.vcu};
        pg8::EpiMoe1 E{(unsigned char*)RA};
        pg8::gemm_phase_g<pg8::EpiMoe1, pg8::MoeOrder, true>(F.lds, g, S, E, A8_E8, W8_E8);
    } SEAM(6);
    if (IN(7)) { REFRESH();
        const int ntiles = moe_layout(F);
        pg8::Gemm g{RA, (const bf16*)(F.ws + WS_WDN), ntiles * MOEB, DM, DEXP / 2};
        pg8::MoeOrder S{(const LAS int*)(F.lds + TILEE_OFF), (const int*)(F.ws + WS_LIST), ntiles, F.G, F.vcu};
        pg8::EpiMoe2 E{F.ws + WS_XS, (const float*)(F.ws + WS_RW)};
        pg8::gemm_phase<pg8::EpiMoe2, pg8::MoeOrder, true, true, true>(F.lds, g, S, E, 124, W8_E8);
    } SEAM(7);
    if (IN(8)) { REFRESH(); p12_combine(F); }
#undef IN
#undef SEAM
}

extern "C" void kernel_launch(void* const* d_in, const int* in_sizes, int n_in, void* d_out, int out_size, void* d_ws, size_t ws_size, hipStream_t stream) {
    static int grid = 0;
    if (grid == 0) {
        if (n_in != 29 || in_sizes[0] != NTOK * DM || out_size != NTOK * DM || ws_size < WS_END) {
            fprintf(stderr, "kernel_launch: unexpected problem (n_in %d, in0 %d, out %d, ws %zu); nothing launched\n", n_in, n_in > 0 ? in_sizes[0] : -1, out_size, ws_size); grid = -1; return; }
        int dev = 0, cus = 0, per_cu = 0;
        if (hipGetDevice(&dev) != hipSuccess || hipDeviceGetAttribute(&cus, hipDeviceAttributeMultiprocessorCount, dev) != hipSuccess) { grid = -1; return; }
        if (hipFuncSetAttribute((const void*)layer_fwd, hipFuncAttributeMaxDynamicSharedMemorySize, LDS_BYTES) != hipSuccess) { fprintf(stderr, "kernel_launch: hipFuncSetAttribute failed\n"); grid = -1; return; }
        if (hipOccupancyMaxActiveBlocksPerMultiprocessor(&per_cu, (const void*)layer_fwd, NWAVES * 64, LDS_BYTES) != hipSuccess || per_cu < 1) fprintf(stderr, "kernel_launch: occupancy query says %d\n", per_cu);
        (void)hipGetLastError();
        grid = cus;
        if (grid != 256) { fprintf(stderr, "kernel_launch: this kernel is built for a 256-CU device (got %d)\n", grid); grid = -1; return; }
    }
    if (grid < 0) return;
    (void)hipMemsetAsync((char*)d_ws + WS_CTL, 0, CTL_ZERO_BYTES, stream);
    Args a{};
    for (int i = 0; i < 29; ++i) a.in[i] = (const float*)d_in[i];
    a.out = (float*)d_out; a.ws = (unsigned char*)d_ws;
#if MK_N_LAUNCHES == 1
    void* kargs[] = {&a};
#if defined(PROBE_A)
    a.ph_lo = 0; a.ph_hi = PROBE_A;
    (void)hipLaunchCooperativeKernel((const void*)layer_fwd, dim3(grid), dim3(NWAVES * 64), kargs, LDS_BYTES, stream);
    (void)hipMemsetAsync((char*)d_ws + WS_CTL + CW_BAR * 4, 0, XCD_BAR_WORDS * 4, stream);
    a.ph_lo = PROBE_B; a.ph_hi = N_PHASES;
    (void)hipLaunchCooperativeKernel((const void*)layer_fwd, dim3(grid), dim3(NWAVES * 64), kargs, LDS_BYTES, stream);
#else
    a.ph_lo = 0; a.ph_hi = N_PHASES;
    hipError_t e = hipLaunchCooperativeKernel((const void*)layer_fwd, dim3(grid), dim3(NWAVES * 64), kargs, LDS_BYTES, stream);
    if (e != hipSuccess) fprintf(stderr, "kernel_launch: cooperative launch failed: %s\n", hipGetErrorString(e));
#endif
#else
    for (int p = 0; p < N_PHASES; ++p) { a.ph_lo = p; a.ph_hi = p + 1; hipLaunchKernelGGL(layer_fwd, dim3(grid), dim3(NWAVES * 64), LDS_BYTES, stream, a); }
#endif
}
```

```cpp
#include <hip/hip_runtime.h>
#include <cstdio>
#include <cstdint>
#include <cmath>
namespace pg8 {
#define PG8_LAS __attribute__((address_space(3)))
typedef unsigned short bf16_t;
typedef short bf16x8 __attribute__((ext_vector_type(8)));
typedef float f32x4 __attribute__((ext_vector_type(4)));
typedef unsigned u32x4 __attribute__((ext_vector_type(4)));
typedef int i32x4 __attribute__((ext_vector_type(4)));
typedef int i32x8 __attribute__((ext_vector_type(8)));
constexpr int BM = 256, BK = 64, HALF = 128, HTB = HALF * BK * 2  , STAGE_BYTES = 8 * HTB, NXCD = 8, WGM = 8;

__host__ __device__ __forceinline__ int lds_byte(int r, int c) { const int st = (r >> 4) * 2 + (c >> 5), rr = r & 15, cc = c & 31, ob = rr * 64 + cc * 2; return st * 1024 + (ob ^ (((ob >> 9) & 1) << 5)); }
__host__ __device__ __forceinline__ void stage_rc(int b, int& R, int& C) { const int st = b / 1024, sb = b % 1024, swz = sb ^ (((sb >> 9) & 1) << 5); R = (st >> 1) * 16 + swz / 64; C = (st & 1) * 32 + (swz % 64) / 2; }
__host__ __device__ __forceinline__ int perm32(int rho) { const int n = rho >> 4, i = rho & 15; return 8 * (i >> 2) + 4 * n + (i & 3); }

struct Unit { int pm, pn; };
struct Gemm { const bf16_t* A; const bf16_t* Bt; int M, N, K; };

struct StaticOrder {
    int nM, nN, nwg, G, c;
    __host__ __device__ void init(int M, int N, int G_, int c_) { nM = M / BM; nN = N / BM; nwg = nM * nN; G = G_; c = c_; }
    __host__ __device__ bool next(int i, Unit& u) const {
        const long L = (long)i * G + c; if (L >= nwg) return false;
        int wgid = (int)L; { const int q = nwg / NXCD, r = nwg % NXCD, xcd = wgid % NXCD, off = wgid / NXCD; wgid = (xcd < r ? xcd * (q + 1) : r * (q + 1) + (xcd - r) * q) + off; }
        const int nig = WGM * nN, gid = wgid / nig, fm = gid * WGM, gsz = (nM - fm) < WGM ? (nM - fm) : WGM;
        u.pm = fm + ((wgid % nig) % gsz); u.pn = (wgid % nig) / gsz; return true;
    }
    __device__ __forceinline__ void a_ready(const Unit&) const {}
    __device__ __forceinline__ void done(const Unit&) const {}
};

__device__ __forceinline__ unsigned cvt_pk_bf16(float lo, float hi) { unsigned r; asm volatile("v_cvt_pk_bf16_f32 %0, %1, %2" : "=v"(r) : "v"(lo), "v"(hi)); return r; }
typedef unsigned u32x2 __attribute__((ext_vector_type(2)));
__device__ __forceinline__ float bf_lo(unsigned w) { return __uint_as_float(w << 16); }
__device__ __forceinline__ float bf_hi(unsigned w) { return __uint_as_float(w & 0xffff0000u); }
__device__ __forceinline__ float sigmoidf_(float x) { return __builtin_amdgcn_rcpf(1.0f + __builtin_amdgcn_exp2f(-1.4426950408889634f * x)); }

typedef float f32x2_ __attribute__((ext_vector_type(2)));
__device__ __forceinline__ unsigned sig_u8x4(const f32x4 v) {
    const f32x2_ ya = (f32x2_){v[0], v[1]} * -1.4426950408889634f, yb = (f32x2_){v[2], v[3]} * -1.4426950408889634f;
    const f32x2_ da = (f32x2_){__builtin_amdgcn_exp2f(ya.x), __builtin_amdgcn_exp2f(ya.y)} + 1.0f, db = (f32x2_){__builtin_amdgcn_exp2f(yb.x), __builtin_amdgcn_exp2f(yb.y)} + 1.0f;
    const f32x2_ qa = (f32x2_){__builtin_amdgcn_rcpf(da.x), __builtin_amdgcn_rcpf(da.y)} * 255.0f + 8388608.0f, qb = (f32x2_){__builtin_amdgcn_rcpf(db.x), __builtin_amdgcn_rcpf(db.y)} * 255.0f + 8388608.0f;
    unsigned t01, t23, w;
    asm("v_perm_b32 %0, %1, %2, %3" : "=v"(t01) : "v"(qa.y), "v"(qa.x), "s"(0x0c0c0400u));
    asm("v_perm_b32 %0, %1, %2, %3" : "=v"(t23) : "v"(qb.y), "v"(qb.x), "s"(0x0c0c0400u));
    asm("v_perm_b32 %0, %1, %2, %3" : "=v"(w) : "v"(t23), "v"(t01), "s"(0x05040100u));
    return w;
}
__device__ __forceinline__ f32x2_ vsig2(const f32x2_ v, const f32x2_ g) {
    const f32x2_ y = g * -1.4426950408889634f;
    const f32x2_ d = (f32x2_){__builtin_amdgcn_exp2f(y.x), __builtin_amdgcn_exp2f(y.y)} + 1.0f;
    return v * (f32x2_){__builtin_amdgcn_rcpf(d.x), __builtin_amdgcn_rcpf(d.y)};
}
constexpr float QSCALE = 0.125f * 1.4426950408889634f;

struct EpiProj {
    static constexpr bool PERM = true, AFTER_DRAIN = false;
    bf16_t *Q, *K, *V, *U, *GA, *GS; float* kpart;
    __device__ __forceinline__ void operator()(const f32x4 (&acc)[2][2][4][2], const Unit& u, int wr, int wc, int fr, int fq) const {
        const int pn = u.pn; const int row0 = u.pm * BM + wr * 64 + fr;
        bf16_t* base; int ld, colt, mode;
        if (pn < 2) { base = Q; ld = 512; colt = pn * 256; mode = 1; }
        else if (pn < 4) { base = K; ld = 512; colt = (pn - 2) * 256; mode = 0; }
        else if (pn < 6) { base = V; ld = 512; colt = (pn - 4) * 256; mode = 0; }
        else if (pn == 6) { base = U; ld = 256; colt = 0; mode = 0; }
        else if (pn < 11) { base = GA; ld = 1024; colt = (pn - 7) * 256; mode = 2; }
        else { base = GS; ld = 1024; colt = (pn - 11) * 256; mode = 2; }
        const int col0 = colt + wc * 32 + 8 * fq;
#pragma unroll
        for (int ai = 0; ai < 2; ++ai)
#pragma unroll
            for (int m = 0; m < 4; ++m) { bf16_t* rowp = base + (size_t)(row0 + ai * HALF + m * 16) * ld + col0;
#pragma unroll
                for (int bj = 0; bj < 2; ++bj) { f32x4 v0 = acc[ai][bj][m][0], v1 = acc[ai][bj][m][1];
                    if (mode == 2) {
                        u32x2 w; w.x = sig_u8x4(v0); w.y = sig_u8x4(v1);
                        *(u32x2*)((unsigned char*)base + (size_t)(row0 + ai * HALF + m * 16) * 1024 + col0 + bj * HALF) = w;
                    } else {
                        if (mode == 1) { v0 = v0 * QSCALE; v1 = v1 * QSCALE; }
                        u32x4 w; w.x = cvt_pk_bf16(v0[0], v0[1]); w.y = cvt_pk_bf16(v0[2], v0[3]); w.z = cvt_pk_bf16(v1[0], v1[1]); w.w = cvt_pk_bf16(v1[2], v1[3]);
                        *(u32x4*)(rowp + bj * HALF) = w; } } }
        if (pn == 2 || pn == 3) {
#pragma unroll
            for (int bj = 0; bj < 2; ++bj)
#pragma unroll
                for (int n = 0; n < 2; ++n) { f32x4 s = (f32x4){0.f, 0.f, 0.f, 0.f};
#pragma unroll
                    for (int ai = 0; ai < 2; ++ai)
#pragma unroll
                        for (int m = 0; m < 4; ++m) s += acc[ai][bj][m][n];
#pragma unroll
                    for (int i = 0; i < 4; ++i) { float t = s[i]; t += __shfl_xor(t, 1); t += __shfl_xor(t, 2); t += __shfl_xor(t, 4); t += __shfl_xor(t, 8); s[i] = t; }
                    if (fr == 0) *(f32x4*)(kpart + (size_t)(u.pm * 2 + wr) * 512 + (pn - 2) * 256 + bj * HALF + wc * 32 + 8 * fq + 4 * n) = s; }
        }
    }
};

struct EpiGlu {
    static constexpr bool PERM = true, AFTER_DRAIN = false;
    const bf16_t* GS; bf16_t* SG;
    __device__ __forceinline__ void operator()(const f32x4 (&acc)[2][2][4][2], const Unit& u, int wr, int wc, int fr, int fq) const {
        const int row0 = u.pm * BM + wr * 64 + fr; const int col0 = u.pn * 128 + wc * 32 + 8 * fq;
#pragma unroll
        for (int ai = 0; ai < 2; ++ai)
#pragma unroll
            for (int m = 0; m < 4; ++m) { const size_t ro = (size_t)(row0 + ai * HALF + m * 16) * 1024 + col0;
                const f32x4 v0 = acc[ai][0][m][0], v1 = acc[ai][0][m][1], g0 = acc[ai][1][m][0], g1 = acc[ai][1][m][1];
                u32x2 w;
                { const f32x2_ a = vsig2((f32x2_){v0[0], v0[1]}, (f32x2_){g0[0], g0[1]}) * 16.0f, b = vsig2((f32x2_){v0[2], v0[3]}, (f32x2_){g0[2], g0[3]}) * 16.0f;
                  const f32x2_ c = vsig2((f32x2_){v1[0], v1[1]}, (f32x2_){g1[0], g1[1]}) * 16.0f, d = vsig2((f32x2_){v1[2], v1[3]}, (f32x2_){g1[2], g1[3]}) * 16.0f;
                  int t = __builtin_amdgcn_cvt_pk_fp8_f32(__builtin_amdgcn_fmed3f(a.x, -440.f, 440.f), __builtin_amdgcn_fmed3f(a.y, -440.f, 440.f), 0, false);
                  t = __builtin_amdgcn_cvt_pk_fp8_f32(__builtin_amdgcn_fmed3f(b.x, -440.f, 440.f), __builtin_amdgcn_fmed3f(b.y, -440.f, 440.f), t, true); w.x = (unsigned)t;
                  t = __builtin_amdgcn_cvt_pk_fp8_f32(__builtin_amdgcn_fmed3f(c.x, -440.f, 440.f), __builtin_amdgcn_fmed3f(c.y, -440.f, 440.f), 0, false);
                  t = __builtin_amdgcn_cvt_pk_fp8_f32(__builtin_amdgcn_fmed3f(d.x, -440.f, 440.f), __builtin_amdgcn_fmed3f(d.y, -440.f, 440.f), t, true); w.y = (unsigned)t; }
                *(u32x2*)((unsigned char*)SG + ro + (size_t)(row0 + ai * HALF + m * 16) * 1024) = w;
                asm volatile("" ::: "memory"); }
    }
};

struct EpiAttOut {
    static constexpr bool PERM = true, AFTER_DRAIN = false;
    const unsigned char* GA; const unsigned char* GS; const bf16_t* SG; unsigned char* MG;
    __device__ __forceinline__ void operator()(const f32x4 (&acc)[2][2][4][2], const Unit& u, int wr, int wc, int fr, int fq) const {
        const int row0 = u.pm * BM + wr * 64 + fr; const int col0 = u.pn * BM + wc * 32 + 8 * fq;
        u32x2 nga[2], ngs[2]; u32x2 nsg[2];
#define EAO_LOAD(idx) do { const size_t ro_ = (size_t)(row0 + ((idx) >> 2) * HALF + ((idx) & 3) * 16) * 1024 + col0; \
        _Pragma("unroll") for (int bj = 0; bj < 2; ++bj) { nga[bj] = *(const u32x2*)(GA + ro_ + bj * HALF); nsg[bj] = *(const u32x2*)((const unsigned char*)SG + 2 * ro_ - col0 + bj * HALF); ngs[bj] = *(const u32x2*)(GS + ro_ + bj * HALF); } } while (0)
#define U8F(w, i) ((float)(((w) >> (8 * (i))) & 0xffu))
        EAO_LOAD(0);
#pragma unroll
        for (int idx = 0; idx < 8; ++idx) { const int ai = idx >> 2, m = idx & 3; const size_t ro = (size_t)(row0 + ai * HALF + m * 16) * 1024 + col0;
            u32x2 cga[2], cgs[2]; u32x2 csg[2];
#pragma unroll
            for (int bj = 0; bj < 2; ++bj) { cga[bj] = nga[bj]; csg[bj] = nsg[bj]; cgs[bj] = ngs[bj]; }
            if (idx < 7) EAO_LOAD(idx + 1);
#pragma unroll
            for (int bj = 0; bj < 2; ++bj) { const f32x4 v0 = acc[ai][bj][m][0], v1 = acc[ai][bj][m][1]; const u32x2 ga = cga[bj], gs = cgs[bj]; const u32x2 sg = csg[bj];
                constexpr float C = 16.0f / 255.0f, CS = 1.0f / 255.0f;
                float o[8];
#define EAO_PAIR(i, gaw, gsw, b0, va, vb, sgw, hi_) do { const f32x2_ s_ = __builtin_amdgcn_cvt_pk_f32_fp8((int)(sgw), hi_); \
                    const f32x2_ r_ = (f32x2_){U8F(gaw, b0), U8F(gaw, b0 + 1)} * (f32x2_){va, vb} * C + (f32x2_){U8F(gsw, b0), U8F(gsw, b0 + 1)} * s_ * CS; \
                    o[i] = __builtin_amdgcn_fmed3f(r_.x, -440.f, 440.f); o[i + 1] = __builtin_amdgcn_fmed3f(r_.y, -440.f, 440.f); } while (0)
                EAO_PAIR(0, ga.x, gs.x, 0, v0[0], v0[1], sg.x, false); EAO_PAIR(2, ga.x, gs.x, 2, v0[2], v0[3], sg.x, true);
                EAO_PAIR(4, ga.y, gs.y, 0, v1[0], v1[1], sg.y, false); EAO_PAIR(6, ga.y, gs.y, 2, v1[2], v1[3], sg.y, true);
#undef EAO_PAIR
                u32x2 w; int t = __builtin_amdgcn_cvt_pk_fp8_f32(o[0], o[1], 0, false); t = __builtin_amdgcn_cvt_pk_fp8_f32(o[2], o[3], t, true); w.x = (unsigned)t;
                t = __builtin_amdgcn_cvt_pk_fp8_f32(o[4], o[5], 0, false); t = __builtin_amdgcn_cvt_pk_fp8_f32(o[6], o[7], t, true); w.y = (unsigned)t;
                *(u32x2*)(MG + ro + bj * HALF) = w; }
            asm volatile("" ::: "memory"); }
#undef U8F
#undef EAO_LOAD
    }
};

struct EpiMix {
    static constexpr bool PERM = true, AFTER_DRAIN = false;
    bf16_t* Y; float* ssq;
    __device__ __forceinline__ void operator()(const f32x4 (&acc)[2][2][4][2], const Unit& u, int wr, int wc, int fr, int fq) const {
        const int row0 = u.pm * BM + wr * 64 + fr; const int col0 = u.pn * BM + wc * 32 + 8 * fq;
#pragma unroll
        for (int ai = 0; ai < 2; ++ai)
#pragma unroll
            for (int m = 0; m < 4; ++m) { const int row = row0 + ai * HALF + m * 16; const size_t ro = (size_t)row * 1024 + col0; float q = 0.f;
#pragma unroll
                for (int bj = 0; bj < 2; ++bj) { const f32x4 v0 = acc[ai][bj][m][0], v1 = acc[ai][bj][m][1];
                    q += (v0[0] * v0[0] + v0[1] * v0[1]) + (v0[2] * v0[2] + v0[3] * v0[3]) + (v1[0] * v1[0] + v1[1] * v1[1]) + (v1[2] * v1[2] + v1[3] * v1[3]);
                    u32x2 w; int t = __builtin_amdgcn_cvt_pk_fp8_f32(__builtin_amdgcn_fmed3f(v0[0] * 8.0f, -440.f, 440.f), __builtin_amdgcn_fmed3f(v0[1] * 8.0f, -440.f, 440.f), 0, false);
                    t = __builtin_amdgcn_cvt_pk_fp8_f32(__builtin_amdgcn_fmed3f(v0[2] * 8.0f, -440.f, 440.f), __builtin_amdgcn_fmed3f(v0[3] * 8.0f, -440.f, 440.f), t, true); w.x = (unsigned)t;
                    t = __builtin_amdgcn_cvt_pk_fp8_f32(__builtin_amdgcn_fmed3f(v1[0] * 8.0f, -440.f, 440.f), __builtin_amdgcn_fmed3f(v1[1] * 8.0f, -440.f, 440.f), 0, false);
                    t = __builtin_amdgcn_cvt_pk_fp8_f32(__builtin_amdgcn_fmed3f(v1[2] * 8.0f, -440.f, 440.f), __builtin_amdgcn_fmed3f(v1[3] * 8.0f, -440.f, 440.f), t, true); w.y = (unsigned)t;
                    *(u32x2*)((unsigned char*)Y + (size_t)row * 2048 + col0 + bj * HALF) = w; }
                q += __shfl_xor(q, 16); q += __shfl_xor(q, 32);
                if (fq == 0) ssq[(size_t)row * 16 + u.pn * 4 + wc] = q; }
    }
};

constexpr float HID8_SCALE = 8.0f;
struct EpiMoe1 {
    static constexpr bool PERM = true, AFTER_DRAIN = false;
    unsigned char* HID;
    __device__ __forceinline__ void operator()(const f32x4 (&acc)[2][2][4][2], const Unit& u, int wr, int wc, int fr, int fq) const {
        const int row0 = u.pm * BM + wr * 64 + fr; const int col0 = (u.pn & 3) * 128 + wc * 32 + 8 * fq;
#pragma unroll
        for (int ai = 0; ai < 2; ++ai)
#pragma unroll
            for (int m = 0; m < 4; ++m) { const size_t ro = (size_t)(row0 + ai * HALF + m * 16) * 512 + col0;
                float h[8];
#pragma unroll
                for (int n = 0; n < 2; ++n) { const f32x4 g = acc[ai][0][m][n], v = acc[ai][1][m][n];
#pragma unroll
                    for (int i = 0; i < 4; i += 2) { const f32x2_ gg = {g[i], g[i + 1]}; const f32x2_ hh = vsig2(gg, gg) * ((f32x2_){v[i], v[i + 1]} * HID8_SCALE);
                        h[4 * n + i] = __builtin_amdgcn_fmed3f(hh.x, -440.f, 440.f); h[4 * n + i + 1] = __builtin_amdgcn_fmed3f(hh.y, -440.f, 440.f); } }
                u32x2 w; int t = __builtin_amdgcn_cvt_pk_fp8_f32(h[0], h[1], 0, false); t = __builtin_amdgcn_cvt_pk_fp8_f32(h[2], h[3], t, true); w.x = (unsigned)t;
                t = __builtin_amdgcn_cvt_pk_fp8_f32(h[4], h[5], 0, false); t = __builtin_amdgcn_cvt_pk_fp8_f32(h[6], h[7], t, true); w.y = (unsigned)t;
                *(u32x2*)(HID + ro) = w; }
    }
};

constexpr float YR8_SCALE = 256.0f;
struct EpiMoe2 {
    static constexpr bool PERM = true, AFTER_DRAIN = false;
    unsigned char* YR; const float* rw;
    __device__ __forceinline__ void operator()(const f32x4 (&acc)[2][2][4][2], const Unit& u, int wr, int wc, int fr, int fq) const {
        const int row0 = u.pm * BM + wr * 64 + fr; const int col0 = (u.pn & 3) * BM + wc * 32 + 8 * fq;
#pragma unroll
        for (int ai = 0; ai < 2; ++ai)
#pragma unroll
            for (int m = 0; m < 4; ++m) { const int row = row0 + ai * HALF + m * 16; const size_t ro = (size_t)row * 1024 + col0; const float s = rw[row] * YR8_SCALE;
#pragma unroll
                for (int bj = 0; bj < 2; ++bj) { f32x4 v0 = acc[ai][bj][m][0] * s, v1 = acc[ai][bj][m][1] * s;
#pragma unroll
                    for (int i = 0; i < 4; ++i) { v0[i] = fminf(fmaxf(v0[i], -440.f), 440.f); v1[i] = fminf(fmaxf(v1[i], -440.f), 440.f); }
                    u32x2 w; int t = __builtin_amdgcn_cvt_pk_fp8_f32(v0[0], v0[1], 0, false); t = __builtin_amdgcn_cvt_pk_fp8_f32(v0[2], v0[3], t, true); w.x = (unsigned)t;
                    t = __builtin_amdgcn_cvt_pk_fp8_f32(v1[0], v1[1], 0, false); t = __builtin_amdgcn_cvt_pk_fp8_f32(v1[2], v1[3], t, true); w.y = (unsigned)t;
                    *(u32x2*)(YR + ro + bj * HALF) = w; } }
    }
};

struct MoeOrder {
    const PG8_LAS int* tile_e; const int* list; int ntiles, G, c;
    __device__ __forceinline__ bool next(int i, Unit& u) const {
        const int L = i * G + c; if (L >= ntiles * 4) return false;
        const int t = L >> 2; u.pm = t; u.pn = tile_e[t] * 4 + (L & 3); return true;
    }
    __device__ __forceinline__ unsigned a_row(const Unit& u, int lr) const {
        const int e = u.pn >> 2, i = u.pm * 256 + lr - tile_e[600 + e];
        return (i < tile_e[640 + e]) ? (unsigned)(list[(size_t)e * 65536 + i] >> 1) : 0u;
    }
    __device__ __forceinline__ void a_ready(const Unit&) const {}
    __device__ __forceinline__ void done(const Unit&) const {}
};

struct PanelOrder {
    int pm, n, rot;
    __device__ __forceinline__ bool next(int i, Unit& u) const { if (i >= n) return false; int p = pm; asm volatile("" : "+s"(p));
        u.pm = p; u.pn = (i + rot) % n; return true; }
    __device__ __forceinline__ void a_ready(const Unit&) const {}
    __device__ __forceinline__ void done(const Unit&) const {}
};
template <class Epi, class Sched, bool ALIGN_EPI = false, bool SP2 = false, bool F8 = false>
__device__ __forceinline__ void gemm_phase(PG8_LAS unsigned char* lds, const Gemm g, const Sched& S, const Epi& E, int sclA = 127, int sclB = 127) {
    int tid_ = threadIdx.x; asm volatile("" : "+v"(tid_));
    const int tid = tid_, wid = __builtin_amdgcn_readfirstlane(tid >> 6), lane = tid & 63, wr = wid >> 2, wc = wid & 3, fr = lane & 15, fq = lane >> 4;
    const int K = g.K, nt = K / BK;
    unsigned voffA[2], voffB[2];
#pragma unroll
    for (int i = 0; i < 2; ++i) { int R, C; stage_rc(tid * 16 + i * 8192, R, C); const int Rb = Epi::PERM ? ((R & ~31) + perm32(R & 31)) : R;
        voffA[i] = (unsigned)(R * K + C) * 2u; voffB[i] = (unsigned)(Rb * K + C) * 2u; }
    const size_t kstep = (size_t)(BK * 2);
    const size_t hstep = (size_t)HALF * K * 2;
    const size_t tstep = 2 * hstep;
    const unsigned ldsw = (unsigned)wid * 1024u;
    const int aoff = lds_byte(wr * 64 + fr, fq * 8), boff = lds_byte(wc * 32 + fr, fq * 8);
#define PG8_SA(b, h) (((b) * 2 + (h)) * HTB)
#define PG8_SB(b, h) ((4 + (b) * 2 + (h)) * HTB)
#define PG8_STAGE(bufoff, gbase, voff) do { _Pragma("unroll") for (int _i = 0; _i < 2; ++_i) \
        __builtin_amdgcn_global_load_lds((const unsigned*)((const char*)(gbase) + (voff)[_i]), (PG8_LAS unsigned*)(lds + (bufoff) + ldsw + _i * 8192), 16, 0, 0); } while (0)
#define PG8_LDA(dst, b, h) do { _Pragma("unroll") for (int m = 0; m < 4; ++m) _Pragma("unroll") for (int k = 0; k < 2; ++k) dst[m][k] = *(const PG8_LAS bf16x8*)(lds + PG8_SA(b, h) + aoff + m * 2048 + k * 1024); } while (0)
#define PG8_LDB(dst, b, h) do { _Pragma("unroll") for (int n = 0; n < 2; ++n) _Pragma("unroll") for (int k = 0; k < 2; ++k) dst[n][k] = *(const PG8_LAS bf16x8*)(lds + PG8_SB(b, h) + boff + n * 2048 + k * 1024); } while (0)
#define PG8_MMA(ai, bj, At, Bt) do { __builtin_amdgcn_s_setprio(1); _Pragma("unroll") for (int m = 0; m < 4; ++m) _Pragma("unroll") for (int n = 0; n < 2; ++n) { \
        if constexpr (F8) { const i32x4 b0_ = __builtin_bit_cast(i32x4, Bt[n][0]), b1_ = __builtin_bit_cast(i32x4, Bt[n][1]), a0_ = __builtin_bit_cast(i32x4, At[m][0]), a1_ = __builtin_bit_cast(i32x4, At[m][1]); \
            const i32x8 b8_ = __builtin_shufflevector(b0_, b1_, 0, 1, 2, 3, 4, 5, 6, 7), a8_ = __builtin_shufflevector(a0_, a1_, 0, 1, 2, 3, 4, 5, 6, 7); \
            asm volatile("v_mfma_scale_f32_16x16x128_f8f6f4 %0, %1, %2, %0, %3, %4 op_sel_hi:[0,0,0]" : "+v"(acc[ai][bj][m][n]) : "v"(b8_), "v"(a8_), "v"(sclB), "v"(sclA)); } \
        else { _Pragma("unroll") for (int k = 0; k < 2; ++k) acc[ai][bj][m][n] = __builtin_amdgcn_mfma_f32_16x16x32_bf16(Bt[n][k], At[m][k], acc[ai][bj][m][n], 0, 0, 0); } } \
        __builtin_amdgcn_s_setprio(0); } while (0)
#define PG8_WAIT_V(n) asm volatile("s_waitcnt vmcnt(" #n ")" ::: "memory")
#define PG8_WAIT_L(n) asm volatile("s_waitcnt lgkmcnt(" #n ")" ::: "memory")
#define PG8_BAR __builtin_amdgcn_s_barrier()
#define PG8_SCHED __builtin_amdgcn_sched_barrier(0)
    Unit cur, nxt; int ui = 0;
    if (!S.next(0, cur)) return;
    f32x4 acc[2][2][4][2];
#pragma unroll
    for (int a = 0; a < 2; ++a)
#pragma unroll
        for (int b = 0; b < 2; ++b)
#pragma unroll
            for (int m = 0; m < 4; ++m)
#pragma unroll
                for (int n = 0; n < 2; ++n) acc[a][b][m][n] = (f32x4){0.f, 0.f, 0.f, 0.f};
    bf16x8 At[4][2], B0[2][2], B1[2][2];
    const char* cA = (const char*)g.A + (size_t)cur.pm * tstep; const char* cB = (const char*)g.Bt + (size_t)cur.pn * tstep;
    S.a_ready(cur);
    if constexpr (SP2) {
        PG8_STAGE(PG8_SB(0, 0), cB, voffB); PG8_STAGE(PG8_SB(0, 1), cB + hstep, voffB); PG8_STAGE(PG8_SA(0, 0), cA, voffA); PG8_STAGE(PG8_SA(0, 1), cA + hstep, voffA);
        if (wr == 1) PG8_BAR;
        PG8_WAIT_V(2); PG8_BAR;
        PG8_STAGE(PG8_SB(1, 0), cB + kstep, voffB); PG8_STAGE(PG8_SA(1, 0), cA + kstep, voffA); PG8_STAGE(PG8_SB(1, 1), cB + hstep + kstep, voffB);
        PG8_WAIT_V(6); PG8_BAR;
    } else {
        PG8_STAGE(PG8_SB(0, 0), cB, voffB); PG8_STAGE(PG8_SA(0, 0), cA, voffA); PG8_STAGE(PG8_SB(0, 1), cB + hstep, voffB); PG8_STAGE(PG8_SA(0, 1), cA + hstep, voffA);
        if (wr == 1) PG8_BAR;
        PG8_WAIT_V(4); PG8_BAR;
        PG8_STAGE(PG8_SB(1, 0), cB + kstep, voffB); PG8_STAGE(PG8_SA(1, 0), cA + kstep, voffA); PG8_STAGE(PG8_SB(1, 1), cB + hstep + kstep, voffB);
        PG8_WAIT_V(6); PG8_BAR;
    }
    for (;;) {
        const bool has_next = S.next(ui + 1, nxt);
        const char* nA = has_next ? (const char*)g.A + (size_t)nxt.pm * tstep : cA; const char* nB = has_next ? (const char*)g.Bt + (size_t)nxt.pn * tstep : cB;
        for (int t = 0; t < nt; t += 2) {
            const bool last = (t == nt - 2);
            const char* a1 = cA + (size_t)(t + 1) * kstep;
            const char* a2 = last ? nA : cA + (size_t)(t + 2) * kstep; const char* b2 = last ? nB : cB + (size_t)(t + 2) * kstep;
            const char* a3 = a2 + kstep; const char* b3 = b2 + kstep;
            if (last && has_next) S.a_ready(nxt);
            if constexpr (SP2) {
            PG8_LDB(B0, 0, 0); PG8_LDB(B1, 0, 1); PG8_SCHED; PG8_LDA(At, 0, 0); PG8_STAGE(PG8_SA(1, 1), a1 + hstep, voffA);
            PG8_WAIT_V(8); PG8_WAIT_L(0); PG8_BAR; PG8_MMA(0, 0, At, B0); PG8_MMA(0, 1, At, B1); PG8_BAR; PG8_SCHED;
            PG8_LDA(At, 0, 1); PG8_STAGE(PG8_SB(0, 0), b2, voffB); PG8_STAGE(PG8_SB(0, 1), b2 + hstep, voffB); PG8_STAGE(PG8_SA(0, 0), a2, voffA);
            PG8_WAIT_V(8); PG8_WAIT_L(0); PG8_BAR; PG8_MMA(1, 0, At, B0); PG8_MMA(1, 1, At, B1); PG8_BAR; PG8_SCHED;
            PG8_LDB(B0, 1, 0); PG8_LDB(B1, 1, 1); PG8_SCHED; PG8_LDA(At, 1, 0); PG8_STAGE(PG8_SA(0, 1), a2 + hstep, voffA);
            PG8_WAIT_V(8); PG8_WAIT_L(0); PG8_BAR; PG8_MMA(0, 0, At, B0); PG8_MMA(0, 1, At, B1); PG8_BAR; PG8_SCHED;
            PG8_LDA(At, 1, 1); PG8_STAGE(PG8_SB(1, 0), b3, voffB); PG8_STAGE(PG8_SB(1, 1), b3 + hstep, voffB); PG8_STAGE(PG8_SA(1, 0), a3, voffA);
            PG8_WAIT_V(8); PG8_WAIT_L(0); PG8_BAR; PG8_MMA(1, 0, At, B0); PG8_MMA(1, 1, At, B1); PG8_BAR; PG8_SCHED;
            } else {
            PG8_LDB(B0, 0, 0); PG8_SCHED; PG8_LDA(At, 0, 0); PG8_STAGE(PG8_SA(1, 1), a1 + hstep, voffA);
            PG8_WAIT_L(8); PG8_BAR; PG8_WAIT_L(0); PG8_MMA(0, 0, At, B0); PG8_BAR; PG8_SCHED;
            PG8_LDB(B1, 0, 1); PG8_STAGE(PG8_SB(0, 0), b2, voffB);
            PG8_BAR; PG8_WAIT_L(0); PG8_MMA(0, 1, At, B1); PG8_BAR;
            PG8_LDA(At, 0, 1); PG8_STAGE(PG8_SA(0, 0), a2, voffA);
            PG8_BAR; PG8_WAIT_L(0); PG8_MMA(1, 0, At, B0); PG8_BAR; PG8_SCHED;
            PG8_STAGE(PG8_SB(0, 1), b2 + hstep, voffB);
            PG8_WAIT_V(6); PG8_BAR; PG8_MMA(1, 1, At, B1); PG8_BAR;
            PG8_LDB(B0, 1, 0); PG8_SCHED; PG8_LDA(At, 1, 0); PG8_STAGE(PG8_SA(0, 1), a2 + hstep, voffA);
            PG8_WAIT_L(8); PG8_BAR; PG8_WAIT_L(0); PG8_MMA(0, 0, At, B0); PG8_BAR; PG8_SCHED;
            PG8_LDB(B1, 1, 1); PG8_STAGE(PG8_SB(1, 0), b3, voffB);
            PG8_BAR; PG8_WAIT_L(0); PG8_MMA(0, 1, At, B1); PG8_BAR;
            PG8_LDA(At, 1, 1); PG8_STAGE(PG8_SA(1, 0), a3, voffA);
            PG8_BAR; PG8_WAIT_L(0); PG8_MMA(1, 0, At, B0); PG8_BAR; PG8_SCHED;
            PG8_STAGE(PG8_SB(1, 1), b3 + hstep, voffB);
            PG8_WAIT_V(6); PG8_BAR; PG8_MMA(1, 1, At, B1); PG8_BAR;
            }
        }
        if constexpr (ALIGN_EPI) { if (wr == 0) PG8_BAR; }
        if constexpr (F8) asm volatile("s_nop 15\n\ts_nop 15" ::: "memory");
        if constexpr (!Epi::AFTER_DRAIN) { E(acc, cur, wr, wc, fr, fq); S.done(cur); }
        if (!has_next) break;
#pragma unroll
        for (int a = 0; a < 2; ++a)
#pragma unroll
            for (int b = 0; b < 2; ++b)
#pragma unroll
                for (int m = 0; m < 4; ++m)
#pragma unroll
                    for (int n = 0; n < 2; ++n) acc[a][b][m][n] = (f32x4){0.f, 0.f, 0.f, 0.f};
        cur = nxt; cA = nA; cB = nB; ++ui;
        if constexpr (ALIGN_EPI) { if (wr == 1) PG8_BAR; }
    }
    PG8_WAIT_V(0);
    if constexpr (!ALIGN_EPI) { if (wr == 0) PG8_BAR; }
    PG8_BAR;
    if constexpr (Epi::AFTER_DRAIN) { E.fused(acc, cur, wr, wc, fr, fq, lds, wid, lane); S.done(cur); }
#undef PG8_SA
#undef PG8_SB
#undef PG8_STAGE
#undef PG8_LDA
#undef PG8_LDB
#undef PG8_MMA
#undef PG8_WAIT_V
#undef PG8_WAIT_L
#undef PG8_BAR
#undef PG8_SCHED
}
template <class Epi, class Sched, bool F8 = false>
__device__ __forceinline__ void gemm_phase_g(PG8_LAS unsigned char* lds, const Gemm g, const Sched& S, const Epi& E, int sclA = 127, int sclB = 127) {
    int tid_ = threadIdx.x; asm volatile("" : "+v"(tid_));
    const int tid = tid_, wid = __builtin_amdgcn_readfirstlane(tid >> 6), lane = tid & 63, wr = wid >> 2, wc = wid & 3, fr = lane & 15, fq = lane >> 4;
    const int K = g.K, nt = K / BK;
    unsigned voffB[2]; int Rr[2], Cc[2];
#pragma unroll
    for (int i = 0; i < 2; ++i) { int R, C; stage_rc(tid * 16 + i * 8192, R, C); const int Rb = Epi::PERM ? ((R & ~31) + perm32(R & 31)) : R; Rr[i] = R; Cc[i] = C; voffB[i] = (unsigned)(Rb * K + C) * 2u; }
    const size_t kstep = (size_t)(BK * 2); const size_t hstep = (size_t)HALF * K * 2; const size_t tstep = 2 * hstep;
    const unsigned ldsw = (unsigned)wid * 1024u;
    const int aoff = lds_byte(wr * 64 + fr, fq * 8), boff = lds_byte(wc * 32 + fr, fq * 8);
#define PG8_SA(b, h) (((b) * 2 + (h)) * HTB)
#define PG8_SB(b, h) ((4 + (b) * 2 + (h)) * HTB)
#define PG8_STAGE(bufoff, gbase, voff) do { _Pragma("unroll") for (int _i = 0; _i < 2; ++_i) \
        __builtin_amdgcn_global_load_lds((const unsigned*)((const char*)(gbase) + (voff)[_i]), (PG8_LAS unsigned*)(lds + (bufoff) + ldsw + _i * 8192), 16, 0, 0); } while (0)
#define PG8_LDA(dst, b, h) do { _Pragma("unroll") for (int m = 0; m < 4; ++m) _Pragma("unroll") for (int k = 0; k < 2; ++k) dst[m][k] = *(const PG8_LAS bf16x8*)(lds + PG8_SA(b, h) + aoff + m * 2048 + k * 1024); } while (0)
#define PG8_LDB(dst, b, h) do { _Pragma("unroll") for (int n = 0; n < 2; ++n) _Pragma("unroll") for (int k = 0; k < 2; ++k) dst[n][k] = *(const PG8_LAS bf16x8*)(lds + PG8_SB(b, h) + boff + n * 2048 + k * 1024); } while (0)
#define PG8_MMA(ai, bj, At, Bt) do { __builtin_amdgcn_s_setprio(1); _Pragma("unroll") for (int m = 0; m < 4; ++m) _Pragma("unroll") for (int n = 0; n < 2; ++n) { \
        if constexpr (F8) { const i32x4 b0_ = __builtin_bit_cast(i32x4, Bt[n][0]), b1_ = __builtin_bit_cast(i32x4, Bt[n][1]), a0_ = __builtin_bit_cast(i32x4, At[m][0]), a1_ = __builtin_bit_cast(i32x4, At[m][1]); \
            const i32x8 b8_ = __builtin_shufflevector(b0_, b1_, 0, 1, 2, 3, 4, 5, 6, 7), a8_ = __builtin_shufflevector(a0_, a1_, 0, 1, 2, 3, 4, 5, 6, 7); \
            asm volatile("v_mfma_scale_f32_16x16x128_f8f6f4 %0, %1, %2, %0, %3, %4 op_sel_hi:[0,0,0]" : "+v"(acc[ai][bj][m][n]) : "v"(b8_), "v"(a8_), "v"(sclB), "v"(sclA)); } \
        else { _Pragma("unroll") for (int k = 0; k < 2; ++k) acc[ai][bj][m][n] = __builtin_amdgcn_mfma_f32_16x16x32_bf16(Bt[n][k], At[m][k], acc[ai][bj][m][n], 0, 0, 0); } } \
        __builtin_amdgcn_s_setprio(0); } while (0)
#define PG8_WAIT_V(n) asm volatile("s_waitcnt vmcnt(" #n ")" ::: "memory")
#define PG8_WAIT_L(n) asm volatile("s_waitcnt lgkmcnt(" #n ")" ::: "memory")
#define PG8_BAR __builtin_amdgcn_s_barrier()
#define PG8_SCHED __builtin_amdgcn_sched_barrier(0)
#define PG8_ROWS(dst, u) do { _Pragma("unroll") for (int _h = 0; _h < 2; ++_h) _Pragma("unroll") for (int _i = 0; _i < 2; ++_i) dst[_h][_i] = S.a_row(u, _h * HALF + Rr[_i]) * (unsigned)(K * 2) + (unsigned)(Cc[_i] * 2); } while (0)
    Unit cur, nxt; int ui = 0;
    if (!S.next(0, cur)) return;
    f32x4 acc[2][2][4][2];
#pragma unroll
    for (int a = 0; a < 2; ++a)
#pragma unroll
        for (int b = 0; b < 2; ++b)
#pragma unroll
            for (int m = 0; m < 4; ++m)
#pragma unroll
                for (int n = 0; n < 2; ++n) acc[a][b][m][n] = (f32x4){0.f, 0.f, 0.f, 0.f};
    bf16x8 At[4][2], B0[2][2], B1[2][2];
    unsigned gC[2][2], gN[2][2];
    PG8_ROWS(gC, cur);
    const char* const A0 = (const char*)g.A;
    const char* cB = (const char*)g.Bt + (size_t)cur.pn * tstep;
    PG8_STAGE(PG8_SB(0, 0), cB, voffB); PG8_STAGE(PG8_SB(0, 1), cB + hstep, voffB); PG8_STAGE(PG8_SA(0, 0), A0, gC[0]); PG8_STAGE(PG8_SA(0, 1), A0, gC[1]);
    if (wr == 1) PG8_BAR;
    PG8_WAIT_V(2); PG8_BAR;
    PG8_STAGE(PG8_SB(1, 0), cB + kstep, voffB); PG8_STAGE(PG8_SA(1, 0), A0 + kstep, gC[0]); PG8_STAGE(PG8_SB(1, 1), cB + hstep + kstep, voffB);
    PG8_WAIT_V(6); PG8_BAR;
    for (;;) {
        const bool has_next = S.next(ui + 1, nxt);
        const char* nB = has_next ? (const char*)g.Bt + (size_t)nxt.pn * tstep : cB;
        if (has_next) { PG8_ROWS(gN, nxt); } else {
#pragma unroll
            for (int _h = 0; _h < 2; ++_h)
#pragma unroll
                for (int _i = 0; _i < 2; ++_i) gN[_h][_i] = gC[_h][_i]; }
        for (int t = 0; t < nt; t += 2) {
            const bool last = (t == nt - 2);
            const char* a1 = A0 + (size_t)(t + 1) * kstep;
            const char* a2 = last ? A0 : A0 + (size_t)(t + 2) * kstep; const char* b2 = last ? nB : cB + (size_t)(t + 2) * kstep;
            const char* a3 = a2 + kstep; const char* b3 = b2 + kstep;
            unsigned gX[2][2];
#pragma unroll
            for (int _h = 0; _h < 2; ++_h)
#pragma unroll
                for (int _i = 0; _i < 2; ++_i) gX[_h][_i] = last ? gN[_h][_i] : gC[_h][_i];
            PG8_LDB(B0, 0, 0); PG8_LDB(B1, 0, 1); PG8_SCHED; PG8_LDA(At, 0, 0); PG8_STAGE(PG8_SA(1, 1), a1, gC[1]);
            PG8_WAIT_V(8); PG8_WAIT_L(0); PG8_BAR; PG8_MMA(0, 0, At, B0); PG8_MMA(0, 1, At, B1); PG8_BAR; PG8_SCHED;
            PG8_LDA(At, 0, 1); PG8_STAGE(PG8_SB(0, 0), b2, voffB); PG8_STAGE(PG8_SB(0, 1), b2 + hstep, voffB); PG8_STAGE(PG8_SA(0, 0), a2, gX[0]);
            PG8_WAIT_V(8); PG8_WAIT_L(0); PG8_BAR; PG8_MMA(1, 0, At, B0); PG8_MMA(1, 1, At, B1); PG8_BAR; PG8_SCHED;
            PG8_LDB(B0, 1, 0); PG8_LDB(B1, 1, 1); PG8_SCHED; PG8_LDA(At, 1, 0); PG8_STAGE(PG8_SA(0, 1), a2, gX[1]);
            PG8_WAIT_V(8); PG8_WAIT_L(0); PG8_BAR; PG8_MMA(0, 0, At, B0); PG8_MMA(0, 1, At, B1); PG8_BAR; PG8_SCHED;
            PG8_LDA(At, 1, 1); PG8_STAGE(PG8_SB(1, 0), b3, voffB); PG8_STAGE(PG8_SB(1, 1), b3 + hstep, voffB); PG8_STAGE(PG8_SA(1, 0), a3, gX[0]);
            PG8_WAIT_V(8); PG8_WAIT_L(0); PG8_BAR; PG8_MMA(1, 0, At, B0); PG8_MMA(1, 1, At, B1); PG8_BAR; PG8_SCHED;
        }
        if (wr == 0) PG8_BAR;
        if constexpr (F8) asm volatile("s_nop 15\n\ts_nop 15" ::: "memory");
        E(acc, cur, wr, wc, fr, fq); S.done(cur);
        if (!has_next) break;
#pragma unroll
        for (int a = 0; a < 2; ++a)
#pragma unroll
            for (int b = 0; b < 2; ++b)
#pragma unroll
                for (int m = 0; m < 4; ++m)
#pragma unroll
                    for (int n = 0; n < 2; ++n) acc[a][b][m][n] = (f32x4){0.f, 0.f, 0.f, 0.f};
        cur = nxt; cB = nB; ++ui;
#pragma unroll
        for (int _h = 0; _h < 2; ++_h)
#pragma unroll
            for (int _i = 0; _i < 2; ++_i) gC[_h][_i] = gN[_h][_i];
        if (wr == 1) PG8_BAR;
    }
    PG8_WAIT_V(0);
    PG8_BAR;
#undef PG8_SA
#undef PG8_SB
#undef PG8_STAGE
#undef PG8_LDA
#undef PG8_LDB
#undef PG8_MMA
#undef PG8_WAIT_V
#undef PG8_WAIT_L
#undef PG8_BAR
#undef PG8_SCHED
#undef PG8_ROWS
}
}

constexpr int NWAVES = 8;
constexpr int BATCH = 16, SEQ = 4096, DM = 1024, NTOK = BATCH * SEQ;
constexpr int NH = 8, HD = 64, ATTW = 512, SSMW = 256, NPROJ = 3840;
constexpr int NEXP = 32, DEXP = 512, MOEB = 256;
constexpr int NROWS_PAD = NTOK * 2 + NEXP * MOEB;
constexpr int MAXTILES = NROWS_PAD / MOEB;
constexpr float RMS_EPS = 1e-6f;
constexpr float LOG2E = 1.4426950408889634f;
constexpr float W8_SCALE = 256.0f, A8_SCALE = 16.0f;
constexpr int W8_E8 = 119, A8_E8 = 123;
constexpr int SSM_L = 32, SSM_NCH = SEQ / SSM_L;

constexpr size_t MiB = 1u << 20;
constexpr size_t WS_CTL = 0, CTL_ZERO_BYTES = 1 * MiB;
constexpr size_t WS_MOD = 1 * MiB;
constexpr size_t WS_BTAB = WS_MOD + 512 * 1024;
constexpr size_t WS_KPART = 2 * MiB;
constexpr size_t WS_SSMTAB = 3 * MiB;
constexpr size_t SSM_GRP_BYTES = 294912, SSM_T_OFF = 0, SSM_W_OFF = 32768, SSM_S_OFF = 163840;
constexpr size_t WS_SSMAL = WS_SSMTAB + 16 * SSM_GRP_BYTES;
constexpr size_t WS_ROUTW = 1009 * MiB;
constexpr size_t WS_ROUTC = 1011 * MiB;
constexpr size_t WS_WIN = 9 * MiB;
constexpr size_t WS_WO = 17 * MiB;
constexpr size_t WS_WGLU = 18 * MiB;
constexpr size_t WS_WMIX = 19 * MiB;
constexpr size_t WS_WGU = 21 * MiB;
constexpr size_t WS_WDN = 85 * MiB;
constexpr size_t WS_RA = 120 * MiB;
constexpr size_t WS_RB = 256 * MiB;
constexpr size_t WS_Q = WS_RB, WS_K = WS_RB + 64 * MiB;
constexpr size_t WS_V = 384 * MiB, WS_U = 448 * MiB, WS_GA = 480 * MiB, WS_GS = 608 * MiB, WS_ATT = 736 * MiB, WS_Z = 800 * MiB;
constexpr size_t WS_H2F8 = 320 * MiB;
constexpr size_t WS_XS = 480 * MiB;
constexpr size_t WS_LIST = 832 * MiB;
constexpr size_t WS_WGT = 840 * MiB;
constexpr size_t WS_ROWMAP = 841 * MiB;
constexpr size_t WS_RW = 842 * MiB;
constexpr size_t WS_SSQ = 844 * MiB;
constexpr size_t WS_SEL = 848 * MiB;
constexpr size_t WS_PL = 850 * MiB;
constexpr size_t WS_RLIST = 860 * MiB;
constexpr size_t WS_RCNT = 876 * MiB;
constexpr size_t WS_YMIX = WS_RA;
constexpr size_t WS_H2 = 880 * MiB;
constexpr size_t WS_X1A = 384 * MiB, WS_X1B = 768 * MiB; constexpr int X1_SPLIT = 49152;
constexpr size_t WS_END = 1012 * MiB;
static_assert(WS_SSMAL + 16 * 64 * 2 * 4 <= WS_ROUTW && WS_WIN + (size_t)NPROJ * DM * 2 <= WS_WO && WS_WDN + (size_t)NEXP * DM * DEXP * 2 <= WS_RA, "ws map 1");
static_assert(WS_RA + (size_t)NROWS_PAD * DEXP * 2 <= WS_RB && WS_XS + (size_t)NROWS_PAD * DM * 2 <= WS_LIST && WS_Z + (size_t)NTOK * SSMW * 2 <= WS_LIST, "ws map 2");
constexpr int CW_BAR = 4096;
constexpr int CW_CNT = 16384;

constexpr int RING_BYTES = 131072;
constexpr int LDSCTL_OFF = RING_BYTES, MISC_OFF = LDSCTL_OFF + 320;
constexpr int TILEE_OFF = RING_BYTES + 1024;
constexpr int LDS_BYTES = 147456;
static_assert(TILEE_OFF + 4 * 1024 <= LDS_BYTES, "LDS map");

#define GAS __attribute__((address_space(1)))
#define LAS __attribute__((address_space(3)))
typedef unsigned short bf16;
typedef unsigned v4u __attribute__((ext_vector_type(4)));
typedef unsigned v2u __attribute__((ext_vector_type(2)));
typedef float f32x4 __attribute__((ext_vector_type(4)));
typedef float f32x16 __attribute__((ext_vector_type(16)));
typedef short bf16x8 __attribute__((ext_vector_type(8)));
typedef short s16x4 __attribute__((ext_vector_type(4)));
typedef GAS unsigned gu32;
#define RLX_AGENT __ATOMIC_RELAXED, __HIP_MEMORY_SCOPE_AGENT
#define LDS_WAIT() asm volatile("s_waitcnt lgkmcnt(0)" ::: "memory")
#define VM_WAIT() asm volatile("s_waitcnt vmcnt(0)" ::: "memory")
__device__ __forceinline__ unsigned pk2(float lo, float hi) { return pg8::cvt_pk_bf16(lo, hi); }
__device__ __forceinline__ float bflo(unsigned w) { return __uint_as_float(w << 16); }
__device__ __forceinline__ float bfhi(unsigned w) { return __uint_as_float(w & 0xffff0000u); }
__device__ __forceinline__ float bf2f(bf16 h) { return __uint_as_float(((unsigned)h) << 16); }
#define XB_TMO      128
#define XB_XCNT(j)  (256  + 64 * (j))
#define XB_XSUB(j)  (1280 + 64 * (j))
#define XB_XGEN(j)  (2304 + 64 * (j))
#define XB_TOP      3328
#define XB_TOPGEN   3392
#define XCD_BAR_WORDS 3456
#define XB_SPIN_CAP (1u << 18)

__device__ __forceinline__ unsigned xb_ld(unsigned* p)              { return __hip_atomic_load(p, __ATOMIC_RELAXED, __HIP_MEMORY_SCOPE_AGENT); }
__device__ __forceinline__ unsigned xb_add(unsigned* p, unsigned v) { return __hip_atomic_fetch_add(p, v, __ATOMIC_RELAXED, __HIP_MEMORY_SCOPE_AGENT); }
__device__ __forceinline__ unsigned xb_xcc_id() { return (unsigned)__builtin_amdgcn_s_getreg((3 << 11) | 20) & 0xFu; }
#define XB_SPIN(cond, bar) do { unsigned _sp = 0; while (cond) { __builtin_amdgcn_s_sleep(1); \
    if ((++_sp & 255u) == 0u) { if (xb_ld(&(bar)[XB_TMO])) break; if (_sp > XB_SPIN_CAP) { atomicAdd(&(bar)[XB_TMO], 1u); break; } } } } while (0)

struct XcdBarrier {
    unsigned* bar; unsigned x;
    volatile LAS unsigned* st;
};

__device__ __forceinline__ XcdBarrier xcd_barrier_post(unsigned* bar, volatile LAS unsigned* st) {
    XcdBarrier b; b.bar = bar; b.x = xb_xcc_id(); b.st = st;
    if (threadIdx.x == 0) (void)xb_add(&bar[XB_XCNT(b.x)], 1u);
    return b;
}
__device__ __forceinline__ void xcd_barrier_complete(unsigned* bar, unsigned x, unsigned& nloc, unsigned& nx) {
    const unsigned G = gridDim.x * gridDim.y * gridDim.z;
    unsigned sum, cnt, mine, sp = 0u;
    for (;;) {
        sum = 0u; cnt = 0u; mine = 0u;
#pragma unroll
        for (unsigned j = 0; j < 16; ++j) { const unsigned c = xb_ld(&bar[XB_XCNT(j)]); sum += c; cnt += (c > 0u) ? 1u : 0u; mine = (j == x) ? c : mine; }
        if (sum == G) break;
        __builtin_amdgcn_s_sleep(1);
        if ((++sp & 255u) == 0u) { if (xb_ld(&bar[XB_TMO])) break; if (sp > XB_SPIN_CAP) { atomicAdd(&bar[XB_TMO], 1u); break; } }
    }
    nloc = mine > 0u ? mine : 1u; nx = cnt > 0u ? cnt : 1u;
}

__device__ __forceinline__ void xcd_barrier(const XcdBarrier& b) {
    asm volatile("s_waitcnt vmcnt(0)" ::: "memory");
    __syncthreads();
    if (threadIdx.x == 0) {
        unsigned* bar = b.bar;
        __builtin_amdgcn_s_waitcnt(0);
        unsigned nloc = b.st[0], nx = b.st[1];
        if (nloc == 0u) { xcd_barrier_complete(bar, b.x, nloc, nx); b.st[0] = nloc; b.st[1] = nx; }
        const unsigned old = xb_add(&bar[XB_XSUB(b.x)], 1u);
        const unsigned gen = old / nloc;
        if (old + 1u == (gen + 1u) * nloc) {
            __builtin_amdgcn_fence(__ATOMIC_RELEASE, "agent");
            asm volatile("s_waitcnt vmcnt(0)" ::: "memory");
            const unsigned og = xb_add(&bar[XB_TOP], 1u);
            const unsigned tg = og / nx;
            if (og + 1u == (tg + 1u) * nx) xb_add(&bar[XB_TOPGEN], 1u);
            else XB_SPIN(xb_ld(&bar[XB_TOPGEN]) == tg, bar);
            __builtin_amdgcn_fence(__ATOMIC_ACQUIRE, "agent");
            xb_add(&bar[XB_XGEN(b.x)], 1u);
            asm volatile("s_waitcnt vmcnt(0)" ::: "memory");
        } else {
            XB_SPIN(xb_ld(&bar[XB_XGEN(b.x)]) == gen, bar);
            __builtin_amdgcn_fence(__ATOMIC_ACQUIRE, "agent");
            asm volatile("s_waitcnt vmcnt(0)" ::: "memory");
        }
    }
    __syncthreads();
}

struct Frame {
    LAS unsigned char* lds; volatile LAS unsigned* MISC; gu32* ctl; unsigned char* ws;
    int tid, lane, wave, vcu, G;
    const float* in[29]; float* out;
};
enum { I_X = 0, I_C, I_RELB, I_WADA, I_BADA, I_GPREMIX, I_GPOSTMIX, I_WIN, I_WATT, I_LRE, I_LIM, I_LOGDT, I_BRE, I_BIM, I_CRE, I_CIM, I_SSMD, I_WGLUV, I_WGLUG, I_WMIX,
       I_GPREFFN, I_GPOSTFFN, I_WRG, I_BRG, I_WRE, I_BRE2, I_WEG, I_WEU, I_WED };
__device__ __forceinline__ float wave_sum(float v) {
#pragma unroll
    for (int o = 1; o < 64; o <<= 1) v += __shfl_xor(v, o);
    return v;
}

__device__ __forceinline__ void p0_mod(Frame& F) {
    LAS float* cact = (LAS float*)F.lds;
    LAS float* red = (LAS float*)(F.lds + 65536);
    const float* c = F.in[I_C]; const float* w = F.in[I_WADA]; const float* bb = F.in[I_BADA];
    float* mod = (float*)(F.ws + WS_MOD);
    for (int i = F.tid; i < 16 * 1024; i += 512) { const int b = i >> 10, k = i & 1023; const float v = c[i]; cact[k * 16 + b] = v / (1.0f + __expf(-v)); }
    __syncthreads();
    const int blk = blockIdx.x, c4 = F.tid % 6, bg = (F.tid / 6) % 4, ks = F.tid / 24;
    float acc[4][4];
#pragma unroll
    for (int i = 0; i < 4; ++i)
#pragma unroll
        for (int j = 0; j < 4; ++j) acc[i][j] = 0.f;
    if (F.tid < 504) {
        for (int k = ks; k < 1024; k += 21) {
            const f32x4 wv = *(const f32x4*)(w + (size_t)k * 6144 + 24 * blk + 4 * c4);
            const f32x4 av = *(const LAS f32x4*)(cact + k * 16 + 4 * bg);
#pragma unroll
            for (int i = 0; i < 4; ++i)
#pragma unroll
                for (int j = 0; j < 4; ++j) acc[i][j] += av[i] * wv[j];
        }
#pragma unroll
        for (int i = 0; i < 4; ++i)
#pragma unroll
            for (int j = 0; j < 4; ++j) red[(ks * 24 + bg * 6 + c4) * 16 + i * 4 + j] = acc[i][j];
    }
    __syncthreads();
    if (F.tid < 384) {
        const int b = F.tid / 24, cc = F.tid % 24, cq = cc >> 2, j = cc & 3, g = b >> 2, bi = b & 3;
        float s = bb[24 * blk + cc];
        for (int q = 0; q < 21; ++q) s += red[(q * 24 + g * 6 + cq) * 16 + bi * 4 + j];
        mod[b * 6144 + 24 * blk + cc] = s;
    }
    __syncthreads();
}

__device__ __forceinline__ int t5_bucket(int d) {
    if (d < 16) return d;
    const float v = logf((float)d / 16.0f) / 2.0794415416798357f * 16.0f;
    const int b = 16 + (int)v; return b < 31 ? b : 31;
}
__device__ __forceinline__ void p0_tables(Frame& F) {
    { float* bt = (float*)(F.ws + WS_BTAB); const float* rb = F.in[I_RELB];
      for (int i = blockIdx.x * 512 + F.tid; i < 8 * 576; i += F.G * 512) { const int h = i / 576, d = i % 576 - 64;
          bt[i] = d < 0 ? -1e30f : rb[t5_bucket(d) * 8 + h] * LOG2E; } }
    { bf16* rw = (bf16*)(F.ws + WS_ROUTW); float* rcb = (float*)(F.ws + WS_ROUTC); const float* wg = F.in[I_WRG]; const float* we = F.in[I_WRE]; const float* mod = (const float*)(F.ws + WS_MOD);
      for (int i = blockIdx.x * 512 + F.tid; i < 16 * 49152; i += F.G * 512) {
          const int b = i / 49152, r = i % 49152, j = r & 7, ln = (r >> 3) & 63, nt = (r >> 9) % 3, ks = r / 1536;
          const int k = 32 * ks + 8 * (ln >> 4) + j, col = 16 * nt + (ln & 15);
          const float v = col < 4 ? wg[k * 4 + col] : (col < 36 ? we[k * 32 + col - 4] : 0.f);
          rw[i] = (bf16)(pk2(v * F.in[I_GPREFFN][k] * (1.0f + mod[b * 6144 + 4096 + k]), 0.f) & 0xffffu); }
      for (int i = blockIdx.x * 512 + F.tid; i < 16 * 48 * 8; i += F.G * 512) {
          const int sl = i & 7, col = (i >> 3) % 48, b = i / 384; float sm = 0.f;
          if (col < 36) for (int k = sl * 128; k < sl * 128 + 128; ++k) sm += mod[b * 6144 + 3072 + k] * (col < 4 ? wg[k * 4 + col] : we[k * 32 + col - 4]);
          sm += __shfl_xor(sm, 1); sm += __shfl_xor(sm, 2); sm += __shfl_xor(sm, 4);
          if (sl == 0) rcb[b * 48 + col] = col < 36 ? sm + (col < 4 ? F.in[I_BRG][col] : F.in[I_BRE2][col - 4]) : 0.f; } }
    {
        const int g = blockIdx.x & 15, part = blockIdx.x >> 4;
        LAS float* Apow = (LAS float*)F.lds;
        LAS float* Bb = Apow + 64 * 33 * 2;
        LAS float* Cc = Bb + 64 * 16 * 2;
        if (F.tid < 64) {
            const int p = F.tid; const float lr = F.in[I_LRE][g * 64 + p], li = F.in[I_LIM][g * 64 + p], dt = expf(F.in[I_LOGDT][g]);
            const float zr = lr * dt, zi = li * dt;
            for (int e = 0; e <= 32; ++e) { float sn, cs; sincosf(zi * (float)e, &sn, &cs); const float mg = expf(zr * (float)e); Apow[(p * 33 + e) * 2] = mg * cs; Apow[(p * 33 + e) * 2 + 1] = mg * sn; }
            float sn, cs, sh; sincosf(zi, &sn, &cs); sh = sinf(0.5f * zi);
            const float nr = expm1f(zr) * cs - 2.0f * sh * sh, ni = expf(zr) * sn, den = lr * lr + li * li;
            const float fr_ = (nr * lr + ni * li) / den, fi_ = (ni * lr - nr * li) / den;
            for (int ch = 0; ch < 16; ++ch) { const float br = F.in[I_BRE][(g * 64 + p) * 16 + ch], bi = F.in[I_BIM][(g * 64 + p) * 16 + ch];
                Bb[(p * 16 + ch) * 2] = fr_ * br - fi_ * bi; Bb[(p * 16 + ch) * 2 + 1] = fr_ * bi + fi_ * br; }
            if (part == 0) { float* aL = (float*)(F.ws + WS_SSMAL) + (g * 64 + p) * 2; aL[0] = Apow[(p * 33 + 32) * 2]; aL[1] = Apow[(p * 33 + 32) * 2 + 1]; }
        }
        for (int i = F.tid; i < 1024; i += 512) { const int co = i >> 6, p = i & 63; Cc[i * 2] = F.in[I_CRE][(g * 16 + co) * 64 + p]; Cc[i * 2 + 1] = F.in[I_CIM][(g * 16 + co) * 64 + p]; }
        __syncthreads();
        unsigned char* gb = F.ws + WS_SSMTAB + (size_t)g * SSM_GRP_BYTES;
        bf16* Tf = (bf16*)(gb + SSM_T_OFF); bf16* Wf = (bf16*)(gb + SSM_W_OFF); bf16* Sf = (bf16*)(gb + SSM_S_OFF);
        for (int q = F.tid; q < 1024; q += 512) {
            const int idx = part * 1024 + q, j = idx & 7, ln = (idx >> 3) & 63, dj = idx >> 9, kq = ln >> 4, co = ln & 15, lag = dj - (kq >> 1), ch = 8 * (kq & 1) + j;
            float s = 0.f;
            if (lag >= 0) for (int p = 0; p < 64; ++p) {
                const float cr = Cc[(co * 64 + p) * 2], ci = Cc[(co * 64 + p) * 2 + 1], ar = Apow[(p * 33 + lag) * 2], ai = Apow[(p * 33 + lag) * 2 + 1], br = Bb[(p * 16 + ch) * 2], bi = Bb[(p * 16 + ch) * 2 + 1];
                const float tr = cr * ar - ci * ai, ti = cr * ai + ci * ar; s += tr * br - ti * bi; }
            if (lag == 0 && co == ch) s += F.in[I_SSMD][g * 16 + co];
            Tf[idx] = (bf16)(pk2(s, 0.f) & 0xffffu);
        }
        for (int q = F.tid; q < 4096; q += 512) {
            const int idx = part * 4096 + q, j = idx & 7, ln = (idx >> 3) & 63, nt = (idx >> 9) & 7, ks = idx >> 12, kq = ln >> 4;
            const int s_ = 2 * ks + (kq >> 1), ch = 8 * (kq & 1) + j, n = 16 * nt + (ln & 15), p = n & 63, e = 31 - s_;
            const float ar = Apow[(p * 33 + e) * 2], ai = Apow[(p * 33 + e) * 2 + 1], br = Bb[(p * 16 + ch) * 2], bi = Bb[(p * 16 + ch) * 2 + 1];
            const float v = (n < 64) ? (ar * br - ai * bi) : (ar * bi + ai * br);
            Wf[idx] = (bf16)(pk2(v, 0.f) & 0xffffu);
        }
        for (int q = F.tid; q < 4096; q += 512) {
            const int idx = part * 4096 + q, j = idx & 7, ln = (idx >> 3) & 63, t = (idx >> 9) & 31, ks = idx >> 14, kq = ln >> 4;
            const int k = 32 * ks + 8 * kq + j, p = k & 63, co = ln & 15;
            const float cr = Cc[(co * 64 + p) * 2], ci = Cc[(co * 64 + p) * 2 + 1], ar = Apow[(p * 33 + t + 1) * 2], ai = Apow[(p * 33 + t + 1) * 2 + 1];
            const float v = (k < 64) ? (cr * ar - ci * ai) : -(cr * ai + ci * ar);
            Sf[idx] = (bf16)(pk2(v, 0.f) & 0xffffu);
        }
        __syncthreads();
    }
}

__device__ __forceinline__ void transpose_item(const float* W, int K, int N, bf16* WT, int mode, LAS float* scr, int item, int lane) {
    const int nblk = N / 32, kb = item / nblk, nb = item % nblk, k0 = 64 * kb, n0 = 32 * nb;
    float tv[32];
#pragma unroll
    for (int i = 0; i < 32; ++i) { const int kk = 2 * i + (lane >> 5); tv[i] = W[(size_t)(k0 + kk) * N + n0 + (lane & 31)]; }
#pragma unroll
    for (int i = 0; i < 32; ++i) { const int kk = 2 * i + (lane >> 5); scr[kk * 33 + (lane & 31)] = tv[i]; }
    LDS_WAIT(); asm volatile("" ::: "memory");
    const int c = lane & 7;
#pragma unroll
    for (int j = 0; j < 4; ++j) { const int n = (lane >> 3) + 8 * j; const LAS float* s = scr + (8 * c) * 33 + n;
        v4u o; o.x = pk2(s[0 * 33], s[1 * 33]); o.y = pk2(s[2 * 33], s[3 * 33]); o.z = pk2(s[4 * 33], s[5 * 33]); o.w = pk2(s[6 * 33], s[7 * 33]);
        const int ng = n0 + n; const int drow = mode == 0 ? ng : (256 * (ng >> 7) + (ng & 127) + (mode == 2 ? 128 : 0));
        *(GAS v4u*)(WT + (size_t)drow * K + k0 + 8 * c) = o; }
    LDS_WAIT(); asm volatile("" ::: "memory");
}
__device__ __forceinline__ float clamp8(float v) { return __builtin_amdgcn_fmed3f(v, -440.f, 440.f); }
__device__ __forceinline__ unsigned pk4_fp8(float a, float b, float c, float d) { int w = __builtin_amdgcn_cvt_pk_fp8_f32(clamp8(a), clamp8(b), 0, false); w = __builtin_amdgcn_cvt_pk_fp8_f32(clamp8(c), clamp8(d), w, true); return (unsigned)w; }
__device__ __forceinline__ void transpose_item_f8(const float* W, int K, int N, unsigned char* WT, int mode, float scale, LAS float* scr, int item, int lane) {
    const int nblk = N / 32, kb = item / nblk, nb = item % nblk, k0 = 64 * kb, n0 = 32 * nb;
    const int g = lane >> 3, c = lane & 7;
    f32x4 tv[8];
    const float* wp = W + (size_t)(k0 + 8 * g) * N + n0 + 4 * c;
#pragma unroll
    for (int i = 0; i < 8; ++i) tv[i] = *(const f32x4*)(wp + (size_t)i * N);
#pragma unroll
    for (int j = 0; j < 4; ++j) {
        v2u o; o.x = pk4_fp8(tv[0][j] * scale, tv[1][j] * scale, tv[2][j] * scale, tv[3][j] * scale); o.y = pk4_fp8(tv[4][j] * scale, tv[5][j] * scale, tv[6][j] * scale, tv[7][j] * scale);
        const int ng = n0 + 4 * c + j; const int drow = mode == 0 ? ng : (256 * (ng >> 7) + (ng & 127) + (mode == 2 ? 128 : 0));
        *(GAS v2u*)(WT + (size_t)drow * K + k0 + 8 * g) = o; }
    (void)scr;
}
#define WDESC(it, S) const float* W##S; unsigned char* D##S; int K##S, N##S, M##S, I##S; do { const int it_ = (it); \
        if (it_ < I0) { W##S = F.in[I_WIN]; D##S = F.ws + WS_WIN; K##S = 1024; N##S = NPROJ; M##S = 0; I##S = it_; } \
        else if (it_ < I1) { W##S = F.in[I_WATT]; D##S = F.ws + WS_WO; K##S = 512; N##S = 1024; M##S = 0; I##S = it_ - I0; } \
        else if (it_ < I2) { W##S = F.in[I_WGLUV]; D##S = F.ws + WS_WGLU; K##S = 256; N##S = 1024; M##S = 1; I##S = it_ - I1; } \
        else if (it_ < I3) { W##S = F.in[I_WGLUG]; D##S = F.ws + WS_WGLU; K##S = 256; N##S = 1024; M##S = 2; I##S = it_ - I2; } \
        else if (it_ < I4) { W##S = F.in[I_WMIX]; D##S = F.ws + WS_WMIX; K##S = 1024; N##S = 1024; M##S = 0; I##S = it_ - I3; } \
        else if (it_ < I5) { const int r_ = it_ - I4, e_ = r_ >> 8; W##S = F.in[I_WEG] + (size_t)e_ * 1024 * 512; D##S = F.ws + WS_WGU + (size_t)e_ * 1024 * 1024; K##S = 1024; N##S = 512; M##S = 1; I##S = r_ & 255; } \
        else if (it_ < I6) { const int r_ = it_ - I5, e_ = r_ >> 8; W##S = F.in[I_WEU] + (size_t)e_ * 1024 * 512; D##S = F.ws + WS_WGU + (size_t)e_ * 1024 * 1024; K##S = 1024; N##S = 512; M##S = 2; I##S = r_ & 255; } \
        else { const int r_ = it_ - I6, e_ = r_ >> 8; W##S = F.in[I_WED] + (size_t)e_ * 512 * 1024; D##S = F.ws + WS_WDN + (size_t)e_ * 1024 * 512; K##S = 512; N##S = 1024; M##S = 0; I##S = r_ & 255; } } while (0)
#define WLOAD(S, tv) do { const int nblk_ = N##S / 32, kb_ = I##S / nblk_, nb_ = I##S % nblk_; const float* wp_ = W##S + (size_t)(64 * kb_ + 8 * (lane >> 3)) * N##S + 32 * nb_ + 4 * (lane & 7); \
        _Pragma("unroll") for (int i = 0; i < 8; ++i) tv[i] = __builtin_nontemporal_load((const f32x4*)(wp_ + (size_t)i * N##S)); } while (0)
#define WSTORE(S, tv) do { const int nblk_ = N##S / 32, kb_ = I##S / nblk_, nb_ = I##S % nblk_, k0_ = 64 * kb_, n0_ = 32 * nb_, g_ = lane >> 3, c_ = lane & 7; \
        _Pragma("unroll") for (int j = 0; j < 4; ++j) { v2u o; o.x = pk4_fp8(tv[0][j] * W8_SCALE, tv[1][j] * W8_SCALE, tv[2][j] * W8_SCALE, tv[3][j] * W8_SCALE); o.y = pk4_fp8(tv[4][j] * W8_SCALE, tv[5][j] * W8_SCALE, tv[6][j] * W8_SCALE, tv[7][j] * W8_SCALE); \
            const int ng = n0_ + 4 * c_ + j; const int drow = M##S == 0 ? ng : (256 * (ng >> 7) + (ng & 127) + (M##S == 2 ? 128 : 0)); \
            *(GAS v2u*)(D##S + (size_t)drow * K##S + k0_ + 8 * g_) = o; } } while (0)
constexpr int WI_EXPERT = 16 * 120 + 8 * 32 + 4 * 32 + 4 * 32 + 16 * 32, WI_END = WI_EXPERT + 3 * 32 * 256;
__device__ __forceinline__ void p0_weights(Frame& F, const int lo, const int hi) {
    const int lane = F.lane; const int gw = F.vcu * NWAVES + F.wave, NGW = F.G * NWAVES;
    constexpr int I0 = 16 * 120, I1 = I0 + 8 * 32, I2 = I1 + 4 * 32, I3 = I2 + 4 * 32, I4 = I3 + 16 * 32, I5 = I4 + 32 * 256, I6 = I5 + 32 * 256, I7 = I6 + 32 * 256;
    static_assert(I4 == WI_EXPERT && I7 == WI_END, "item ranges");
    f32x4 nv[8];
    if (lo + gw < hi) { WDESC(lo + gw, a); WLOAD(a, nv); }
    for (int it = lo + gw; it < hi; it += NGW) {
        f32x4 cv[8];
#pragma unroll
        for (int i = 0; i < 8; ++i) cv[i] = nv[i];
        const int nit = it + NGW < hi ? it + NGW : it;
        { WDESC(nit, n); WLOAD(n, nv); }
        { WDESC(it, c); WSTORE(c, cv); }
    }
}
#undef WDESC
#undef WLOAD
#undef WSTORE

__device__ __forceinline__ void p1_xn(Frame& F) {
    const int gw = F.vcu * NWAVES + F.wave; const int row0 = gw * 32, b = row0 >> 12;
    const float* mod = (const float*)(F.ws + WS_MOD) + b * 6144; const float* g = F.in[I_GPREMIX];
    f32x4 A1[4], A3[4];
#pragma unroll
    for (int j = 0; j < 4; ++j) { const int c = 4 * F.lane + 256 * j; const f32x4 gg = *(const f32x4*)(g + c), sc = *(const f32x4*)(mod + 1024 + c); A1[j] = gg * (sc + 1.0f); A3[j] = *(const f32x4*)(mod + c); }
    unsigned char* XN = F.ws + WS_RA;
    f32x4 nx[4];
    { const f32x4* xr = (const f32x4*)(F.in[I_X] + (size_t)row0 * 1024) + F.lane;
#pragma unroll
      for (int j = 0; j < 4; ++j) nx[j] = __builtin_nontemporal_load(xr + 64 * j); }
    for (int r = 0; r < 32; ++r) {
        const size_t row = (size_t)(row0 + r);
        f32x4 v[4]; float s = 0.f;
#pragma unroll
        for (int j = 0; j < 4; ++j) v[j] = nx[j];
        { const f32x4* xr = (const f32x4*)(F.in[I_X] + (row + (r < 31 ? 1 : 0)) * 1024) + F.lane;
#pragma unroll
          for (int j = 0; j < 4; ++j) nx[j] = __builtin_nontemporal_load(xr + 64 * j); }
#pragma unroll
        for (int j = 0; j < 4; ++j) s += (v[j].x * v[j].x + v[j].y * v[j].y) + (v[j].z * v[j].z + v[j].w * v[j].w);
        const float rstd = rsqrtf(wave_sum(s) * (1.0f / 1024.0f) + RMS_EPS);
        unsigned* o = (unsigned*)(XN + row * 1024) + F.lane;
#pragma unroll
        for (int j = 0; j < 4; ++j) { const f32x4 h = (v[j] * rstd * A1[j] + A3[j]) * A8_SCALE; o[64 * j] = pk4_fp8(h.x, h.y, h.z, h.w); }
    }
}

namespace att {
constexpr int LK = 0, LV = 32768, LBT = 65536, LKM = 67840, LWS = 72192, LSTG = 74240, LLIST = 111104;
constexpr int STG_ROW = 144, STG_WAVE = 32 * STG_ROW;
#define KSWZ64(row, colB) ((row) * 128 + ((colB) ^ ((((row) >> 1) & 7) << 4)))
__device__ __forceinline__ int crow(int r, int hi) { return (r & 3) + 8 * (r >> 2) + 4 * hi; }
__device__ __forceinline__ int v_st(int k, int c) { const int kk = (k & ~0xC) | ((k & 4) << 1) | ((k & 8) >> 1); return ((kk >> 3) * 2 + (c >> 5)) * 512 + ((kk & 7) * 32 + (c & 31)) * 2; }
__device__ __forceinline__ int v_rd_base(int lane) { return ((lane & 3) << 3) | (((lane >> 2) & 3) << 6) | (((lane >> 4) & 1) << 5) | (((lane >> 5) & 1) << 8); }
constexpr int v_rd_off(int d0, int ks, int half) { return d0 * 512 + ks * 2048 + half * 1024; }
template <int OFF> __device__ __forceinline__ s16x4 tr_read(int vb) { s16x4 r; asm volatile("ds_read_b64_tr_b16 %0, %1 offset:%2" : "=&v"(r) : "v"(vb), "i"(OFF) : "memory"); return r; }
#define SBAR() __builtin_amdgcn_sched_barrier(0)
template <int D0> __device__ __forceinline__ void pv_one(f32x16& od, int vb, bf16x8 pa0, bf16x8 pa1, bf16x8 pa2, bf16x8 pa3) {
    const s16x4 l0 = tr_read<v_rd_off(D0, 0, 0)>(vb), h0 = tr_read<v_rd_off(D0, 0, 1)>(vb), l1 = tr_read<v_rd_off(D0, 1, 0)>(vb), h1 = tr_read<v_rd_off(D0, 1, 1)>(vb);
    const s16x4 l2 = tr_read<v_rd_off(D0, 2, 0)>(vb), h2 = tr_read<v_rd_off(D0, 2, 1)>(vb), l3 = tr_read<v_rd_off(D0, 3, 0)>(vb), h3 = tr_read<v_rd_off(D0, 3, 1)>(vb);
    asm volatile("s_waitcnt lgkmcnt(0)" ::: "memory"); SBAR();
#define PK(L, H) (bf16x8){L[0], L[1], L[2], L[3], H[0], H[1], H[2], H[3]}
    od = __builtin_amdgcn_mfma_f32_32x32x16_bf16(pa0, PK(l0, h0), od, 0, 0, 0);
    od = __builtin_amdgcn_mfma_f32_32x32x16_bf16(pa1, PK(l1, h1), od, 0, 0, 0);
    od = __builtin_amdgcn_mfma_f32_32x32x16_bf16(pa2, PK(l2, h2), od, 0, 0, 0);
    od = __builtin_amdgcn_mfma_f32_32x32x16_bf16(pa3, PK(l3, h3), od, 0, 0, 0);
#undef PK
}
__device__ __forceinline__ void pv_two(f32x16 (&o)[2], int vb, bf16x8 pa0, bf16x8 pa1, bf16x8 pa2, bf16x8 pa3) {
    const s16x4 l0 = tr_read<v_rd_off(0, 0, 0)>(vb), h0 = tr_read<v_rd_off(0, 0, 1)>(vb), l1 = tr_read<v_rd_off(0, 1, 0)>(vb), h1 = tr_read<v_rd_off(0, 1, 1)>(vb);
    const s16x4 l2 = tr_read<v_rd_off(0, 2, 0)>(vb), h2 = tr_read<v_rd_off(0, 2, 1)>(vb), l3 = tr_read<v_rd_off(0, 3, 0)>(vb), h3 = tr_read<v_rd_off(0, 3, 1)>(vb);
    const s16x4 m0 = tr_read<v_rd_off(1, 0, 0)>(vb), g0 = tr_read<v_rd_off(1, 0, 1)>(vb), m1 = tr_read<v_rd_off(1, 1, 0)>(vb), g1 = tr_read<v_rd_off(1, 1, 1)>(vb);
    const s16x4 m2 = tr_read<v_rd_off(1, 2, 0)>(vb), g2 = tr_read<v_rd_off(1, 2, 1)>(vb), m3 = tr_read<v_rd_off(1, 3, 0)>(vb), g3 = tr_read<v_rd_off(1, 3, 1)>(vb);
    asm volatile("s_waitcnt lgkmcnt(8)" ::: "memory"); SBAR();
#define PK(L, H) (bf16x8){L[0], L[1], L[2], L[3], H[0], H[1], H[2], H[3]}
    o[0] = __builtin_amdgcn_mfma_f32_32x32x16_bf16(pa0, PK(l0, h0), o[0], 0, 0, 0);
    o[0] = __builtin_amdgcn_mfma_f32_32x32x16_bf16(pa1, PK(l1, h1), o[0], 0, 0, 0);
    o[0] = __builtin_amdgcn_mfma_f32_32x32x16_bf16(pa2, PK(l2, h2), o[0], 0, 0, 0);
    o[0] = __builtin_amdgcn_mfma_f32_32x32x16_bf16(pa3, PK(l3, h3), o[0], 0, 0, 0);
    asm volatile("s_waitcnt lgkmcnt(0)" ::: "memory"); SBAR();
    o[1] = __builtin_amdgcn_mfma_f32_32x32x16_bf16(pa0, PK(m0, g0), o[1], 0, 0, 0);
    o[1] = __builtin_amdgcn_mfma_f32_32x32x16_bf16(pa1, PK(m1, g1), o[1], 0, 0, 0);
    o[1] = __builtin_amdgcn_mfma_f32_32x32x16_bf16(pa2, PK(m2, g2), o[1], 0, 0, 0);
    o[1] = __builtin_amdgcn_mfma_f32_32x32x16_bf16(pa3, PK(m3, g3), o[1], 0, 0, 0);
#undef PK
}
__device__ __forceinline__ void stage_kv(Frame& F, size_t rowb, int h, int key0, int ntile) {
    const bf16* Kg = (const bf16*)(F.ws + WS_K); const bf16* Vg = (const bf16*)(F.ws + WS_V);
    const int sr = F.tid >> 3, sc = (F.tid & 7) * 8; const int kst = KSWZ64(sr, sc * 2), vst = v_st(sr, sc);
    for (int t = 0; t < ntile; ++t) { const size_t go = (rowb + key0 + t * 64 + sr) * ATTW + h * HD + sc;
        const bf16x8 kv = *(const bf16x8*)(Kg + go), vv = *(const bf16x8*)(Vg + go);
        *(LAS bf16x8*)(F.lds + LK + t * 8192 + kst) = kv; *(LAS bf16x8*)(F.lds + LV + t * 8192 + vst) = vv; }
}
template <bool GENERAL> __device__ __forceinline__ void tile_step(LAS unsigned char* L, int kt, const bf16x8 (&qr)[4], float cinit, int ib, float& m_reg, float& l_reg, f32x16 (&o)[2],
                                                                  LAS float* wsf, int r32, int hi, int vb0) {
    f32x16 p0, p1;
#pragma unroll
    for (int r = 0; r < 16; ++r) { p0[r] = cinit; p1[r] = cinit; }
    const LAS unsigned char* Kt = L + LK + kt * 8192;
#pragma unroll
    for (int d0 = 0; d0 < 4; ++d0) { const int cb = (d0 * 16 + hi * 8) * 2;
        const bf16x8 k0 = *(const LAS bf16x8*)(Kt + KSWZ64(r32, cb)); const bf16x8 k1 = *(const LAS bf16x8*)(Kt + KSWZ64(32 + r32, cb));
        p0 = __builtin_amdgcn_mfma_f32_32x32x16_bf16(k0, qr[d0], p0, 0, 0, 0);
        p1 = __builtin_amdgcn_mfma_f32_32x32x16_bf16(k1, qr[d0], p1, 0, 0, 0); }
    if (GENERAL) {
        const LAS float* btab = (const LAS float*)(L + LBT);
        float bv0[16], bv1[16];
#pragma unroll
        for (int r = 0; r < 16; ++r) { const int c = (r & 3) + 8 * (r >> 2); bv0[r] = btab[ib - c]; bv1[r] = btab[ib - 32 - c]; }
        SBAR();
#pragma unroll
        for (int r = 0; r < 16; ++r) { p0[r] += bv0[r]; p1[r] += bv1[r]; }
    }
    float pmax = p0[0];
#pragma unroll
    for (int r = 1; r < 16; ++r) pmax = fmaxf(pmax, p0[r]);
#pragma unroll
    for (int r = 0; r < 16; ++r) pmax = fmaxf(pmax, p1[r]);
    { auto rr = __builtin_amdgcn_permlane32_swap(__float_as_uint(pmax), __float_as_uint(pmax), false, false); pmax = fmaxf(__uint_as_float(rr[0]), __uint_as_float(rr[1])); }
    pmax = fmaxf(pmax, -1e20f);
    const float mn = fmaxf(m_reg, pmax); const float alpha = __builtin_amdgcn_exp2f(m_reg - mn); m_reg = mn;
    float ps = 0.f;
#pragma unroll
    for (int r = 0; r < 16; ++r) { p0[r] = __builtin_amdgcn_exp2f(p0[r] - mn); p1[r] = __builtin_amdgcn_exp2f(p1[r] - mn); ps += p0[r] + p1[r]; }
    { auto rr = __builtin_amdgcn_permlane32_swap(__float_as_uint(ps), __float_as_uint(ps), false, false); ps = __uint_as_float(rr[0]) + __uint_as_float(rr[1]); }
    l_reg = l_reg * alpha + ps;
    bf16x8 pa0, pa1, pa2, pa3;
#define PK4(P, BASE, OUT) do { unsigned a0 = pk2(P[BASE + 0], P[BASE + 1]), a1 = pk2(P[BASE + 2], P[BASE + 3]); \
    unsigned b0 = pk2(P[BASE + 4], P[BASE + 5]), b1 = pk2(P[BASE + 6], P[BASE + 7]); \
    auto r0 = __builtin_amdgcn_permlane32_swap(a0, b0, false, false); auto r1 = __builtin_amdgcn_permlane32_swap(a1, b1, false, false); \
    v4u w = {r0[0], r1[0], r0[1], r1[1]}; OUT = __builtin_bit_cast(bf16x8, w); } while (0)
    PK4(p0, 0, pa0); PK4(p0, 8, pa1); PK4(p1, 0, pa2); PK4(p1, 8, pa3);
#undef PK4
    if (__any(alpha < 1.f)) { if (hi == 0) wsf[r32] = alpha; LDS_WAIT();
#pragma unroll
        for (int r = 0; r < 16; ++r) { const float a = wsf[crow(r, hi)]; o[0][r] *= a; o[1][r] *= a; }
        LDS_WAIT(); }
    const int vb = vb0 + kt * 8192;
    pv_one<0>(o[0], vb, pa0, pa1, pa2, pa3); pv_one<1>(o[1], vb, pa0, pa1, pa2, pa3);
}

__device__ __forceinline__ bool owned(int qb, int sub) { const int q = qb & 3; return sub ? (q == 1 || q == 2) : (q == 0 || q == 3); }
__device__ __forceinline__ void select_rows(Frame& F, int b, int h, int half) {
    LAS float* kmean = (LAS float*)(F.lds + LKM);
    LAS unsigned short* mloc = (LAS unsigned short*)(F.lds + LK);
    LAS int* lcnt = (LAS int*)(F.lds + LK + 4096);
    { const float* kp = (const float*)(F.ws + WS_KPART);
      for (int i = F.tid; i < 1024; i += 512) { const int n = i >> 6, d = i & 63; const size_t o = (size_t)((b * 16 + n) * 2) * 512 + h * 64 + d; kmean[i] = (kp[o] + kp[o + 512]) * (1.0f / 256.0f); }
      if (F.tid < 32) lcnt[F.tid] = 0; }
    __syncthreads();
    const bf16* Qg = (const bf16*)(F.ws + WS_Q); unsigned short* sel = (unsigned short*)(F.ws + WS_SEL);
    for (int c = 0; c < 4; ++c) {
        const int row = half * 2048 + c * 512 + F.tid, qb = row >> 8;
        const v4u* qp = (const v4u*)(Qg + ((size_t)b * SEQ + row) * ATTW + h * HD);
        float qf[64];
#pragma unroll
        for (int i = 0; i < 8; ++i) { const v4u w = qp[i]; qf[8 * i] = bflo(w.x); qf[8 * i + 1] = bfhi(w.x); qf[8 * i + 2] = bflo(w.y); qf[8 * i + 3] = bfhi(w.y); qf[8 * i + 4] = bflo(w.z); qf[8 * i + 5] = bfhi(w.z); qf[8 * i + 6] = bflo(w.w); qf[8 * i + 7] = bfhi(w.w); }
        float v0 = -3.0e38f, v1 = -3.0e38f, v2 = -3.0e38f; int i0 = -1, i1 = -1, i2 = -1;
        for (int n = 0; n < qb; ++n) {
            float g = 0.f;
#pragma unroll
            for (int d = 0; d < 64; ++d) g += qf[d] * kmean[n * 64 + d];
            if (g > v0) { v2 = v1; i2 = i1; v1 = v0; i1 = i0; v0 = g; i0 = n; }
            else if (g > v1) { v2 = v1; i2 = i1; v1 = g; i1 = n; }
            else if (g > v2) { v2 = g; i2 = n; }
        }
        unsigned m = 0u; if (i0 >= 0) m |= 1u << i0; if (i1 >= 0) m |= 1u << i1; if (i2 >= 0) m |= 1u << i2;
        sel[((size_t)(b * NH + h)) * SEQ + row] = (unsigned short)m; mloc[c * 512 + F.tid] = (unsigned short)m;
    }
    __syncthreads();
    unsigned short* rl = (unsigned short*)(F.ws + WS_RLIST) + ((size_t)(b * NH + h) * 16) * 4 * 1024;
    for (int qi = 0; qi < 8; ++qi) {
        const int qb = half * 8 + qi, sub = owned(qb, 0) ? 0 : 1;
        if (F.tid < 256) { const int lr = qi * 256 + F.tid; unsigned m = mloc[lr];
            while (m) { const int n = __builtin_ctz(m); m &= m - 1u; const int pos = __hip_atomic_fetch_add(lcnt + n * 2 + sub, 1, __ATOMIC_RELAXED, __HIP_MEMORY_SCOPE_WORKGROUP);
                rl[((size_t)(n * 2 + sub) * 2 + half) * 1024 + pos] = (unsigned short)(half * 2048 + lr); } }
        __syncthreads();
    }
    if (F.tid < 32) { int* rc = (int*)(F.ws + WS_RCNT) + ((size_t)(b * NH + h) * 16) * 4; rc[F.tid * 2 + half] = lcnt[F.tid]; }
    __syncthreads();
}

template <bool GENERAL, bool FIRST, bool PREF> __device__ __forceinline__ void tile_pair(LAS unsigned char* L, int kt0, bf16x8 (&qr)[4], float cinit, int ib, float& m_reg, float& l_reg, f32x16 (&o)[2],
                                                                             LAS float* wsf, int r32, int hi, int vb0, const bf16* qnext) {
    f32x16 s[2][2];
#pragma unroll
    for (int t = 0; t < 2; ++t) {
#pragma unroll
        for (int r = 0; r < 16; ++r) { s[t][0][r] = cinit; s[t][1][r] = cinit; }
        const LAS unsigned char* Kt = L + LK + (kt0 + t) * 8192;
#pragma unroll
        for (int d0 = 0; d0 < 4; ++d0) { const int cb = (d0 * 16 + hi * 8) * 2;
            const bf16x8 k0 = *(const LAS bf16x8*)(Kt + KSWZ64(r32, cb)); const bf16x8 k1 = *(const LAS bf16x8*)(Kt + KSWZ64(32 + r32, cb));
            s[t][0] = __builtin_amdgcn_mfma_f32_32x32x16_bf16(k0, qr[d0], s[t][0], 0, 0, 0);
            s[t][1] = __builtin_amdgcn_mfma_f32_32x32x16_bf16(k1, qr[d0], s[t][1], 0, 0, 0); }
    }
    if (PREF) {
#pragma unroll
        for (int d0 = 0; d0 < 4; ++d0) qr[d0] = *(const bf16x8*)(qnext + d0 * 16); }
    if (GENERAL) {
        const LAS float* btab = (const LAS float*)(L + LBT);
#pragma unroll
        for (int t = 0; t < 2; ++t) { float bv0[16], bv1[16];
#pragma unroll
            for (int r = 0; r < 16; ++r) { const int c = (r & 3) + 8 * (r >> 2); int i0 = ib - t * 64 - c, i1 = ib - t * 64 - 32 - c; i0 = i0 < 575 ? i0 : 575; i1 = i1 < 575 ? i1 : 575; bv0[r] = btab[i0]; bv1[r] = btab[i1]; }
            SBAR();
#pragma unroll
            for (int r = 0; r < 16; ++r) { s[t][0][r] += bv0[r]; s[t][1][r] += bv1[r]; } }
    }
    float pmax = fmaxf(s[0][0][0], s[1][0][0]);
#pragma unroll
    for (int r = 0; r < 16; ++r) pmax = fmaxf(pmax, fmaxf(fmaxf(s[0][0][r], s[0][1][r]), fmaxf(s[1][0][r], s[1][1][r])));
    { auto rr = __builtin_amdgcn_permlane32_swap(__float_as_uint(pmax), __float_as_uint(pmax), false, false); pmax = fmaxf(__uint_as_float(rr[0]), __uint_as_float(rr[1])); }
    pmax = fmaxf(pmax, -1e20f);
    const float mn = fmaxf(m_reg, pmax); const float alpha = __builtin_amdgcn_exp2f(m_reg - mn); m_reg = mn;
    float ps = 0.f;
#pragma unroll
    for (int t = 0; t < 2; ++t)
#pragma unroll
        for (int r = 0; r < 16; ++r) { s[t][0][r] = __builtin_amdgcn_exp2f(s[t][0][r] - mn); s[t][1][r] = __builtin_amdgcn_exp2f(s[t][1][r] - mn); ps += s[t][0][r] + s[t][1][r]; }
    { auto rr = __builtin_amdgcn_permlane32_swap(__float_as_uint(ps), __float_as_uint(ps), false, false); ps = __uint_as_float(rr[0]) + __uint_as_float(rr[1]); }
    l_reg = FIRST ? ps : (l_reg * alpha + ps);
    if (!FIRST) { if (__any(alpha < 1.f)) { if (hi == 0) wsf[r32] = alpha; LDS_WAIT();
#pragma unroll
        for (int r = 0; r < 16; ++r) { const float a = wsf[crow(r, hi)]; o[0][r] *= a; o[1][r] *= a; }
        LDS_WAIT(); } }
#define PK4(P, BASE, OUT) do { unsigned a0 = pk2(P[BASE + 0], P[BASE + 1]), a1 = pk2(P[BASE + 2], P[BASE + 3]); \
    unsigned b0 = pk2(P[BASE + 4], P[BASE + 5]), b1 = pk2(P[BASE + 6], P[BASE + 7]); \
    auto r0 = __builtin_amdgcn_permlane32_swap(a0, b0, false, false); auto r1 = __builtin_amdgcn_permlane32_swap(a1, b1, false, false); \
    v4u w = {r0[0], r1[0], r0[1], r1[1]}; OUT = __builtin_bit_cast(bf16x8, w); } while (0)
#pragma unroll
    for (int t = 0; t < 2; ++t) { bf16x8 pa0, pa1, pa2, pa3;
        PK4(s[t][0], 0, pa0); PK4(s[t][0], 8, pa1); PK4(s[t][1], 0, pa2); PK4(s[t][1], 8, pa3);
        const int vb = vb0 + (kt0 + t) * 8192;
        pv_one<0>(o[0], vb, pa0, pa1, pa2, pa3); pv_one<1>(o[1], vb, pa0, pa1, pa2, pa3); }
#undef PK4
}

struct MobaPre { bf16x8 k[4], v[4]; v2u lw; int c0, c1; };
__device__ __forceinline__ void moba_preload(Frame& F, int b, int h, int n, int sub, MobaPre& P) {
    int tid = F.tid; asm volatile("" : "+v"(tid));
    const size_t rowb = (size_t)b * SEQ; const int sr = tid >> 3, sc = (tid & 7) * 8;
    const bf16* Kg = (const bf16*)(F.ws + WS_K); const bf16* Vg = (const bf16*)(F.ws + WS_V);
#pragma unroll
    for (int t = 0; t < 4; ++t) { const size_t go = (rowb + n * 256 + t * 64 + sr) * ATTW + h * HD + sc; P.k[t] = *(const bf16x8*)(Kg + go); P.v[t] = *(const bf16x8*)(Vg + go); }
    const int* rc = (const int*)(F.ws + WS_RCNT) + (((size_t)(b * NH + h) * 16 + n) * 2 + sub) * 2;
    P.c0 = rc[0]; P.c1 = rc[1];
    const int hf = tid >> 8, e0 = (tid & 255) * 4;
    P.lw = *(const v2u*)((const unsigned short*)(F.ws + WS_RLIST) + ((((size_t)(b * NH + h) * 16 + n) * 2 + sub) * 2 + hf) * 1024 + e0);
}
__device__ __forceinline__ void moba_unit(Frame& F, int b, int h, int n, int sub, MobaPre& P) {
    const int tid = F.tid, lane = F.lane, wid = F.wave, r32 = lane & 31, hi = lane >> 5;
    LAS unsigned char* L = F.lds; const size_t rowb = (size_t)b * SEQ;
    LAS float* btab = (LAS float*)(L + LBT); LAS float* wsf = (LAS float*)(L + LWS) + wid * 64;
    LAS unsigned short* list = (LAS unsigned short*)(L + LLIST); LAS int* qctr = (LAS int*)(L + LKM + 64);
    const unsigned short* sel = (const unsigned short*)(F.ws + WS_SEL) + ((size_t)(b * NH + h)) * SEQ;
    __syncthreads();
    const int sr = tid >> 3, sc = (tid & 7) * 8; const int kst = KSWZ64(sr, sc * 2), vst = v_st(sr, sc);
    const int c0 = P.c0, c1 = P.c1;
    { const int hf = tid >> 8, e0 = (tid & 255) * 4; const int ch = hf ? c1 : c0, ob = hf ? c0 : 0; const v2u w = P.lw;
      if (e0 < ch) {
          list[ob + e0] = (unsigned short)(w.x & 0xffffu); if (e0 + 1 < ch) list[ob + e0 + 1] = (unsigned short)(w.x >> 16);
          if (e0 + 2 < ch) list[ob + e0 + 2] = (unsigned short)(w.y & 0xffffu); if (e0 + 3 < ch) list[ob + e0 + 3] = (unsigned short)(w.y >> 16); } }
    const int base = c0 + c1;
#pragma unroll
    for (int t = 0; t < 4; ++t) { *(LAS bf16x8*)(L + LK + t * 8192 + kst) = P.k[t]; *(LAS bf16x8*)(L + LV + t * 8192 + vst) = P.v[t]; }
    if (tid == 0) qctr[0] = 0;
    __syncthreads();
    const int count = base; const int ngroups = (count + 31) >> 5;
    const int nown = owned(n, sub) ? 8 : 0, nitems = nown + ngroups;
    const float b31 = btab[64 + 200];
    const int vb0 = (int)(unsigned)(uintptr_t)(L + LV) + v_rd_base(lane);
    const bf16* Qg = (const bf16*)(F.ws + WS_Q);
    unsigned char* PO8 = (unsigned char*)F.out; float* PL = (float*)(F.ws + WS_PL);
    typedef float f32x2_ __attribute__((ext_vector_type(2)));
    LAS unsigned char* stg = L + LSTG + wid * STG_WAVE;
#define PULL(v) do { int _v = 0; if (lane == 0) _v = __hip_atomic_fetch_add(qctr, 1, __ATOMIC_RELAXED, __HIP_MEMORY_SCOPE_WORKGROUP); v = __builtin_amdgcn_readfirstlane(_v); } while (0)
#define ITEM_ROW(it) (((it) < nown) ? (n * 256 + (7 - (it)) * 32 + r32) : (int)list[(((it) - nown) * 32 + r32) < count ? (((it) - nown) * 32 + r32) : count - 1])
    int cur; PULL(cur);
    bf16x8 qr[4]; int row = 0;
    if (cur < nitems) { row = ITEM_ROW(cur); const bf16* Qw = Qg + (rowb + row) * ATTW + h * HD + hi * 8;
#pragma unroll
        for (int d0 = 0; d0 < 4; ++d0) qr[d0] = *(const bf16x8*)(Qw + d0 * 16); }
    while (cur < nitems) {
        int nxt; PULL(nxt);
        const int rown = ITEM_ROW(nxt < nitems ? nxt : cur);
        const bf16* Qn = Qg + (rowb + rown) * ATTW + h * HD + hi * 8;
        float m_reg = -1e30f, l_reg = 0.f; f32x16 o[2]; o[0] = f32x16{}; o[1] = f32x16{};
        const unsigned msk = sel[row];
        if (cur < nown) {
            const int rg = 7 - cur; const int nkt = (rg >> 1) + 1;
            const size_t pi = ((rowb + row) * NH + h) * 3;
            float lsraw[3];
#pragma unroll
            for (int s = 0; s < 3; ++s) lsraw[s] = PL[pi + s];
            for (int kt = 0; kt < nkt; ++kt) tile_step<true>(L, kt, qr, 0.f, 64 + (rg * 32 + r32) - kt * 64 - 4 * hi, m_reg, l_reg, o, wsf, r32, hi, vb0);
            const int nv = __builtin_popcount(msk);
            const float lse_own = m_reg + __builtin_amdgcn_logf(l_reg);
            float ls[3]; float M = lse_own;
#pragma unroll
            for (int s = 0; s < 3; ++s) { ls[s] = (s < nv) ? lsraw[s] : -1e30f; M = fmaxf(M, ls[s]); }
            float wown = __builtin_amdgcn_exp2f(lse_own - M), ws_[3], W = wown;
#pragma unroll
            for (int s = 0; s < 3; ++s) { ws_[s] = __builtin_amdgcn_exp2f(ls[s] - M); W += ws_[s]; }
            const float rW = __builtin_amdgcn_rcpf(W);
            if (hi == 0) wsf[32 + r32] = wown * rW * __builtin_amdgcn_rcpf(l_reg); LDS_WAIT();
#pragma unroll
            for (int r = 0; r < 16; ++r) { const int orow = crow(r, hi); const float cf = wsf[32 + orow];
                *(LAS bf16*)(stg + orow * STG_ROW + r32 * 2) = (bf16)(pk2(o[0][r] * cf, 0.f) & 0xffffu); *(LAS bf16*)(stg + orow * STG_ROW + 64 + r32 * 2) = (bf16)(pk2(o[1][r] * cf, 0.f) & 0xffffu); }
            LDS_WAIT();
            float acc[32];
            { const LAS v4u* src = (const LAS v4u*)(stg + r32 * STG_ROW + hi * 64);
#pragma unroll
              for (int i = 0; i < 4; ++i) { const v4u w = src[i]; acc[8 * i] = bflo(w.x); acc[8 * i + 1] = bfhi(w.x); acc[8 * i + 2] = bflo(w.y); acc[8 * i + 3] = bfhi(w.y); acc[8 * i + 4] = bflo(w.z); acc[8 * i + 5] = bfhi(w.z); acc[8 * i + 6] = bflo(w.w); acc[8 * i + 7] = bfhi(w.w); } }
#pragma unroll
            for (int s = 0; s < 3; ++s) if (s < nv) { const float cs = ws_[s] * rW * (1.0f / A8_SCALE); const v4u* src = (const v4u*)(PO8 + (pi + s) * 64) + hi * 2;
#pragma unroll
                for (int i = 0; i < 2; ++i) { const v4u w = src[i]; const unsigned ww[4] = {w.x, w.y, w.z, w.w};
#pragma unroll
                    for (int q = 0; q < 4; ++q) { const f32x2_ lo = __builtin_amdgcn_cvt_pk_f32_fp8((int)ww[q], false), hi2 = __builtin_amdgcn_cvt_pk_f32_fp8((int)ww[q], true);
                        acc[16 * i + 4 * q] += cs * lo.x; acc[16 * i + 4 * q + 1] += cs * lo.y; acc[16 * i + 4 * q + 2] += cs * hi2.x; acc[16 * i + 4 * q + 3] += cs * hi2.y; } }
                asm volatile("" ::: "memory"); }
            { v4u* dst = (v4u*)(F.ws + WS_ATT + (rowb + row) * ATTW + h * HD) + hi * 2;
#pragma unroll
              for (int i = 0; i < 2; ++i) { v4u w; const float* a = acc + 16 * i;
                  w.x = pk4_fp8(a[0] * A8_SCALE, a[1] * A8_SCALE, a[2] * A8_SCALE, a[3] * A8_SCALE); w.y = pk4_fp8(a[4] * A8_SCALE, a[5] * A8_SCALE, a[6] * A8_SCALE, a[7] * A8_SCALE);
                  w.z = pk4_fp8(a[8] * A8_SCALE, a[9] * A8_SCALE, a[10] * A8_SCALE, a[11] * A8_SCALE); w.w = pk4_fp8(a[12] * A8_SCALE, a[13] * A8_SCALE, a[14] * A8_SCALE, a[15] * A8_SCALE); dst[i] = w; } }
            LDS_WAIT();
#pragma unroll
            for (int d0 = 0; d0 < 4; ++d0) qr[d0] = *(const bf16x8*)(Qn + d0 * 16);
        } else {
            const bool valid = ((cur - nown) * 32 + r32) < count;
            const bool adj = __any((row >> 8) == n + 1);
            if (adj) { const int ib = 64 + row - n * 256 - 4 * hi;
                tile_pair<true, true, false>(L, 0, qr, 0.f, ib, m_reg, l_reg, o, wsf, r32, hi, vb0, Qn); tile_pair<true, false, true>(L, 2, qr, 0.f, ib - 128, m_reg, l_reg, o, wsf, r32, hi, vb0, Qn); }
            else { tile_pair<false, true, false>(L, 0, qr, b31, 0, m_reg, l_reg, o, wsf, r32, hi, vb0, Qn); tile_pair<false, false, true>(L, 2, qr, b31, 0, m_reg, l_reg, o, wsf, r32, hi, vb0, Qn); }
            if (hi == 0) wsf[32 + r32] = l_reg; LDS_WAIT();
#pragma unroll
            for (int r = 0; r < 16; ++r) { const int orow = crow(r, hi); const float rl = __builtin_amdgcn_rcpf(wsf[32 + orow]);
                *(LAS bf16*)(stg + orow * STG_ROW + r32 * 2) = (bf16)(pk2(o[0][r] * rl, 0.f) & 0xffffu); *(LAS bf16*)(stg + orow * STG_ROW + 64 + r32 * 2) = (bf16)(pk2(o[1][r] * rl, 0.f) & 0xffffu); }
            LDS_WAIT();
            if (valid) {
                const int slot = __builtin_popcount(msk & ((1u << n) - 1u));
                const size_t pi = ((rowb + row) * NH + h) * 3 + slot;
                v4u* dst = (v4u*)(PO8 + pi * 64) + hi * 2; const LAS v4u* src = (const LAS v4u*)(stg + r32 * STG_ROW + hi * 64);
#pragma unroll
                for (int i = 0; i < 2; ++i) { const v4u a = src[2 * i], c = src[2 * i + 1]; v4u w;
                    w.x = pk4_fp8(bflo(a.x) * A8_SCALE, bfhi(a.x) * A8_SCALE, bflo(a.y) * A8_SCALE, bfhi(a.y) * A8_SCALE); w.y = pk4_fp8(bflo(a.z) * A8_SCALE, bfhi(a.z) * A8_SCALE, bflo(a.w) * A8_SCALE, bfhi(a.w) * A8_SCALE);
                    w.z = pk4_fp8(bflo(c.x) * A8_SCALE, bfhi(c.x) * A8_SCALE, bflo(c.y) * A8_SCALE, bfhi(c.y) * A8_SCALE); w.w = pk4_fp8(bflo(c.z) * A8_SCALE, bfhi(c.z) * A8_SCALE, bflo(c.w) * A8_SCALE, bfhi(c.w) * A8_SCALE); dst[i] = w; }
                if (hi == 0) PL[pi] = m_reg + __builtin_amdgcn_logf(l_reg);
            }
            LDS_WAIT();
        }
        cur = nxt; row = rown;
    }
#undef PULL
#undef ITEM_ROW
    asm volatile("" ::: "memory"); __builtin_amdgcn_sched_barrier(0);
    moba_preload(F, b, h, n + 1 < 16 ? n + 1 : 15, sub, P);
}
#undef SBAR
}

namespace ssm {
constexpr int LW = 0, LX = 65536, XSTR = 136, LT = 100352, LT2 = RING_BYTES + 2048;
static_assert(LX + 128 * XSTR * 2 <= LT && LT + 30 * 1024 <= RING_BYTES && LT2 >= TILEE_OFF && LT2 + 2048 <= LDS_BYTES, "SSM LDS map");
__device__ __forceinline__ float gelu_tanh(float x) {
    const float a = 0.7978845608028654f * (x + 0.044715f * x * x * x);
    const float e = __builtin_amdgcn_exp2f(2.0f * LOG2E * a);
    const float th = 1.0f - 2.0f * __builtin_amdgcn_rcpf(1.0f + e);
    return 0.5f * x * (1.0f + th);
}
__device__ __forceinline__ void ssm_unit(Frame& F, int b, int g) {
    const int lane = F.lane, w = F.wave, m = lane & 15, kq = lane >> 4;
    LAS unsigned char* L = F.lds;
    const bf16* Ug = (const bf16*)(F.ws + WS_U); unsigned char* Zg = F.ws + WS_Z;
    const unsigned char* gb = F.ws + WS_SSMTAB + (size_t)g * SSM_GRP_BYTES;
    const bf16x8* Wf = (const bf16x8*)(gb + SSM_W_OFF) + lane; const bf16x8* Sf = (const bf16x8*)(gb + SSM_S_OFF) + lane;
    const size_t rowb = (size_t)b * SEQ;
    bf16x8 A[16];
    { const bf16* up = Ug + (rowb + (size_t)(16 * w + m) * 32 + (kq >> 1)) * SSMW + g * 16 + 8 * (kq & 1);
#pragma unroll
      for (int ks = 0; ks < 16; ++ks) A[ks] = *(const bf16x8*)(up + (size_t)(2 * ks) * SSMW); }
    LAS float* Wl = (LAS float*)(L + LW);
    bf16x8 Bq[16], Bn[16];
#pragma unroll
    for (int ks = 0; ks < 16; ++ks) Bq[ks] = Wf[(ks * 8) * 64];
#define SSM_S1(BC, BN, nt_) do { const int ntn_ = (nt_) + 1 < 8 ? (nt_) + 1 : 7; \
        _Pragma("unroll") for (int ks = 0; ks < 16; ++ks) BN[ks] = Wf[(ks * 8 + ntn_) * 64]; \
        __builtin_amdgcn_sched_barrier(0); \
        pg8::f32x4 acc = {0.f, 0.f, 0.f, 0.f}, ac1 = acc, ac2 = acc, ac3 = acc;     \
        _Pragma("unroll") for (int ks = 0; ks < 16; ks += 4) { acc = __builtin_amdgcn_mfma_f32_16x16x32_bf16(A[ks], BC[ks], acc, 0, 0, 0); ac1 = __builtin_amdgcn_mfma_f32_16x16x32_bf16(A[ks + 1], BC[ks + 1], ac1, 0, 0, 0); \
            ac2 = __builtin_amdgcn_mfma_f32_16x16x32_bf16(A[ks + 2], BC[ks + 2], ac2, 0, 0, 0); ac3 = __builtin_amdgcn_mfma_f32_16x16x32_bf16(A[ks + 3], BC[ks + 3], ac3, 0, 0, 0); } \
        acc = (acc + ac1) + (ac2 + ac3); \
        _Pragma("unroll") for (int r = 0; r < 4; ++r) Wl[(16 * w + 4 * kq + r) * 128 + 16 * (nt_) + m] = acc[r]; } while (0)
#pragma unroll 1
    for (int nt = 0; nt < 8; nt += 2) { SSM_S1(Bq, Bn, nt); SSM_S1(Bn, Bq, nt + 1); }
#undef SSM_S1
    __syncthreads();
    bf16x8 tst[4];
#pragma unroll
    for (int i = 0; i < 4; ++i) tst[i] = *((const bf16x8*)(gb + SSM_T_OFF) + F.tid + 512 * i);
    LAS bf16* Xl = (LAS bf16*)(L + LX);
    if (F.tid < 64) {
        const int p = F.tid; const float* aL = (const float*)(F.ws + WS_SSMAL) + (g * 64 + p) * 2; const float ar = aL[0], ai = aL[1];
        float xr = 0.f, xi = 0.f;
#pragma unroll 8
        for (int c = 0; c < SSM_NCH; ++c) {
            Xl[c * XSTR + p] = (bf16)(pk2(xr, 0.f) & 0xffffu); Xl[c * XSTR + 64 + p] = (bf16)(pk2(xi, 0.f) & 0xffffu);
            const float wr_ = Wl[c * 128 + p], wi_ = Wl[c * 128 + 64 + p];
            const float nr = ar * xr - ai * xi + wr_, ni = ar * xi + ai * xr + wi_; xr = nr; xi = ni;
        }
    }
    bf16x8 Bs[4];
#pragma unroll
    for (int ks = 0; ks < 4; ++ks) Bs[ks] = Sf[(ks * 32) * 64];
#pragma unroll
    for (int i = 0; i < 4; ++i) { const int p = F.tid + 512 * i, e = p >> 6; *(LAS bf16x8*)(L + (e < 30 ? LT + e * 1024 : LT2 + (e - 30) * 1024) + (p & 63) * 16) = tst[i]; }
    __syncthreads();
    bf16x8 Xf[4];
#pragma unroll
    for (int ks = 0; ks < 4; ++ks) Xf[ks] = *(const LAS bf16x8*)(Xl + (16 * w + m) * XSTR + 32 * ks + 8 * kq);
#pragma unroll 1
    for (int par = 0; par < 2; ++par) {
        const bf16x8 zf = {0, 0, 0, 0, 0, 0, 0, 0};
        bf16x8 R[17], Bs1[4];
#pragma unroll
        for (int k = 0; k < 17; ++k) R[k] = zf;
#pragma unroll 1
        for (int tt0 = 0; tt0 < 16; tt0 += 2) {
#pragma unroll
            for (int k = 14; k >= 0; --k) { R[k + 2] = R[k]; asm volatile("" : "+v"(R[k + 2])); }
#pragma unroll
            for (int j4 = 0; j4 < 2; ++j4) { const int e = par + 2 * (tt0 + j4); R[1 - j4] = *(const LAS bf16x8*)(L + (e < 30 ? LT + e * 1024 : LT2 + (e - 30) * 1024) + lane * 16); }
#define SSM_STEP(j4, SC, SN) do { const int tt = tt0 + (j4), t = 2 * tt + par; \
                pg8::f32x4 acc = {0.f, 0.f, 0.f, 0.f}, ac1 = acc, ac2 = acc, ac3 = acc;     \
                { const int tn = tt + 1 < 16 ? t + 2 : (par == 0 ? 1 : 31);     \
                  _Pragma("unroll") for (int ks = 0; ks < 4; ++ks) SN[ks] = Sf[(ks * 32 + tn) * 64]; } \
                __builtin_amdgcn_sched_barrier(0); \
                acc = __builtin_amdgcn_mfma_f32_16x16x32_bf16(Xf[0], SC[0], acc, 0, 0, 0); ac1 = __builtin_amdgcn_mfma_f32_16x16x32_bf16(Xf[1], SC[1], ac1, 0, 0, 0); \
                ac2 = __builtin_amdgcn_mfma_f32_16x16x32_bf16(Xf[2], SC[2], ac2, 0, 0, 0); ac3 = __builtin_amdgcn_mfma_f32_16x16x32_bf16(Xf[3], SC[3], ac3, 0, 0, 0); \
                _Pragma("unroll") for (int ks = 0; ks < 16; ks += 4) if (ks <= tt) { \
                    acc = __builtin_amdgcn_mfma_f32_16x16x32_bf16(A[ks], R[ks + 1 - (j4)], acc, 0, 0, 0); \
                    if (ks + 1 <= tt) ac1 = __builtin_amdgcn_mfma_f32_16x16x32_bf16(A[ks + 1], R[ks + 2 - (j4)], ac1, 0, 0, 0); \
                    if (ks + 2 <= tt) ac2 = __builtin_amdgcn_mfma_f32_16x16x32_bf16(A[ks + 2], R[ks + 3 - (j4)], ac2, 0, 0, 0); \
                    if (ks + 3 <= tt) ac3 = __builtin_amdgcn_mfma_f32_16x16x32_bf16(A[ks + 3], R[ks + 4 - (j4)], ac3, 0, 0, 0); } \
                acc = (acc + ac1) + (ac2 + ac3); \
                _Pragma("unroll") for (int r = 0; r < 4; ++r) { const size_t tok = rowb + (size_t)(16 * w + 4 * kq + r) * 32 + t; const size_t o = tok * SSMW + g * 16 + m; \
                    Zg[o] = (unsigned char)(__builtin_amdgcn_cvt_pk_fp8_f32(clamp8(gelu_tanh(acc[r]) * A8_SCALE), 0.f, 0, false) & 0xff); } } while (0)
            SSM_STEP(0, Bs, Bs1); SSM_STEP(1, Bs1, Bs);
#undef SSM_STEP
        }
    }
    __syncthreads();
}
}

__device__ __forceinline__ void p3a_select_ssm(Frame& F) {
    const int bh = F.vcu >> 1;
    att::select_rows(F, bh >> 3, bh & 7, F.vcu & 1);
    ssm::ssm_unit(F, F.vcu >> 4, F.vcu & 15);
}
__device__ __forceinline__ void p3b_moba(Frame& F) {
    const int bh = F.vcu >> 1, sub = F.vcu & 1;
    { LAS float* btab = (LAS float*)(F.lds + att::LBT); const float* bt = (const float*)(F.ws + WS_BTAB) + (bh & 7) * 576; for (int i = F.tid; i < 576; i += 512) btab[i] = bt[i]; }
    att::MobaPre P; att::moba_preload(F, bh >> 3, bh & 7, 0, sub, P);
#pragma unroll 1
    for (int n = 0; n < 16; ++n) att::moba_unit(F, bh >> 3, bh & 7, n, sub, P);
}

__device__ __forceinline__ void p7_rows(Frame& F) {
    const int gw = F.vcu * NWAVES + F.wave; const int row0 = gw * 32, b = row0 >> 12;
    const float* mod = (const float*)(F.ws + WS_MOD) + b * 6144;
    f32x4 A1[4], A2[4], A3[4];
#pragma unroll
    for (int j = 0; j < 4; ++j) { const int c = 4 * F.lane + 256 * j;
        A1[j] = *(const f32x4*)(mod + 2048 + c) * *(const f32x4*)(F.in[I_GPOSTMIX] + c);
        A2[j] = *(const f32x4*)(F.in[I_GPREFFN] + c) * (*(const f32x4*)(mod + 4096 + c) + 1.0f);
        A3[j] = *(const f32x4*)(mod + 3072 + c); }
    const bf16* YM = (const bf16*)(F.ws + WS_YMIX); const float* ssq = (const float*)(F.ws + WS_SSQ);
    f32x4 nx[4]; unsigned ny[4]; float nq;
    { const f32x4* xr = (const f32x4*)(F.in[I_X] + (size_t)row0 * 1024) + F.lane; const unsigned* yr = (const unsigned*)((const unsigned char*)YM + (size_t)row0 * 2048) + F.lane;
#pragma unroll
      for (int j = 0; j < 4; ++j) { nx[j] = __builtin_nontemporal_load(xr + 64 * j); ny[j] = yr[64 * j]; }
      nq = ssq[(size_t)row0 * 16 + (F.lane & 15)]; }
    for (int r = 0; r < 32; ++r) {
        const size_t row = (size_t)(row0 + r);
        f32x4 xv[4]; unsigned yv[4]; float q = nq;
#pragma unroll
        for (int j = 0; j < 4; ++j) { xv[j] = nx[j]; yv[j] = ny[j]; }
        { const size_t rn = row + (r < 31 ? 1 : 0);
          const f32x4* xr = (const f32x4*)(F.in[I_X] + rn * 1024) + F.lane; const unsigned* yr = (const unsigned*)((const unsigned char*)YM + rn * 2048) + F.lane;
#pragma unroll
          for (int j = 0; j < 4; ++j) { nx[j] = __builtin_nontemporal_load(xr + 64 * j); ny[j] = yr[64 * j]; }
          nq = ssq[rn * 16 + (F.lane & 15)]; }
        q += __shfl_xor(q, 1); q += __shfl_xor(q, 2); q += __shfl_xor(q, 4); q += __shfl_xor(q, 8);
        const float rstd1 = rsqrtf(q * (1.0f / 1024.0f) + RMS_EPS) * 0.125f;
        v2u* xo = (v2u*)(row < (size_t)X1_SPLIT ? F.ws + WS_X1A + row * 2048 : F.ws + WS_X1B + (row - X1_SPLIT) * 2048) + F.lane;
        f32x4 v[4]; float s = 0.f;
#pragma unroll
        for (int j = 0; j < 4; ++j) { const pg8::f32x2_ ylo = __builtin_amdgcn_cvt_pk_f32_fp8((int)yv[j], false), yhi = __builtin_amdgcn_cvt_pk_f32_fp8((int)yv[j], true); const f32x4 y = {ylo.x, ylo.y, yhi.x, yhi.y};
            v[j] = xv[j] + A1[j] * (y * rstd1); { v2u xw; xw.x = pk2(v[j].x, v[j].y); xw.y = pk2(v[j].z, v[j].w); xo[64 * j] = xw; }
            s += (v[j].x * v[j].x + v[j].y * v[j].y) + (v[j].z * v[j].z + v[j].w * v[j].w); }
        const float rstd2 = rsqrtf(wave_sum(s) * (1.0f / 1024.0f) + RMS_EPS);
        unsigned* o8 = (unsigned*)(F.ws + WS_H2F8 + row * 1024) + F.lane;
        if (F.lane == 0) ((LAS float*)(F.lds + 122880))[F.wave * 32 + r] = rstd2;
#pragma unroll
        for (int j = 0; j < 4; ++j) { const f32x4 hs = (v[j] * rstd2 * A2[j] + A3[j]) * A8_SCALE; o8[64 * j] = pk4_fp8(hs.x, hs.y, hs.z, hs.w); }
    }
}

__device__ __forceinline__ void p8_router(Frame& F) {
    LAS unsigned char* L = F.lds;
    const int b = (F.vcu * 256) >> 12;
    LAS float* cb = (LAS float*)(L + 123904);
    { const v4u* src = (const v4u*)(F.ws + WS_ROUTW + (size_t)b * 98304); LAS v4u* dst = (LAS v4u*)L; for (int i = F.tid; i < 6144; i += 512) dst[i] = src[i];
      if (F.tid < 48) cb[F.tid] = ((const float*)(F.ws + WS_ROUTC))[b * 48 + F.tid]; }
    __syncthreads();
    const int lane = F.lane, m = lane & 15, kq = lane >> 4;
    LAS float* lg = (LAS float*)(L + 98304 + F.wave * 3072);
    const LAS float* rs2 = (const LAS float*)(L + 122880) + F.wave * 32;
    int* list = (int*)(F.ws + WS_LIST); float* wgt = (float*)(F.ws + WS_WGT);
    const int gw = F.vcu * NWAVES + F.wave;
    for (int tile = gw * 2; tile < gw * 2 + 2; ++tile) {
        const size_t arow = (size_t)(tile * 16 + m);
        const bf16* ap = (const bf16*)(arow < (size_t)X1_SPLIT ? F.ws + WS_X1A + arow * 2048 : F.ws + WS_X1B + (arow - X1_SPLIT) * 2048) + 8 * kq;
        pg8::f32x4 a0 = {0.f, 0.f, 0.f, 0.f}, a1 = a0, a2 = a0;
#pragma unroll 8
        for (int ks = 0; ks < 32; ++ks) { const bf16x8 av = *(const bf16x8*)(ap + 32 * ks);
            const LAS bf16x8* bp = (const LAS bf16x8*)L + (ks * 3) * 64 + lane;
            a0 = __builtin_amdgcn_mfma_f32_16x16x32_bf16(av, bp[0], a0, 0, 0, 0);
            a1 = __builtin_amdgcn_mfma_f32_16x16x32_bf16(av, bp[64], a1, 0, 0, 0);
            a2 = __builtin_amdgcn_mfma_f32_16x16x32_bf16(av, bp[128], a2, 0, 0, 0); }
#pragma unroll
        for (int r = 0; r < 4; ++r) { lg[(4 * kq + r) * 48 + m] = a0[r]; lg[(4 * kq + r) * 48 + 16 + m] = a1[r]; lg[(4 * kq + r) * 48 + 32 + m] = a2[r]; }
        LDS_WAIT(); asm volatile("" ::: "memory");
        if (lane < 16) {
            const LAS float* q = lg + lane * 48; const int tok = tile * 16 + lane; const float r2 = rs2[(tile & 1) * 16 + lane];
            float gl[4]; int gi = 0; float gm;
#pragma unroll
            for (int i = 0; i < 4; ++i) gl[i] = q[i] * r2 + cb[i];
            gm = gl[0];
#pragma unroll
            for (int i = 1; i < 4; ++i) if (gl[i] > gm) { gm = gl[i]; gi = i; }
            float gs = 0.f;
#pragma unroll
            for (int i = 0; i < 4; ++i) gs += __expf(gl[i] - gm);
            const float gp = 1.0f / gs;
            float e1 = -3.0e38f, e2 = -3.0e38f; int i1 = 0, i2 = 0;
#pragma unroll
            for (int i = 0; i < 8; ++i) { const float v = q[4 + gi * 8 + i] * r2 + cb[4 + gi * 8 + i];
                if (v > e1) { e2 = e1; i2 = i1; e1 = v; i1 = i; } else if (v > e2) { e2 = v; i2 = i; } }
            const float t = __expf(e2 - e1), w1 = gp / (1.0f + t), w2 = gp * t / (1.0f + t);
            const int x1 = gi * 8 + i1, x2 = gi * 8 + i2;
            const int p1 = (int)__hip_atomic_fetch_add(F.ctl + CW_CNT + 64 * x1, 1u, RLX_AGENT);
            const int p2 = (int)__hip_atomic_fetch_add(F.ctl + CW_CNT + 64 * x2, 1u, RLX_AGENT);
            list[(size_t)x1 * NTOK + p1] = tok * 2; list[(size_t)x2 * NTOK + p2] = tok * 2 + 1;
            wgt[tok * 2] = w1; wgt[tok * 2 + 1] = w2;
        }
        LDS_WAIT(); asm volatile("" ::: "memory");
    }
}

__device__ __forceinline__ int moe_layout(Frame& F) {
    LAS int* te = (LAS int*)(F.lds + TILEE_OFF);
    if (F.tid < 64) {
        const int e = F.tid; int c = 0;
        if (e < NEXP) c = (int)__hip_atomic_load(F.ctl + CW_CNT + 64 * e, RLX_AGENT);
        const int nt = (c + MOEB - 1) / MOEB; int incl = nt;
#pragma unroll
        for (int d = 1; d < 32; d <<= 1) { const int v = __shfl_up(incl, d); if (e >= d) incl += v; }
        const int start = incl - nt;
        if (e < NEXP) { te[600 + e] = start * MOEB; te[640 + e] = c; for (int t = 0; t < nt; ++t) te[start + t] = e; }
        if (e == NEXP - 1) te[600 + NEXP] = incl * MOEB;
    }
    __syncthreads();
    return te[600 + NEXP] / MOEB;
}

__device__ __forceinline__ void moe_rowmap(Frame& F, int ntiles) {
    LAS int* te = (LAS int*)(F.lds + TILEE_OFF);
    const int nrows = ntiles * MOEB;
    const int* list = (const int*)(F.ws + WS_LIST); const float* wgt = (const float*)(F.ws + WS_WGT); int* rowmap = (int*)(F.ws + WS_ROWMAP); float* rw = (float*)(F.ws + WS_RW);
    for (int r = F.vcu * 512 + F.tid; r < nrows; r += F.G * 512) {
        const int e = te[r >> 8]; const int i = r - te[600 + e];
        if (i < te[640 + e]) { const int tk = list[(size_t)e * NTOK + i]; rowmap[tk] = r; rw[r] = wgt[tk]; } else rw[r] = 0.f;
    }
}

__device__ __forceinline__ void p12_combine(Frame& F) {
    const int gw = F.vcu * NWAVES + F.wave; const int row0 = gw * 32, b = row0 >> 12;
    const float* mod = (const float*)(F.ws + WS_MOD) + b * 6144;
    f32x4 A1[4];
#pragma unroll
    for (int j = 0; j < 4; ++j) { const int c = 4 * F.lane + 256 * j; A1[j] = *(const f32x4*)(mod + 5120 + c) * *(const f32x4*)(F.in[I_GPOSTFFN] + c); }
    const unsigned char* YR = F.ws + WS_XS; const int* rowmap = (const int*)(F.ws + WS_ROWMAP);
    typedef float f32x2_ __attribute__((ext_vector_type(2)));
    const int myrm = rowmap[(size_t)row0 * 2 + F.lane];
    unsigned na[4], nc[4]; v2u nxw[4];
#define CMB_LOAD(r_) do { const int r0_ = __shfl(myrm, 2 * (r_)), r1_ = __shfl(myrm, 2 * (r_) + 1); const size_t rw_ = (size_t)(row0 + (r_)); \
        const unsigned* y0_ = (const unsigned*)(YR + (size_t)r0_ * 1024) + F.lane; const unsigned* y1_ = (const unsigned*)(YR + (size_t)r1_ * 1024) + F.lane; \
        const v2u* xi_ = (const v2u*)(rw_ < (size_t)X1_SPLIT ? F.ws + WS_X1A + rw_ * 2048 : F.ws + WS_X1B + (rw_ - X1_SPLIT) * 2048) + F.lane; \
        _Pragma("unroll") for (int j = 0; j < 4; ++j) { na[j] = y0_[64 * j]; nc[j] = y1_[64 * j]; nxw[j] = xi_[64 * j]; } } while (0)
    CMB_LOAD(0);
    for (int r = 0; r < 32; ++r) {
        const size_t row = (size_t)(row0 + r);
        unsigned ca[4], cc[4]; v2u cx[4];
#pragma unroll
        for (int j = 0; j < 4; ++j) { ca[j] = na[j]; cc[j] = nc[j]; cx[j] = nxw[j]; }
        { const int rn = r < 31 ? r + 1 : r; CMB_LOAD(rn); }
        f32x4 f[4]; float s = 0.f;
#pragma unroll
        for (int j = 0; j < 4; ++j) { const int a = (int)ca[j], c = (int)cc[j];
            const f32x2_ al = __builtin_amdgcn_cvt_pk_f32_fp8(a, false), ah = __builtin_amdgcn_cvt_pk_f32_fp8(a, true), cl = __builtin_amdgcn_cvt_pk_f32_fp8(c, false), ch = __builtin_amdgcn_cvt_pk_f32_fp8(c, true);
            f[j] = (f32x4){al.x + cl.x, al.y + cl.y, ah.x + ch.x, ah.y + ch.y} * (1.0f / 256.0f);
            s += (f[j].x * f[j].x + f[j].y * f[j].y) + (f[j].z * f[j].z + f[j].w * f[j].w); }
        const float rstd = rsqrtf(wave_sum(s) * (1.0f / 1024.0f) + RMS_EPS);
        f32x4* xo = (f32x4*)(F.out + row * 1024) + F.lane;
#pragma unroll
        for (int j = 0; j < 4; ++j) { const v2u xw = cx[j]; const f32x4 x1 = {bflo(xw.x), bfhi(xw.x), bflo(xw.y), bfhi(xw.y)}; xo[64 * j] = x1 + A1[j] * (f[j] * rstd); }
    }
#undef CMB_LOAD
}

struct Args { const float* in[29]; float* out; unsigned char* ws; int ph_lo, ph_hi; };
#if defined(SPLIT5)
constexpr int N_PHASES = 10;
#else
constexpr int N_PHASES = 9;
#endif
#ifndef MK_N_LAUNCHES
#define MK_N_LAUNCHES 1
#endif

__global__ void __launch_bounds__(NWAVES * 64, 2) layer_fwd(Args args) {
    extern __shared__ __attribute__((aligned(16))) unsigned char lds[];
    Frame F;
    F.lds = (LAS unsigned char*)lds; F.MISC = (volatile LAS unsigned*)(F.lds + MISC_OFF);
    F.tid = threadIdx.x; F.lane = F.tid & 63; F.wave = __builtin_amdgcn_readfirstlane(F.tid >> 6);
    F.G = gridDim.x; { const int bx = blockIdx.x; F.vcu = (F.G % 8 == 0) ? (bx % 8) * (F.G / 8) + bx / 8 : bx; }
    F.ws = args.ws; F.ctl = (gu32*)(args.ws + WS_CTL); F.out = args.out;
#pragma unroll
    for (int i = 0; i < 29; ++i) F.in[i] = args.in[i];
    for (int u = F.tid; u < (LDS_BYTES - LDSCTL_OFF) / 4; u += NWAVES * 64) ((LAS unsigned*)(F.lds + LDSCTL_OFF))[u] = 0u;
    __syncthreads();
    XcdBarrier bar; bar.bar = (unsigned*)(F.ctl + CW_BAR); bar.x = 0; bar.st = nullptr;
    if (MK_N_LAUNCHES == 1) bar = xcd_barrier_post((unsigned*)(F.ctl + CW_BAR), F.MISC + 8);
    const int lo = args.ph_lo, hi = args.ph_hi;
#ifndef ONLYP
#define ONLYP -1
#endif
#define IN(k) ((ONLYP < 0 || ONLYP == (k)) && lo <= (k) && (k) < hi)
#define SEAM(k) do { if (IN(k) && IN((k) + 1)) xcd_barrier(bar); } while (0)
#define REFRESH() do { int t_ = threadIdx.x; asm volatile("" : "+v"(t_)); F.tid = t_; F.lane = t_ & 63; F.wave = __builtin_amdgcn_readfirstlane(t_ >> 6); } while (0)
    bf16* const RA = (bf16*)(F.ws + WS_RA); bf16* const RB = (bf16*)(F.ws + WS_RB);

    if (IN(0)) { REFRESH(); p0_mod(F); } SEAM(0);
    if (IN(1)) { REFRESH(); p1_xn(F); p0_tables(F); p0_weights(F, 0, WI_EXPERT); } SEAM(1);
    if (IN(2)) { REFRESH();
        pg8::Gemm g{RA, (const bf16*)(F.ws + WS_WIN), NTOK, NPROJ, DM / 2}; pg8::StaticOrder S; S.init(NTOK, NPROJ, F.G, (int)blockIdx.x);
        pg8::EpiProj E{(bf16*)(F.ws + WS_Q), (bf16*)(F.ws + WS_K), (bf16*)(F.ws + WS_V), (bf16*)(F.ws + WS_U), (bf16*)(F.ws + WS_GA), (bf16*)(F.ws + WS_GS), (float*)(F.ws + WS_KPART)};
        pg8::gemm_phase<pg8::EpiProj, pg8::StaticOrder, true, true, true>(F.lds, g, S, E, A8_E8, W8_E8);
    } SEAM(2);
    if (IN(3)) { REFRESH(); p3a_select_ssm(F); } SEAM(3);
    if (IN(4)) { REFRESH(); p3b_moba(F); } SEAM(4);
    if (IN(5)) { REFRESH();
        const int pm = F.vcu;
        if ((pm & 1) == 0) { p0_weights(F, WI_EXPERT, WI_END); VM_WAIT(); __syncthreads(); REFRESH(); }
        { pg8::Gemm g{(const bf16*)(F.ws + WS_Z), (const bf16*)(F.ws + WS_WGLU), NTOK, 2048, SSMW / 2}; pg8::PanelOrder S{pm, 8, pm & 7};
          pg8::EpiGlu E{(const bf16*)(F.ws + WS_GS), RA};
          pg8::gemm_phase<pg8::EpiGlu, pg8::PanelOrder, true, true, true>(F.lds, g, S, E, A8_E8, W8_E8); }
        VM_WAIT(); __syncthreads();
        { pg8::Gemm g{(const bf16*)(F.ws + WS_ATT), (const bf16*)(F.ws + WS_WO), NTOK, DM, ATTW / 2}; pg8::PanelOrder S{pm, 4, pm & 3};
          pg8::EpiAttOut E{F.ws + WS_GA, F.ws + WS_GS, RA, (unsigned char*)RB};
          pg8::gemm_phase<pg8::EpiAttOut, pg8::PanelOrder, true, true, true>(F.lds, g, S, E, A8_E8, W8_E8); }
        VM_WAIT(); __syncthreads();
        { pg8::Gemm g{RB, (const bf16*)(F.ws + WS_WMIX), NTOK, DM, DM / 2}; pg8::PanelOrder S{pm, 4, pm & 3};
          pg8::EpiMix E{(bf16*)(F.ws + WS_YMIX), (float*)(F.ws + WS_SSQ)};
          pg8::gemm_phase<pg8::EpiMix, pg8::PanelOrder, true, true, true>(F.lds, g, S, E, A8_E8, W8_E8); }
        VM_WAIT(); __syncthreads();
        REFRESH(); p7_rows(F);
        VM_WAIT(); __syncthreads();
#if !defined(SPLIT5)
        REFRESH(); p8_router(F);
        if ((F.vcu & 1) != 0) { REFRESH(); p0_weights(F, WI_EXPERT, WI_END); }
    } SEAM(5);
#else
        if ((F.vcu & 1) != 0) { REFRESH(); p0_weights(F, WI_EXPERT, WI_END); }
    } SEAM(5);
    if (IN(9)) { REFRESH(); p8_router(F); } if (IN(9) && IN(6)) xcd_barrier(bar);
#endif
    if (IN(6)) { REFRESH();
        const int ntiles = moe_layout(F);
        moe_rowmap(F, ntiles);
        pg8::Gemm g{(const bf16*)(F.ws + WS_H2F8), (const bf16*)(F.ws + WS_WGU), ntiles * MOEB, DM, DM / 2};
        pg8::MoeOrder S{(const LAS int*)(F.lds + TILEE_OFF), (const int*)(F.ws + WS_LIST), ntiles, F.G, F.vcu};
        pg8::EpiMoe1 E{(unsigned char*)RA};
        pg8::gemm_phase_g<pg8::EpiMoe1, pg8::MoeOrder, true>(F.lds, g, S, E, A8_E8, W8_E8);
    } SEAM(6);
    if (IN(7)) { REFRESH();
        const int ntiles = moe_layout(F);
        pg8::Gemm g{RA, (const bf16*)(F.ws + WS_WDN), ntiles * MOEB, DM, DEXP / 2};
        pg8::MoeOrder S{(const LAS int*)(F.lds + TILEE_OFF), (const int*)(F.ws + WS_LIST), ntiles, F.G, F.vcu};
        pg8::EpiMoe2 E{F.ws + WS_XS, (const float*)(F.ws + WS_RW)};
        pg8::gemm_phase<pg8::EpiMoe2, pg8::MoeOrder, true, true, true>(F.lds, g, S, E, 124, W8_E8);
    } SEAM(7);
    if (IN(8)) { REFRESH(); p12_combine(F); }
#undef IN
#undef SEAM
}

extern "C" void kernel_launch(void* const* d_in, const int* in_sizes, int n_in, void* d_out, int out_size, void* d_ws, size_t ws_size, hipStream_t stream) {
    static int grid = 0;
    if (grid == 0) {
        if (n_in != 29 || in_sizes[0] != NTOK * DM || out_size != NTOK * DM || ws_size < WS_END) {
            fprintf(stderr, "kernel_launch: unexpected problem (n_in %d, in0 %d, out %d, ws %zu); nothing launched\n", n_in, n_in > 0 ? in_sizes[0] : -1, out_size, ws_size); grid = -1; return; }
        int dev = 0, cus = 0, per_cu = 0;
        if (hipGetDevice(&dev) != hipSuccess || hipDeviceGetAttribute(&cus, hipDeviceAttributeMultiprocessorCount, dev) != hipSuccess) { grid = -1; return; }
        if (hipFuncSetAttribute((const void*)layer_fwd, hipFuncAttributeMaxDynamicSharedMemorySize, LDS_BYTES) != hipSuccess) { fprintf(stderr, "kernel_launch: hipFuncSetAttribute failed\n"); grid = -1; return; }
        if (hipOccupancyMaxActiveBlocksPerMultiprocessor(&per_cu, (const void*)layer_fwd, NWAVES * 64, LDS_BYTES) != hipSuccess || per_cu < 1) fprintf(stderr, "kernel_launch: occupancy query says %d\n", per_cu);
        (void)hipGetLastError();
        grid = cus;
        if (grid != 256) { fprintf(stderr, "kernel_launch: this kernel is built for a 256-CU device (got %d)\n", grid); grid = -1; return; }
    }
    if (grid < 0) return;
    (void)hipMemsetAsync((char*)d_ws + WS_CTL, 0, CTL_ZERO_BYTES, stream);
    Args a{};
    for (int i = 0; i < 29; ++i) a.in[i] = (const float*)d_in[i];
    a.out = (float*)d_out; a.ws = (unsigned char*)d_ws;
#if MK_N_LAUNCHES == 1
    void* kargs[] = {&a};
#if defined(PROBE_A)
    a.ph_lo = 0; a.ph_hi = PROBE_A;
    (void)hipLaunchCooperativeKernel((const void*)layer_fwd, dim3(grid), dim3(NWAVES * 64), kargs, LDS_BYTES, stream);
    (void)hipMemsetAsync((char*)d_ws + WS_CTL + CW_BAR * 4, 0, XCD_BAR_WORDS * 4, stream);
    a.ph_lo = PROBE_B; a.ph_hi = N_PHASES;
    (void)hipLaunchCooperativeKernel((const void*)layer_fwd, dim3(grid), dim3(NWAVES * 64), kargs, LDS_BYTES, stream);
#else
    a.ph_lo = 0; a.ph_hi = N_PHASES;
    hipError_t e = hipLaunchCooperativeKernel((const void*)layer_fwd, dim3(grid), dim3(NWAVES * 64), kargs, LDS_BYTES, stream);
    if (e != hipSuccess) fprintf(stderr, "kernel_launch: cooperative launch failed: %s\n", hipGetErrorString(e));
#endif
#else
    for (int p = 0; p < N_PHASES; ++p) { a.ph_lo = p; a.ph_hi = p + 1; hipLaunchKernelGGL(layer_fwd, dim3(grid), dim3(NWAVES * 64), LDS_BYTES, stream, a); }
#endif
}
```

```cpp
#include <hip/hip_runtime.h>
#include <cstdio>
#include <cstdint>
#include <cmath>
namespace pg8 {
#define PG8_LAS __attribute__((address_space(3)))
typedef unsigned short bf16_t;
typedef short bf16x8 __attribute__((ext_vector_type(8)));
typedef float f32x4 __attribute__((ext_vector_type(4)));
typedef unsigned u32x4 __attribute__((ext_vector_type(4)));
typedef int i32x4 __attribute__((ext_vector_type(4)));
typedef int i32x8 __attribute__((ext_vector_type(8)));
constexpr int BM = 256, BK = 64, HALF = 128, HTB = HALF * BK * 2  , STAGE_BYTES = 8 * HTB, NXCD = 8, WGM = 8;

__host__ __device__ __forceinline__ int lds_byte(int r, int c) { const int st = (r >> 4) * 2 + (c >> 5), rr = r & 15, cc = c & 31, ob = rr * 64 + cc * 2; return st * 1024 + (ob ^ (((ob >> 9) & 1) << 5)); }
__host__ __device__ __forceinline__ void stage_rc(int b, int& R, int& C) { const int st = b / 1024, sb = b % 1024, swz = sb ^ (((sb >> 9) & 1) << 5); R = (st >> 1) * 16 + swz / 64; C = (st & 1) * 32 + (swz % 64) / 2; }
__host__ __device__ __forceinline__ int perm32(int rho) { const int n = rho >> 4, i = rho & 15; return 8 * (i >> 2) + 4 * n + (i & 3); }

struct Unit { int pm, pn; };
struct Gemm { const bf16_t* A; const bf16_t* Bt; int M, N, K; };

struct StaticOrder {
    int nM, nN, nwg, G, c;
    __host__ __device__ void init(int M, int N, int G_, int c_) { nM = M / BM; nN = N / BM; nwg = nM * nN; G = G_; c = c_; }
    __host__ __device__ bool next(int i, Unit& u) const {
        const long L = (long)i * G + c; if (L >= nwg) return false;
        int wgid = (int)L; { const int q = nwg / NXCD, r = nwg % NXCD, xcd = wgid % NXCD, off = wgid / NXCD; wgid = (xcd < r ? xcd * (q + 1) : r * (q + 1) + (xcd - r) * q) + off; }
        const int nig = WGM * nN, gid = wgid / nig, fm = gid * WGM, gsz = (nM - fm) < WGM ? (nM - fm) : WGM;
        u.pm = fm + ((wgid % nig) % gsz); u.pn = (wgid % nig) / gsz; return true;
    }
    __device__ __forceinline__ void a_ready(const Unit&) const {}
    __device__ __forceinline__ void done(const Unit&) const {}
};

__device__ __forceinline__ unsigned cvt_pk_bf16(float lo, float hi) { unsigned r; asm volatile("v_cvt_pk_bf16_f32 %0, %1, %2" : "=v"(r) : "v"(lo), "v"(hi)); return r; }
typedef unsigned u32x2 __attribute__((ext_vector_type(2)));
__device__ __forceinline__ float bf_lo(unsigned w) { return __uint_as_float(w << 16); }
__device__ __forceinline__ float bf_hi(unsigned w) { return __uint_as_float(w & 0xffff0000u); }
__device__ __forceinline__ float sigmoidf_(float x) { return __builtin_amdgcn_rcpf(1.0f + __builtin_amdgcn_exp2f(-1.4426950408889634f * x)); }

typedef float f32x2_ __attribute__((ext_vector_type(2)));
__device__ __forceinline__ unsigned sig_u8x4(const f32x4 v) {
    const f32x2_ ya = (f32x2_){v[0], v[1]} * -1.4426950408889634f, yb = (f32x2_){v[2], v[3]} * -1.4426950408889634f;
    const f32x2_ da = (f32x2_){__builtin_amdgcn_exp2f(ya.x), __builtin_amdgcn_exp2f(ya.y)} + 1.0f, db = (f32x2_){__builtin_amdgcn_exp2f(yb.x), __builtin_amdgcn_exp2f(yb.y)} + 1.0f;
    const f32x2_ qa = (f32x2_){__builtin_amdgcn_rcpf(da.x), __builtin_amdgcn_rcpf(da.y)} * 255.0f + 8388608.0f, qb = (f32x2_){__builtin_amdgcn_rcpf(db.x), __builtin_amdgcn_rcpf(db.y)} * 255.0f + 8388608.0f;
    unsigned t01, t23, w;
    asm("v_perm_b32 %0, %1, %2, %3" : "=v"(t01) : "v"(qa.y), "v"(qa.x), "s"(0x0c0c0400u));
    asm("v_perm_b32 %0, %1, %2, %3" : "=v"(t23) : "v"(qb.y), "v"(qb.x), "s"(0x0c0c0400u));
    asm("v_perm_b32 %0, %1, %2, %3" : "=v"(w) : "v"(t23), "v"(t01), "s"(0x05040100u));
    return w;
}
__device__ __forceinline__ f32x2_ vsig2(const f32x2_ v, const f32x2_ g) {
    const f32x2_ y = g * -1.4426950408889634f;
    const f32x2_ d = (f32x2_){__builtin_amdgcn_exp2f(y.x), __builtin_amdgcn_exp2f(y.y)} + 1.0f;
    return v * (f32x2_){__builtin_amdgcn_rcpf(d.x), __builtin_amdgcn_rcpf(d.y)};
}
constexpr float QSCALE = 0.125f * 1.4426950408889634f;

struct EpiProj {
    static constexpr bool PERM = true, AFTER_DRAIN = false;
    bf16_t *Q, *K, *V, *U, *GA, *GS; float* kpart;
    __device__ __forceinline__ void operator()(const f32x4 (&acc)[2][2][4][2], const Unit& u, int wr, int wc, int fr, int fq) const {
        const int pn = u.pn; const int row0 = u.pm * BM + wr * 64 + fr;
        bf16_t* base; int ld, colt, mode;
        if (pn < 2) { base = Q; ld = 512; colt = pn * 256; mode = 1; }
        else if (pn < 4) { base = K; ld = 512; colt = (pn - 2) * 256; mode = 0; }
        else if (pn < 6) { base = V; ld = 512; colt = (pn - 4) * 256; mode = 0; }
        else if (pn == 6) { base = U; ld = 256; colt = 0; mode = 0; }
        else if (pn < 11) { base = GA; ld = 1024; colt = (pn - 7) * 256; mode = 2; }
        else { base = GS; ld = 1024; colt = (pn - 11) * 256; mode = 2; }
        const int col0 = colt + wc * 32 + 8 * fq;
#pragma unroll
        for (int ai = 0; ai < 2; ++ai)
#pragma unroll
            for (int m = 0; m < 4; ++m) { bf16_t* rowp = base + (size_t)(row0 + ai * HALF + m * 16) * ld + col0;
#pragma unroll
                for (int bj = 0; bj < 2; ++bj) { f32x4 v0 = acc[ai][bj][m][0], v1 = acc[ai][bj][m][1];
                    if (mode == 2) {
                        u32x2 w; w.x = sig_u8x4(v0); w.y = sig_u8x4(v1);
                        *(u32x2*)((unsigned char*)base + (size_t)(row0 + ai * HALF + m * 16) * 1024 + col0 + bj * HALF) = w;
                    } else {
                        if (mode == 1) { v0 = v0 * QSCALE; v1 = v1 * QSCALE; }
                        u32x4 w; w.x = cvt_pk_bf16(v0[0], v0[1]); w.y = cvt_pk_bf16(v0[2], v0[3]); w.z = cvt_pk_bf16(v1[0], v1[1]); w.w = cvt_pk_bf16(v1[2], v1[3]);
                        *(u32x4*)(rowp + bj * HALF) = w; } } }
        if (pn == 2 || pn == 3) {
#pragma unroll
            for (int bj = 0; bj < 2; ++bj)
#pragma unroll
                for (int n = 0; n < 2; ++n) { f32x4 s = (f32x4){0.f, 0.f, 0.f, 0.f};
#pragma unroll
                    for (int ai = 0; ai < 2; ++ai)
#pragma unroll
                        for (int m = 0; m < 4; ++m) s += acc[ai][bj][m][n];
#pragma unroll
                    for (int i = 0; i < 4; ++i) { float t = s[i]; t += __shfl_xor(t, 1); t += __shfl_xor(t, 2); t += __shfl_xor(t, 4); t += __shfl_xor(t, 8); s[i] = t; }
                    if (fr == 0) *(f32x4*)(kpart + (size_t)(u.pm * 2 + wr) * 512 + (pn - 2) * 256 + bj * HALF + wc * 32 + 8 * fq + 4 * n) = s; }
        }
    }
};

struct EpiGlu {
    static constexpr bool PERM = true, AFTER_DRAIN = false;
    const bf16_t* GS; bf16_t* SG;
    __device__ __forceinline__ void operator()(const f32x4 (&acc)[2][2][4][2], const Unit& u, int wr, int wc, int fr, int fq) const {
        const int row0 = u.pm * BM + wr * 64 + fr; const int col0 = u.pn * 128 + wc * 32 + 8 * fq;
#pragma unroll
        for (int ai = 0; ai < 2; ++ai)
#pragma unroll
            for (int m = 0; m < 4; ++m) { const size_t ro = (size_t)(row0 + ai * HALF + m * 16) * 1024 + col0;
                const f32x4 v0 = acc[ai][0][m][0], v1 = acc[ai][0][m][1], g0 = acc[ai][1][m][0], g1 = acc[ai][1][m][1];
                u32x2 w;
                { const f32x2_ a = vsig2((f32x2_){v0[0], v0[1]}, (f32x2_){g0[0], g0[1]}) * 16.0f, b = vsig2((f32x2_){v0[2], v0[3]}, (f32x2_){g0[2], g0[3]}) * 16.0f;
                  const f32x2_ c = vsig2((f32x2_){v1[0], v1[1]}, (f32x2_){g1[0], g1[1]}) * 16.0f, d = vsig2((f32x2_){v1[2], v1[3]}, (f32x2_){g1[2], g1[3]}) * 16.0f;
                  int t = __builtin_amdgcn_cvt_pk_fp8_f32(__builtin_amdgcn_fmed3f(a.x, -440.f, 440.f), __builtin_amdgcn_fmed3f(a.y, -440.f, 440.f), 0, false);
                  t = __builtin_amdgcn_cvt_pk_fp8_f32(__builtin_amdgcn_fmed3f(b.x, -440.f, 440.f), __builtin_amdgcn_fmed3f(b.y, -440.f, 440.f), t, true); w.x = (unsigned)t;
                  t = __builtin_amdgcn_cvt_pk_fp8_f32(__builtin_amdgcn_fmed3f(c.x, -440.f, 440.f), __builtin_amdgcn_fmed3f(c.y, -440.f, 440.f), 0, false);
                  t = __builtin_amdgcn_cvt_pk_fp8_f32(__builtin_amdgcn_fmed3f(d.x, -440.f, 440.f), __builtin_amdgcn_fmed3f(d.y, -440.f, 440.f), t, true); w.y = (unsigned)t; }
                *(u32x2*)((unsigned char*)SG + ro + (size_t)(row0 + ai * HALF + m * 16) * 1024) = w;
                asm volatile("" ::: "memory"); }
    }
};

struct EpiAttOut {
    static constexpr bool PERM = true, AFTER_DRAIN = false;
    const unsigned char* GA; const unsigned char* GS; const bf16_t* SG; unsigned char* MG;
    __device__ __forceinline__ void operator()(const f32x4 (&acc)[2][2][4][2], const Unit& u, int wr, int wc, int fr, int fq) const {
        const int row0 = u.pm * BM + wr * 64 + fr; const int col0 = u.pn * BM + wc * 32 + 8 * fq;
        u32x2 nga[2], ngs[2]; u32x2 nsg[2];
#define EAO_LOAD(idx) do { const size_t ro_ = (size_t)(row0 + ((idx) >> 2) * HALF + ((idx) & 3) * 16) * 1024 + col0; \
        _Pragma("unroll") for (int bj = 0; bj < 2; ++bj) { nga[bj] = *(const u32x2*)(GA + ro_ + bj * HALF); nsg[bj] = *(const u32x2*)((const unsigned char*)SG + 2 * ro_ - col0 + bj * HALF); ngs[bj] = *(const u32x2*)(GS + ro_ + bj * HALF); } } while (0)
#define U8F(w, i) ((float)(((w) >> (8 * (i))) & 0xffu))
        EAO_LOAD(0);
#pragma unroll
        for (int idx = 0; idx < 8; ++idx) { const int ai = idx >> 2, m = idx & 3; const size_t ro = (size_t)(row0 + ai * HALF + m * 16) * 1024 + col0;
            u32x2 cga[2], cgs[2]; u32x2 csg[2];
#pragma unroll
            for (int bj = 0; bj < 2; ++bj) { cga[bj] = nga[bj]; csg[bj] = nsg[bj]; cgs[bj] = ngs[bj]; }
            if (idx < 7) EAO_LOAD(idx + 1);
#pragma unroll
            for (int bj = 0; bj < 2; ++bj) { const f32x4 v0 = acc[ai][bj][m][0], v1 = acc[ai][bj][m][1]; const u32x2 ga = cga[bj], gs = cgs[bj]; const u32x2 sg = csg[bj];
                constexpr float C = 16.0f / 255.0f, CS = 1.0f / 255.0f;
                float o[8];
#define EAO_PAIR(i, gaw, gsw, b0, va, vb, sgw, hi_) do { const f32x2_ s_ = __builtin_amdgcn_cvt_pk_f32_fp8((int)(sgw), hi_); \
                    const f32x2_ r_ = (f32x2_){U8F(gaw, b0), U8F(gaw, b0 + 1)} * (f32x2_){va, vb} * C + (f32x2_){U8F(gsw, b0), U8F(gsw, b0 + 1)} * s_ * CS; \
                    o[i] = __builtin_amdgcn_fmed3f(r_.x, -440.f, 440.f); o[i + 1] = __builtin_amdgcn_fmed3f(r_.y, -440.f, 440.f); } while (0)
                EAO_PAIR(0, ga.x, gs.x, 0, v0[0], v0[1], sg.x, false); EAO_PAIR(2, ga.x, gs.x, 2, v0[2], v0[3], sg.x, true);
                EAO_PAIR(4, ga.y, gs.y, 0, v1[0], v1[1], sg.y, false); EAO_PAIR(6, ga.y, gs.y, 2, v1[2], v1[3], sg.y, true);
#undef EAO_PAIR
                u32x2 w; int t = __builtin_amdgcn_cvt_pk_fp8_f32(o[0], o[1], 0, false); t = __builtin_amdgcn_cvt_pk_fp8_f32(o[2], o[3], t, true); w.x = (unsigned)t;
                t = __builtin_amdgcn_cvt_pk_fp8_f32(o[4], o[5], 0, false); t = __builtin_amdgcn_cvt_pk_fp8_f32(o[6], o[7], t, true); w.y = (unsigned)t;
                *(u32x2*)(MG + ro + bj * HALF) = w; }
            asm volatile("" ::: "memory"); }
#undef U8F
#undef EAO_LOAD
    }
};

struct EpiMix {
    static constexpr bool PERM = true, AFTER_DRAIN = false;
    bf16_t* Y; float* ssq;
    __device__ __forceinline__ void operator()(const f32x4 (&acc)[2][2][4][2], const Unit& u, int wr, int wc, int fr, int fq) const {
        const int row0 = u.pm * BM + wr * 64 + fr; const int col0 = u.pn * BM + wc * 32 + 8 * fq;
#pragma unroll
        for (int ai = 0; ai < 2; ++ai)
#pragma unroll
            for (int m = 0; m < 4; ++m) { const int row = row0 + ai * HALF + m * 16; const size_t ro = (size_t)row * 1024 + col0; float q = 0.f;
#pragma unroll
                for (int bj = 0; bj < 2; ++bj) { const f32x4 v0 = acc[ai][bj][m][0], v1 = acc[ai][bj][m][1];
                    q += (v0[0] * v0[0] + v0[1] * v0[1]) + (v0[2] * v0[2] + v0[3] * v0[3]) + (v1[0] * v1[0] + v1[1] * v1[1]) + (v1[2] * v1[2] + v1[3] * v1[3]);
                    u32x2 w; int t = __builtin_amdgcn_cvt_pk_fp8_f32(__builtin_amdgcn_fmed3f(v0[0] * 8.0f, -440.f, 440.f), __builtin_amdgcn_fmed3f(v0[1] * 8.0f, -440.f, 440.f), 0, false);
                    t = __builtin_amdgcn_cvt_pk_fp8_f32(__builtin_amdgcn_fmed3f(v0[2] * 8.0f, -440.f, 440.f), __builtin_amdgcn_fmed3f(v0[3] * 8.0f, -440.f, 440.f), t, true); w.x = (unsigned)t;
                    t = __builtin_amdgcn_cvt_pk_fp8_f32(__builtin_amdgcn_fmed3f(v1[0] * 8.0f, -440.f, 440.f), __builtin_amdgcn_fmed3f(v1[1] * 8.0f, -440.f, 440.f), 0, false);
                    t = __builtin_amdgcn_cvt_pk_fp8_f32(__builtin_amdgcn_fmed3f(v1[2] * 8.0f, -440.f, 440.f), __builtin_amdgcn_fmed3f(v1[3] * 8.0f, -440.f, 440.f), t, true); w.y = (unsigned)t;
                    *(u32x2*)((unsigned char*)Y + (size_t)row * 2048 + col0 + bj * HALF) = w; }
                q += __shfl_xor(q, 16); q += __shfl_xor(q, 32);
                if (fq == 0) ssq[(size_t)row * 16 + u.pn * 4 + wc] = q; }
    }
};

constexpr float HID8_SCALE = 8.0f;
struct EpiMoe1 {
    static constexpr bool PERM = true, AFTER_DRAIN = false;
    unsigned char* HID;
    __device__ __forceinline__ void operator()(const f32x4 (&acc)[2][2][4][2], const Unit& u, int wr, int wc, int fr, int fq) const {
        const int row0 = u.pm * BM + wr * 64 + fr; const int col0 = (u.pn & 3) * 128 + wc * 32 + 8 * fq;
#pragma unroll
        for (int ai = 0; ai < 2; ++ai)
#pragma unroll
            for (int m = 0; m < 4; ++m) { const size_t ro = (size_t)(row0 + ai * HALF + m * 16) * 512 + col0;
                float h[8];
#pragma unroll
                for (int n = 0; n < 2; ++n) { const f32x4 g = acc[ai][0][m][n], v = acc[ai][1][m][n];
#pragma unroll
                    for (int i = 0; i < 4; i += 2) { const f32x2_ gg = {g[i], g[i + 1]}; const f32x2_ hh = vsig2(gg, gg) * ((f32x2_){v[i], v[i + 1]} * HID8_SCALE);
                        h[4 * n + i] = __builtin_amdgcn_fmed3f(hh.x, -440.f, 440.f); h[4 * n + i + 1] = __builtin_amdgcn_fmed3f(hh.y, -440.f, 440.f); } }
                u32x2 w; int t = __builtin_amdgcn_cvt_pk_fp8_f32(h[0], h[1], 0, false); t = __builtin_amdgcn_cvt_pk_fp8_f32(h[2], h[3], t, true); w.x = (unsigned)t;
                t = __builtin_amdgcn_cvt_pk_fp8_f32(h[4], h[5], 0, false); t = __builtin_amdgcn_cvt_pk_fp8_f32(h[6], h[7], t, true); w.y = (unsigned)t;
                *(u32x2*)(HID + ro) = w; }
    }
};

constexpr float YR8_SCALE = 32.0f;
struct EpiMoe2 {
    static constexpr bool PERM = true, AFTER_DRAIN = false;
    unsigned char* YR; const float* rw;
    __device__ __forceinline__ void operator()(const f32x4 (&acc)[2][2][4][2], const Unit& u, int wr, int wc, int fr, int fq) const {
        const int row0 = u.pm * BM + wr * 64 + fr; const int col0 = (u.pn & 3) * BM + wc * 32 + 8 * fq;
#pragma unroll
        for (int ai = 0; ai < 2; ++ai)
#pragma unroll
            for (int m = 0; m < 4; ++m) { const int row = row0 + ai * HALF + m * 16; const size_t ro = (size_t)row * 1024 + col0; const float s = YR8_SCALE;
#pragma unroll
                for (int bj = 0; bj < 2; ++bj) { f32x4 v0 = acc[ai][bj][m][0] * s, v1 = acc[ai][bj][m][1] * s;
#pragma unroll
                    for (int i = 0; i < 4; ++i) { v0[i] = fminf(fmaxf(v0[i], -440.f), 440.f); v1[i] = fminf(fmaxf(v1[i], -440.f), 440.f); }
                    u32x2 w; int t = __builtin_amdgcn_cvt_pk_fp8_f32(v0[0], v0[1], 0, false); t = __builtin_amdgcn_cvt_pk_fp8_f32(v0[2], v0[3], t, true); w.x = (unsigned)t;
                    t = __builtin_amdgcn_cvt_pk_fp8_f32(v1[0], v1[1], 0, false); t = __builtin_amdgcn_cvt_pk_fp8_f32(v1[2], v1[3], t, true); w.y = (unsigned)t;
                    *(u32x2*)(YR + ro + bj * HALF) = w; } }
    }
};

struct MoeOrder {
    const PG8_LAS int* tile_e; const int* list; int ntiles, G, c;
    __device__ __forceinline__ bool next(int i, Unit& u) const {
        const int L = i * G + c; if (L >= ntiles * 4) return false;
        const int t = L >> 2; u.pm = t; u.pn = tile_e[t] * 4 + (L & 3); return true;
    }
    __device__ __forceinline__ unsigned a_row(const Unit& u, int lr) const {
        const int e = u.pn >> 2, i = u.pm * 256 + lr - tile_e[600 + e];
        return (i < tile_e[640 + e]) ? (unsigned)(list[(size_t)e * 65536 + i] >> 1) : 0u;
    }
    __device__ __forceinline__ void a_ready(const Unit&) const {}
    __device__ __forceinline__ void done(const Unit&) const {}
};

struct PanelOrder {
    int pm, n, rot;
    __device__ __forceinline__ bool next(int i, Unit& u) const { if (i >= n) return false; int p = pm; asm volatile("" : "+s"(p));
        u.pm = p; u.pn = (i + rot) % n; return true; }
    __device__ __forceinline__ void a_ready(const Unit&) const {}
    __device__ __forceinline__ void done(const Unit&) const {}
};
template <class Epi, class Sched, bool ALIGN_EPI = false, bool SP2 = false, bool F8 = false>
__device__ __forceinline__ void gemm_phase(PG8_LAS unsigned char* lds, const Gemm g, const Sched& S, const Epi& E, int sclA = 127, int sclB = 127) {
    int tid_ = threadIdx.x; asm volatile("" : "+v"(tid_));
    const int tid = tid_, wid = __builtin_amdgcn_readfirstlane(tid >> 6), lane = tid & 63, wr = wid >> 2, wc = wid & 3, fr = lane & 15, fq = lane >> 4;
    const int K = g.K, nt = K / BK;
    unsigned voffA[2], voffB[2];
#pragma unroll
    for (int i = 0; i < 2; ++i) { int R, C; stage_rc(tid * 16 + i * 8192, R, C); const int Rb = Epi::PERM ? ((R & ~31) + perm32(R & 31)) : R;
        voffA[i] = (unsigned)(R * K + C) * 2u; voffB[i] = (unsigned)(Rb * K + C) * 2u; }
    const size_t kstep = (size_t)(BK * 2);
    const size_t hstep = (size_t)HALF * K * 2;
    const size_t tstep = 2 * hstep;
    const unsigned ldsw = (unsigned)wid * 1024u;
    const int aoff = lds_byte(wr * 64 + fr, fq * 8), boff = lds_byte(wc * 32 + fr, fq * 8);
#define PG8_SA(b, h) (((b) * 2 + (h)) * HTB)
#define PG8_SB(b, h) ((4 + (b) * 2 + (h)) * HTB)
#define PG8_STAGE(bufoff, gbase, voff) do { _Pragma("unroll") for (int _i = 0; _i < 2; ++_i) \
        __builtin_amdgcn_global_load_lds((const unsigned*)((const char*)(gbase) + (voff)[_i]), (PG8_LAS unsigned*)(lds + (bufoff) + ldsw + _i * 8192), 16, 0, 0); } while (0)
#define PG8_LDA(dst, b, h) do { _Pragma("unroll") for (int m = 0; m < 4; ++m) _Pragma("unroll") for (int k = 0; k < 2; ++k) dst[m][k] = *(const PG8_LAS bf16x8*)(lds + PG8_SA(b, h) + aoff + m * 2048 + k * 1024); } while (0)
#define PG8_LDB(dst, b, h) do { _Pragma("unroll") for (int n = 0; n < 2; ++n) _Pragma("unroll") for (int k = 0; k < 2; ++k) dst[n][k] = *(const PG8_LAS bf16x8*)(lds + PG8_SB(b, h) + boff + n * 2048 + k * 1024); } while (0)
#define PG8_MMA(ai, bj, At, Bt) do { __builtin_amdgcn_s_setprio(1); _Pragma("unroll") for (int m = 0; m < 4; ++m) _Pragma("unroll") for (int n = 0; n < 2; ++n) { \
        if constexpr (F8) { const i32x4 b0_ = __builtin_bit_cast(i32x4, Bt[n][0]), b1_ = __builtin_bit_cast(i32x4, Bt[n][1]), a0_ = __builtin_bit_cast(i32x4, At[m][0]), a1_ = __builtin_bit_cast(i32x4, At[m][1]); \
            const i32x8 b8_ = __builtin_shufflevector(b0_, b1_, 0, 1, 2, 3, 4, 5, 6, 7), a8_ = __builtin_shufflevector(a0_, a1_, 0, 1, 2, 3, 4, 5, 6, 7); \
            asm volatile("v_mfma_scale_f32_16x16x128_f8f6f4 %0, %1, %2, %0, %3, %4 op_sel_hi:[0,0,0]" : "+v"(acc[ai][bj][m][n]) : "v"(b8_), "v"(a8_), "v"(sclB), "v"(sclA)); } \
        else { _Pragma("unroll") for (int k = 0; k < 2; ++k) acc[ai][bj][m][n] = __builtin_amdgcn_mfma_f32_16x16x32_bf16(Bt[n][k], At[m][k], acc[ai][bj][m][n], 0, 0, 0); } } \
        __builtin_amdgcn_s_setprio(0); } while (0)
#define PG8_WAIT_V(n) asm volatile("s_waitcnt vmcnt(" #n ")" ::: "memory")
#define PG8_WAIT_L(n) asm volatile("s_waitcnt lgkmcnt(" #n ")" ::: "memory")
#define PG8_BAR __builtin_amdgcn_s_barrier()
#define PG8_SCHED __builtin_amdgcn_sched_barrier(0)
    Unit cur, nxt; int ui = 0;
    if (!S.next(0, cur)) return;
    f32x4 acc[2][2][4][2];
#pragma unroll
    for (int a = 0; a < 2; ++a)
#pragma unroll
        for (int b = 0; b < 2; ++b)
#pragma unroll
            for (int m = 0; m < 4; ++m)
#pragma unroll
                for (int n = 0; n < 2; ++n) acc[a][b][m][n] = (f32x4){0.f, 0.f, 0.f, 0.f};
    bf16x8 At[4][2], B0[2][2], B1[2][2];
    const char* cA = (const char*)g.A + (size_t)cur.pm * tstep; const char* cB = (const char*)g.Bt + (size_t)cur.pn * tstep;
    S.a_ready(cur);
    if constexpr (SP2) {
        PG8_STAGE(PG8_SB(0, 0), cB, voffB); PG8_STAGE(PG8_SB(0, 1), cB + hstep, voffB); PG8_STAGE(PG8_SA(0, 0), cA, voffA); PG8_STAGE(PG8_SA(0, 1), cA + hstep, voffA);
        if (wr == 1) PG8_BAR;
        PG8_WAIT_V(2); PG8_BAR;
        PG8_STAGE(PG8_SB(1, 0), cB + kstep, voffB); PG8_STAGE(PG8_SA(1, 0), cA + kstep, voffA); PG8_STAGE(PG8_SB(1, 1), cB + hstep + kstep, voffB);
        PG8_WAIT_V(6); PG8_BAR;
    } else {
        PG8_STAGE(PG8_SB(0, 0), cB, voffB); PG8_STAGE(PG8_SA(0, 0), cA, voffA); PG8_STAGE(PG8_SB(0, 1), cB + hstep, voffB); PG8_STAGE(PG8_SA(0, 1), cA + hstep, voffA);
        if (wr == 1) PG8_BAR;
        PG8_WAIT_V(4); PG8_BAR;
        PG8_STAGE(PG8_SB(1, 0), cB + kstep, voffB); PG8_STAGE(PG8_SA(1, 0), cA + kstep, voffA); PG8_STAGE(PG8_SB(1, 1), cB + hstep + kstep, voffB);
        PG8_WAIT_V(6); PG8_BAR;
    }
    for (;;) {
        const bool has_next = S.next(ui + 1, nxt);
        const char* nA = has_next ? (const char*)g.A + (size_t)nxt.pm * tstep : cA; const char* nB = has_next ? (const char*)g.Bt + (size_t)nxt.pn * tstep : cB;
        for (int t = 0; t < nt; t += 2) {
            const bool last = (t == nt - 2);
            const char* a1 = cA + (size_t)(t + 1) * kstep;
            const char* a2 = last ? nA : cA + (size_t)(t + 2) * kstep; const char* b2 = last ? nB : cB + (size_t)(t + 2) * kstep;
            const char* a3 = a2 + kstep; const char* b3 = b2 + kstep;
            if (last && has_next) S.a_ready(nxt);
            if constexpr (SP2) {
            PG8_LDB(B0, 0, 0); PG8_LDB(B1, 0, 1); PG8_SCHED; PG8_LDA(At, 0, 0); PG8_STAGE(PG8_SA(1, 1), a1 + hstep, voffA);
            PG8_WAIT_V(8); PG8_WAIT_L(0); PG8_BAR; PG8_MMA(0, 0, At, B0); PG8_MMA(0, 1, At, B1); PG8_BAR; PG8_SCHED;
            PG8_LDA(At, 0, 1); PG8_STAGE(PG8_SB(0, 0), b2, voffB); PG8_STAGE(PG8_SB(0, 1), b2 + hstep, voffB); PG8_STAGE(PG8_SA(0, 0), a2, voffA);
            PG8_WAIT_V(8); PG8_WAIT_L(0); PG8_BAR; PG8_MMA(1, 0, At, B0); PG8_MMA(1, 1, At, B1); PG8_BAR; PG8_SCHED;
            PG8_LDB(B0, 1, 0); PG8_LDB(B1, 1, 1); PG8_SCHED; PG8_LDA(At, 1, 0); PG8_STAGE(PG8_SA(0, 1), a2 + hstep, voffA);
            PG8_WAIT_V(8); PG8_WAIT_L(0); PG8_BAR; PG8_MMA(0, 0, At, B0); PG8_MMA(0, 1, At, B1); PG8_BAR; PG8_SCHED;
            PG8_LDA(At, 1, 1); PG8_STAGE(PG8_SB(1, 0), b3, voffB); PG8_STAGE(PG8_SB(1, 1), b3 + hstep, voffB); PG8_STAGE(PG8_SA(1, 0), a3, voffA);
            PG8_WAIT_V(8); PG8_WAIT_L(0); PG8_BAR; PG8_MMA(1, 0, At, B0); PG8_MMA(1, 1, At, B1); PG8_BAR; PG8_SCHED;
            } else {
            PG8_LDB(B0, 0, 0); PG8_SCHED; PG8_LDA(At, 0, 0); PG8_STAGE(PG8_SA(1, 1), a1 + hstep, voffA);
            PG8_WAIT_L(8); PG8_BAR; PG8_WAIT_L(0); PG8_MMA(0, 0, At, B0); PG8_BAR; PG8_SCHED;
            PG8_LDB(B1, 0, 1); PG8_STAGE(PG8_SB(0, 0), b2, voffB);
            PG8_BAR; PG8_WAIT_L(0); PG8_MMA(0, 1, At, B1); PG8_BAR;
            PG8_LDA(At, 0, 1); PG8_STAGE(PG8_SA(0, 0), a2, voffA);
            PG8_BAR; PG8_WAIT_L(0); PG8_MMA(1, 0, At, B0); PG8_BAR; PG8_SCHED;
            PG8_STAGE(PG8_SB(0, 1), b2 + hstep, voffB);
            PG8_WAIT_V(6); PG8_BAR; PG8_MMA(1, 1, At, B1); PG8_BAR;
            PG8_LDB(B0, 1, 0); PG8_SCHED; PG8_LDA(At, 1, 0); PG8_STAGE(PG8_SA(0, 1), a2 + hstep, voffA);
            PG8_WAIT_L(8); PG8_BAR; PG8_WAIT_L(0); PG8_MMA(0, 0, At, B0); PG8_BAR; PG8_SCHED;
            PG8_LDB(B1, 1, 1); PG8_STAGE(PG8_SB(1, 0), b3, voffB);
            PG8_BAR; PG8_WAIT_L(0); PG8_MMA(0, 1, At, B1); PG8_BAR;
            PG8_LDA(At, 1, 1); PG8_STAGE(PG8_SA(1, 0), a3, voffA);
            PG8_BAR; PG8_WAIT_L(0); PG8_MMA(1, 0, At, B0); PG8_BAR; PG8_SCHED;
            PG8_STAGE(PG8_SB(1, 1), b3 + hstep, voffB);
            PG8_WAIT_V(6); PG8_BAR; PG8_MMA(1, 1, At, B1); PG8_BAR;
            }
        }
        if constexpr (ALIGN_EPI) { if (wr == 0) PG8_BAR; }
        if constexpr (F8) asm volatile("s_nop 15\n\ts_nop 15" ::: "memory");
        if constexpr (!Epi::AFTER_DRAIN) { E(acc, cur, wr, wc, fr, fq); S.done(cur); }
        if (!has_next) break;
#pragma unroll
        for (int a = 0; a < 2; ++a)
#pragma unroll
            for (int b = 0; b < 2; ++b)
#pragma unroll
                for (int m = 0; m < 4; ++m)
#pragma unroll
                    for (int n = 0; n < 2; ++n) acc[a][b][m][n] = (f32x4){0.f, 0.f, 0.f, 0.f};
        cur = nxt; cA = nA; cB = nB; ++ui;
        if constexpr (ALIGN_EPI) { if (wr == 1) PG8_BAR; }
    }
    PG8_WAIT_V(0);
    if constexpr (!ALIGN_EPI) { if (wr == 0) PG8_BAR; }
    PG8_BAR;
    if constexpr (Epi::AFTER_DRAIN) { E.fused(acc, cur, wr, wc, fr, fq, lds, wid, lane); S.done(cur); }
#undef PG8_SA
#undef PG8_SB
#undef PG8_STAGE
#undef PG8_LDA
#undef PG8_LDB
#undef PG8_MMA
#undef PG8_WAIT_V
#undef PG8_WAIT_L
#undef PG8_BAR
#undef PG8_SCHED
}
template <class Epi, class Sched, bool F8 = false>
__device__ __forceinline__ void gemm_phase_g(PG8_LAS unsigned char* lds, const Gemm g, const Sched& S, const Epi& E, int sclA = 127, int sclB = 127) {
    int tid_ = threadIdx.x; asm volatile("" : "+v"(tid_));
    const int tid = tid_, wid = __builtin_amdgcn_readfirstlane(tid >> 6), lane = tid & 63, wr = wid >> 2, wc = wid & 3, fr = lane & 15, fq = lane >> 4;
    const int K = g.K, nt = K / BK;
    unsigned voffB[2]; int Rr[2], Cc[2];
#pragma unroll
    for (int i = 0; i < 2; ++i) { int R, C; stage_rc(tid * 16 + i * 8192, R, C); const int Rb = Epi::PERM ? ((R & ~31) + perm32(R & 31)) : R; Rr[i] = R; Cc[i] = C; voffB[i] = (unsigned)(Rb * K + C) * 2u; }
    const size_t kstep = (size_t)(BK * 2); const size_t hstep = (size_t)HALF * K * 2; const size_t tstep = 2 * hstep;
    const unsigned ldsw = (unsigned)wid * 1024u;
    const int aoff = lds_byte(wr * 64 + fr, fq * 8), boff = lds_byte(wc * 32 + fr, fq * 8);
#define PG8_SA(b, h) (((b) * 2 + (h)) * HTB)
#define PG8_SB(b, h) ((4 + (b) * 2 + (h)) * HTB)
#define PG8_STAGE(bufoff, gbase, voff) do { _Pragma("unroll") for (int _i = 0; _i < 2; ++_i) \
        __builtin_amdgcn_global_load_lds((const unsigned*)((const char*)(gbase) + (voff)[_i]), (PG8_LAS unsigned*)(lds + (bufoff) + ldsw + _i * 8192), 16, 0, 0); } while (0)
#define PG8_LDA(dst, b, h) do { _Pragma("unroll") for (int m = 0; m < 4; ++m) _Pragma("unroll") for (int k = 0; k < 2; ++k) dst[m][k] = *(const PG8_LAS bf16x8*)(lds + PG8_SA(b, h) + aoff + m * 2048 + k * 1024); } while (0)
#define PG8_LDB(dst, b, h) do { _Pragma("unroll") for (int n = 0; n < 2; ++n) _Pragma("unroll") for (int k = 0; k < 2; ++k) dst[n][k] = *(const PG8_LAS bf16x8*)(lds + PG8_SB(b, h) + boff + n * 2048 + k * 1024); } while (0)
#define PG8_MMA(ai, bj, At, Bt) do { __builtin_amdgcn_s_setprio(1); _Pragma("unroll") for (int m = 0; m < 4; ++m) _Pragma("unroll") for (int n = 0; n < 2; ++n) { \
        if constexpr (F8) { const i32x4 b0_ = __builtin_bit_cast(i32x4, Bt[n][0]), b1_ = __builtin_bit_cast(i32x4, Bt[n][1]), a0_ = __builtin_bit_cast(i32x4, At[m][0]), a1_ = __builtin_bit_cast(i32x4, At[m][1]); \
            const i32x8 b8_ = __builtin_shufflevector(b0_, b1_, 0, 1, 2, 3, 4, 5, 6, 7), a8_ = __builtin_shufflevector(a0_, a1_, 0, 1, 2, 3, 4, 5, 6, 7); \
            asm volatile("v_mfma_scale_f32_16x16x128_f8f6f4 %0, %1, %2, %0, %3, %4 op_sel_hi:[0,0,0]" : "+v"(acc[ai][bj][m][n]) : "v"(b8_), "v"(a8_), "v"(sclB), "v"(sclA)); } \
        else { _Pragma("unroll") for (int k = 0; k < 2; ++k) acc[ai][bj][m][n] = __builtin_amdgcn_mfma_f32_16x16x32_bf16(Bt[n][k], At[m][k], acc[ai][bj][m][n], 0, 0, 0); } } \
        __builtin_amdgcn_s_setprio(0); } while (0)
#define PG8_WAIT_V(n) asm volatile("s_waitcnt vmcnt(" #n ")" ::: "memory")
#define PG8_WAIT_L(n) asm volatile("s_waitcnt lgkmcnt(" #n ")" ::: "memory")
#define PG8_BAR __builtin_amdgcn_s_barrier()
#define PG8_SCHED __builtin_amdgcn_sched_barrier(0)
#define PG8_ROWS(dst, u) do { _Pragma("unroll") for (int _h = 0; _h < 2; ++_h) _Pragma("unroll") for (int _i = 0; _i < 2; ++_i) dst[_h][_i] = S.a_row(u, _h * HALF + Rr[_i]) * (unsigned)(K * 2) + (unsigned)(Cc[_i] * 2); } while (0)
    Unit cur, nxt; int ui = 0;
    if (!S.next(0, cur)) return;
    f32x4 acc[2][2][4][2];
#pragma unroll
    for (int a = 0; a < 2; ++a)
#pragma unroll
        for (int b = 0; b < 2; ++b)
#pragma unroll
            for (int m = 0; m < 4; ++m)
#pragma unroll
                for (int n = 0; n < 2; ++n) acc[a][b][m][n] = (f32x4){0.f, 0.f, 0.f, 0.f};
    bf16x8 At[4][2], B0[2][2], B1[2][2];
    unsigned gC[2][2], gN[2][2];
    PG8_ROWS(gC, cur);
    const char* const A0 = (const char*)g.A;
    const char* cB = (const char*)g.Bt + (size_t)cur.pn * tstep;
    PG8_STAGE(PG8_SB(0, 0), cB, voffB); PG8_STAGE(PG8_SB(0, 1), cB + hstep, voffB); PG8_STAGE(PG8_SA(0, 0), A0, gC[0]); PG8_STAGE(PG8_SA(0, 1), A0, gC[1]);
    if (wr == 1) PG8_BAR;
    PG8_WAIT_V(2); PG8_BAR;
    PG8_STAGE(PG8_SB(1, 0), cB + kstep, voffB); PG8_STAGE(PG8_SA(1, 0), A0 + kstep, gC[0]); PG8_STAGE(PG8_SB(1, 1), cB + hstep + kstep, voffB);
    PG8_WAIT_V(6); PG8_BAR;
    for (;;) {
        const bool has_next = S.next(ui + 1, nxt);
        const char* nB = has_next ? (const char*)g.Bt + (size_t)nxt.pn * tstep : cB;
        if (has_next) { PG8_ROWS(gN, nxt); } else {
#pragma unroll
            for (int _h = 0; _h < 2; ++_h)
#pragma unroll
                for (int _i = 0; _i < 2; ++_i) gN[_h][_i] = gC[_h][_i]; }
        for (int t = 0; t < nt; t += 2) {
            const bool last = (t == nt - 2);
            const char* a1 = A0 + (size_t)(t + 1) * kstep;
            const char* a2 = last ? A0 : A0 + (size_t)(t + 2) * kstep; const char* b2 = last ? nB : cB + (size_t)(t + 2) * kstep;
            const char* a3 = a2 + kstep; const char* b3 = b2 + kstep;
            unsigned gX[2][2];
#pragma unroll
            for (int _h = 0; _h < 2; ++_h)
#pragma unroll
                for (int _i = 0; _i < 2; ++_i) gX[_h][_i] = last ? gN[_h][_i] : gC[_h][_i];
            PG8_LDB(B0, 0, 0); PG8_LDB(B1, 0, 1); PG8_SCHED; PG8_LDA(At, 0, 0); PG8_STAGE(PG8_SA(1, 1), a1, gC[1]);
            PG8_WAIT_V(8); PG8_WAIT_L(0); PG8_BAR; PG8_MMA(0, 0, At, B0); PG8_MMA(0, 1, At, B1); PG8_BAR; PG8_SCHED;
            PG8_LDA(At, 0, 1); PG8_STAGE(PG8_SB(0, 0), b2, voffB); PG8_STAGE(PG8_SB(0, 1), b2 + hstep, voffB); PG8_STAGE(PG8_SA(0, 0), a2, gX[0]);
            PG8_WAIT_V(8); PG8_WAIT_L(0); PG8_BAR; PG8_MMA(1, 0, At, B0); PG8_MMA(1, 1, At, B1); PG8_BAR; PG8_SCHED;
            PG8_LDB(B0, 1, 0); PG8_LDB(B1, 1, 1); PG8_SCHED; PG8_LDA(At, 1, 0); PG8_STAGE(PG8_SA(0, 1), a2, gX[1]);
            PG8_WAIT_V(8); PG8_WAIT_L(0); PG8_BAR; PG8_MMA(0, 0, At, B0); PG8_MMA(0, 1, At, B1); PG8_BAR; PG8_SCHED;
            PG8_LDA(At, 1, 1); PG8_STAGE(PG8_SB(1, 0), b3, voffB); PG8_STAGE(PG8_SB(1, 1), b3 + hstep, voffB); PG8_STAGE(PG8_SA(1, 0), a3, gX[0]);
            PG8_WAIT_V(8); PG8_WAIT_L(0); PG8_BAR; PG8_MMA(1, 0, At, B0); PG8_MMA(1, 1, At, B1); PG8_BAR; PG8_SCHED;
        }
        if (wr == 0) PG8_BAR;
        if constexpr (F8) asm volatile("s_nop 15\n\ts_nop 15" ::: "memory");
        E(acc, cur, wr, wc, fr, fq); S.done(cur);
        if (!has_next) break;
#pragma unroll
        for (int a = 0; a < 2; ++a)
#pragma unroll
            for (int b = 0; b < 2; ++b)
#pragma unroll
                for (int m = 0; m < 4; ++m)
#pragma unroll
                    for (int n = 0; n < 2; ++n) acc[a][b][m][n] = (f32x4){0.f, 0.f, 0.f, 0.f};
        cur = nxt; cB = nB; ++ui;
#pragma unroll
        for (int _h = 0; _h < 2; ++_h)
#pragma unroll
            for (int _i = 0; _i < 2; ++_i) gC[_h][_i] = gN[_h][_i];
        if (wr == 1) PG8_BAR;
    }
    PG8_WAIT_V(0);
    PG8_BAR;
#undef PG8_SA
#undef PG8_SB
#undef PG8_STAGE
#undef PG8_LDA
#undef PG8_LDB
#undef PG8_MMA
#undef PG8_WAIT_V
#undef PG8_WAIT_L
#undef PG8_BAR
#undef PG8_SCHED
#undef PG8_ROWS
}
}

constexpr int NWAVES = 8;
constexpr int BATCH = 16, SEQ = 4096, DM = 1024, NTOK = BATCH * SEQ;
constexpr int NH = 8, HD = 64, ATTW = 512, SSMW = 256, NPROJ = 3840;
constexpr int NEXP = 32, DEXP = 512, MOEB = 256;
constexpr int NROWS_PAD = NTOK * 2 + NEXP * MOEB;
constexpr int MAXTILES = NROWS_PAD / MOEB;
constexpr float RMS_EPS = 1e-6f;
constexpr float LOG2E = 1.4426950408889634f;
constexpr float W8_SCALE = 256.0f, A8_SCALE = 16.0f;
constexpr int W8_E8 = 119, A8_E8 = 123;
constexpr int SSM_L = 32, SSM_NCH = SEQ / SSM_L;

constexpr size_t MiB = 1u << 20;
constexpr size_t WS_CTL = 0, CTL_ZERO_BYTES = 1 * MiB;
constexpr size_t WS_MOD = 1 * MiB;
constexpr size_t WS_BTAB = WS_MOD + 512 * 1024;
constexpr size_t WS_KPART = 2 * MiB;
constexpr size_t WS_SSMTAB = 3 * MiB;
constexpr size_t SSM_GRP_BYTES = 294912, SSM_T_OFF = 0, SSM_W_OFF = 32768, SSM_S_OFF = 163840;
constexpr size_t WS_SSMAL = WS_SSMTAB + 16 * SSM_GRP_BYTES;
constexpr size_t WS_ROUTW = 1009 * MiB;
constexpr size_t WS_ROUTC = 1011 * MiB;
constexpr size_t WS_WIN = 9 * MiB;
constexpr size_t WS_WO = 17 * MiB;
constexpr size_t WS_WGLU = 18 * MiB;
constexpr size_t WS_WMIX = 19 * MiB;
constexpr size_t WS_WGU = 21 * MiB;
constexpr size_t WS_WDN = 85 * MiB;
constexpr size_t WS_RA = 120 * MiB;
constexpr size_t WS_RB = 256 * MiB;
constexpr size_t WS_Q = WS_RB, WS_K = WS_RB + 64 * MiB;
constexpr size_t WS_V = 384 * MiB, WS_U = 448 * MiB, WS_GA = 480 * MiB, WS_GS = 608 * MiB, WS_ATT = 736 * MiB, WS_Z = 800 * MiB;
constexpr size_t WS_H2F8 = 320 * MiB;
constexpr size_t WS_XS = 480 * MiB;
constexpr size_t WS_LIST = 832 * MiB;
constexpr size_t WS_WGT = 840 * MiB;
constexpr size_t WS_ROWMAP = 841 * MiB;
constexpr size_t WS_RW = 842 * MiB;
constexpr size_t WS_SSQ = 844 * MiB;
constexpr size_t WS_SEL = 848 * MiB;
constexpr size_t WS_PL = 850 * MiB;
constexpr size_t WS_RLIST = 860 * MiB;
constexpr size_t WS_RCNT = 876 * MiB;
constexpr size_t WS_YMIX = WS_RA;
constexpr size_t WS_H2 = 880 * MiB;
constexpr size_t WS_X1A = 384 * MiB, WS_X1B = 768 * MiB; constexpr int X1_SPLIT = 49152;
constexpr size_t WS_END = 1012 * MiB;
static_assert(WS_SSMAL + 16 * 64 * 2 * 4 <= WS_ROUTW && WS_WIN + (size_t)NPROJ * DM * 2 <= WS_WO && WS_WDN + (size_t)NEXP * DM * DEXP * 2 <= WS_RA, "ws map 1");
static_assert(WS_RA + (size_t)NROWS_PAD * DEXP * 2 <= WS_RB && WS_XS + (size_t)NROWS_PAD * DM * 2 <= WS_LIST && WS_Z + (size_t)NTOK * SSMW * 2 <= WS_LIST, "ws map 2");
constexpr int CW_BAR = 4096;
constexpr int CW_CNT = 16384;

constexpr int RING_BYTES = 131072;
constexpr int LDSCTL_OFF = RING_BYTES, MISC_OFF = LDSCTL_OFF + 320;
constexpr int TILEE_OFF = RING_BYTES + 1024;
constexpr int LDS_BYTES = 147456;
static_assert(TILEE_OFF + 4 * 1024 <= LDS_BYTES, "LDS map");

#define GAS __attribute__((address_space(1)))
#define LAS __attribute__((address_space(3)))
typedef unsigned short bf16;
typedef unsigned v4u __attribute__((ext_vector_type(4)));
typedef unsigned v2u __attribute__((ext_vector_type(2)));
typedef float f32x4 __attribute__((ext_vector_type(4)));
typedef float f32x16 __attribute__((ext_vector_type(16)));
typedef short bf16x8 __attribute__((ext_vector_type(8)));
typedef short s16x4 __attribute__((ext_vector_type(4)));
typedef GAS unsigned gu32;
#define RLX_AGENT __ATOMIC_RELAXED, __HIP_MEMORY_SCOPE_AGENT
#define LDS_WAIT() asm volatile("s_waitcnt lgkmcnt(0)" ::: "memory")
#define VM_WAIT() asm volatile("s_waitcnt vmcnt(0)" ::: "memory")
__device__ __forceinline__ unsigned pk2(float lo, float hi) { return pg8::cvt_pk_bf16(lo, hi); }
__device__ __forceinline__ float bflo(unsigned w) { return __uint_as_float(w << 16); }
__device__ __forceinline__ float bfhi(unsigned w) { return __uint_as_float(w & 0xffff0000u); }
__device__ __forceinline__ float bf2f(bf16 h) { return __uint_as_float(((unsigned)h) << 16); }
#define XB_TMO      128
#define XB_XCNT(j)  (256  + 64 * (j))
#define XB_XSUB(j)  (1280 + 64 * (j))
#define XB_XGEN(j)  (2304 + 64 * (j))
#define XB_TOP      3328
#define XB_TOPGEN   3392
#define XCD_BAR_WORDS 3456
#define XB_SPIN_CAP (1u << 18)

__device__ __forceinline__ unsigned xb_ld(unsigned* p)              { return __hip_atomic_load(p, __ATOMIC_RELAXED, __HIP_MEMORY_SCOPE_AGENT); }
__device__ __forceinline__ unsigned xb_add(unsigned* p, unsigned v) { return __hip_atomic_fetch_add(p, v, __ATOMIC_RELAXED, __HIP_MEMORY_SCOPE_AGENT); }
__device__ __forceinline__ unsigned xb_xcc_id() { return (unsigned)__builtin_amdgcn_s_getreg((3 << 11) | 20) & 0xFu; }
#define XB_SPIN(cond, bar) do { unsigned _sp = 0; while (cond) { __builtin_amdgcn_s_sleep(1); \
    if ((++_sp & 255u) == 0u) { if (xb_ld(&(bar)[XB_TMO])) break; if (_sp > XB_SPIN_CAP) { atomicAdd(&(bar)[XB_TMO], 1u); break; } } } } while (0)

struct XcdBarrier {
    unsigned* bar; unsigned x;
    volatile LAS unsigned* st;
};

__device__ __forceinline__ XcdBarrier xcd_barrier_post(unsigned* bar, volatile LAS unsigned* st) {
    XcdBarrier b; b.bar = bar; b.x = xb_xcc_id(); b.st = st;
    if (threadIdx.x == 0) (void)xb_add(&bar[XB_XCNT(b.x)], 1u);
    return b;
}
__device__ __forceinline__ void xcd_barrier_complete(unsigned* bar, unsigned x, unsigned& nloc, unsigned& nx) {
    const unsigned G = gridDim.x * gridDim.y * gridDim.z;
    unsigned sum, cnt, mine, sp = 0u;
    for (;;) {
        sum = 0u; cnt = 0u; mine = 0u;
#pragma unroll
        for (unsigned j = 0; j < 16; ++j) { const unsigned c = xb_ld(&bar[XB_XCNT(j)]); sum += c; cnt += (c > 0u) ? 1u : 0u; mine = (j == x) ? c : mine; }
        if (sum == G) break;
        __builtin_amdgcn_s_sleep(1);
        if ((++sp & 255u) == 0u) { if (xb_ld(&bar[XB_TMO])) break; if (sp > XB_SPIN_CAP) { atomicAdd(&bar[XB_TMO], 1u); break; } }
    }
    nloc = mine > 0u ? mine : 1u; nx = cnt > 0u ? cnt : 1u;
}

__device__ __forceinline__ void xcd_barrier(const XcdBarrier& b) {
    asm volatile("s_waitcnt vmcnt(0)" ::: "memory");
    __syncthreads();
    if (threadIdx.x == 0) {
        unsigned* bar = b.bar;
        __builtin_amdgcn_s_waitcnt(0);
        unsigned nloc = b.st[0], nx = b.st[1];
        if (nloc == 0u) { xcd_barrier_complete(bar, b.x, nloc, nx); b.st[0] = nloc; b.st[1] = nx; }
        const unsigned old = xb_add(&bar[XB_XSUB(b.x)], 1u);
        const unsigned gen = old / nloc;
        if (old + 1u == (gen + 1u) * nloc) {
            __builtin_amdgcn_fence(__ATOMIC_RELEASE, "agent");
            asm volatile("s_waitcnt vmcnt(0)" ::: "memory");
            const unsigned og = xb_add(&bar[XB_TOP], 1u);
            const unsigned tg = og / nx;
            if (og + 1u == (tg + 1u) * nx) xb_add(&bar[XB_TOPGEN], 1u);
            else XB_SPIN(xb_ld(&bar[XB_TOPGEN]) == tg, bar);
            __builtin_amdgcn_fence(__ATOMIC_ACQUIRE, "agent");
            xb_add(&bar[XB_XGEN(b.x)], 1u);
            asm volatile("s_waitcnt vmcnt(0)" ::: "memory");
        } else {
            XB_SPIN(xb_ld(&bar[XB_XGEN(b.x)]) == gen, bar);
            __builtin_amdgcn_fence(__ATOMIC_ACQUIRE, "agent");
            asm volatile("s_waitcnt vmcnt(0)" ::: "memory");
        }
    }
    __syncthreads();
}

struct Frame {
    LAS unsigned char* lds; volatile LAS unsigned* MISC; gu32* ctl; unsigned char* ws;
    int tid, lane, wave, vcu, G;
    const float* in[29]; float* out;
};
enum { I_X = 0, I_C, I_RELB, I_WADA, I_BADA, I_GPREMIX, I_GPOSTMIX, I_WIN, I_WATT, I_LRE, I_LIM, I_LOGDT, I_BRE, I_BIM, I_CRE, I_CIM, I_SSMD, I_WGLUV, I_WGLUG, I_WMIX,
       I_GPREFFN, I_GPOSTFFN, I_WRG, I_BRG, I_WRE, I_BRE2, I_WEG, I_WEU, I_WED };
__device__ __forceinline__ float wave_sum(float v) {
#pragma unroll
    for (int o = 1; o < 64; o <<= 1) v += __shfl_xor(v, o);
    return v;
}

__device__ __forceinline__ void p0_mod(Frame& F) {
    LAS float* cact = (LAS float*)F.lds;
    LAS float* red = (LAS float*)(F.lds + 65536);
    const float* c = F.in[I_C]; const float* w = F.in[I_WADA]; const float* bb = F.in[I_BADA];
    float* mod = (float*)(F.ws + WS_MOD);
    for (int i = F.tid; i < 16 * 1024; i += 512) { const int b = i >> 10, k = i & 1023; const float v = c[i]; cact[k * 16 + b] = v / (1.0f + __expf(-v)); }
    __syncthreads();
    const int blk = blockIdx.x, c4 = F.tid % 6, bg = (F.tid / 6) % 4, ks = F.tid / 24;
    float acc[4][4];
#pragma unroll
    for (int i = 0; i < 4; ++i)
#pragma unroll
        for (int j = 0; j < 4; ++j) acc[i][j] = 0.f;
    if (F.tid < 504) {
        for (int k = ks; k < 1024; k += 21) {
            const f32x4 wv = *(const f32x4*)(w + (size_t)k * 6144 + 24 * blk + 4 * c4);
            const f32x4 av = *(const LAS f32x4*)(cact + k * 16 + 4 * bg);
#pragma unroll
            for (int i = 0; i < 4; ++i)
#pragma unroll
                for (int j = 0; j < 4; ++j) acc[i][j] += av[i] * wv[j];
        }
#pragma unroll
        for (int i = 0; i < 4; ++i)
#pragma unroll
            for (int j = 0; j < 4; ++j) red[(ks * 24 + bg * 6 + c4) * 16 + i * 4 + j] = acc[i][j];
    }
    __syncthreads();
    if (F.tid < 384) {
        const int b = F.tid / 24, cc = F.tid % 24, cq = cc >> 2, j = cc & 3, g = b >> 2, bi = b & 3;
        float s = bb[24 * blk + cc];
        for (int q = 0; q < 21; ++q) s += red[(q * 24 + g * 6 + cq) * 16 + bi * 4 + j];
        mod[b * 6144 + 24 * blk + cc] = s;
    }
    __syncthreads();
}

__device__ __forceinline__ int t5_bucket(int d) {
    if (d < 16) return d;
    const float v = logf((float)d / 16.0f) / 2.0794415416798357f * 16.0f;
    const int b = 16 + (int)v; return b < 31 ? b : 31;
}
__device__ __forceinline__ void p0_tables(Frame& F) {
    { float* bt = (float*)(F.ws + WS_BTAB); const float* rb = F.in[I_RELB];
      for (int i = blockIdx.x * 512 + F.tid; i < 8 * 576; i += F.G * 512) { const int h = i / 576, d = i % 576 - 64;
          bt[i] = d < 0 ? -1e30f : rb[t5_bucket(d) * 8 + h] * LOG2E; } }
    { bf16* rw = (bf16*)(F.ws + WS_ROUTW); float* rcb = (float*)(F.ws + WS_ROUTC); const float* wg = F.in[I_WRG]; const float* we = F.in[I_WRE]; const float* mod = (const float*)(F.ws + WS_MOD);
      for (int i = blockIdx.x * 512 + F.tid; i < 16 * 49152; i += F.G * 512) {
          const int b = i / 49152, r = i % 49152, j = r & 7, ln = (r >> 3) & 63, nt = (r >> 9) % 3, ks = r / 1536;
          const int k = 32 * ks + 8 * (ln >> 4) + j, col = 16 * nt + (ln & 15);
          const float v = col < 4 ? wg[k * 4 + col] : (col < 36 ? we[k * 32 + col - 4] : 0.f);
          rw[i] = (bf16)(pk2(v * F.in[I_GPREFFN][k] * (1.0f + mod[b * 6144 + 4096 + k]), 0.f) & 0xffffu); }
      for (int i = blockIdx.x * 512 + F.tid; i < 16 * 48 * 8; i += F.G * 512) {
          const int sl = i & 7, col = (i >> 3) % 48, b = i / 384; float sm = 0.f;
          if (col < 36) for (int k = sl * 128; k < sl * 128 + 128; ++k) sm += mod[b * 6144 + 3072 + k] * (col < 4 ? wg[k * 4 + col] : we[k * 32 + col - 4]);
          sm += __shfl_xor(sm, 1); sm += __shfl_xor(sm, 2); sm += __shfl_xor(sm, 4);
          if (sl == 0) rcb[b * 48 + col] = col < 36 ? sm + (col < 4 ? F.in[I_BRG][col] : F.in[I_BRE2][col - 4]) : 0.f; } }
    {
        const int g = blockIdx.x & 15, part = blockIdx.x >> 4;
        LAS float* Apow = (LAS float*)F.lds;
        LAS float* Bb = Apow + 64 * 33 * 2;
        LAS float* Cc = Bb + 64 * 16 * 2;
        if (F.tid < 64) {
            const int p = F.tid; const float lr = F.in[I_LRE][g * 64 + p], li = F.in[I_LIM][g * 64 + p], dt = expf(F.in[I_LOGDT][g]);
            const float zr = lr * dt, zi = li * dt;
            for (int e = 0; e <= 32; ++e) { float sn, cs; sincosf(zi * (float)e, &sn, &cs); const float mg = expf(zr * (float)e); Apow[(p * 33 + e) * 2] = mg * cs; Apow[(p * 33 + e) * 2 + 1] = mg * sn; }
            float sn, cs, sh; sincosf(zi, &sn, &cs); sh = sinf(0.5f * zi);
            const float nr = expm1f(zr) * cs - 2.0f * sh * sh, ni = expf(zr) * sn, den = lr * lr + li * li;
            const float fr_ = (nr * lr + ni * li) / den, fi_ = (ni * lr - nr * li) / den;
            for (int ch = 0; ch < 16; ++ch) { const float br = F.in[I_BRE][(g * 64 + p) * 16 + ch], bi = F.in[I_BIM][(g * 64 + p) * 16 + ch];
                Bb[(p * 16 + ch) * 2] = fr_ * br - fi_ * bi; Bb[(p * 16 + ch) * 2 + 1] = fr_ * bi + fi_ * br; }
            if (part == 0) { float* aL = (float*)(F.ws + WS_SSMAL) + (g * 64 + p) * 2; aL[0] = Apow[(p * 33 + 32) * 2]; aL[1] = Apow[(p * 33 + 32) * 2 + 1]; }
        }
        for (int i = F.tid; i < 1024; i += 512) { const int co = i >> 6, p = i & 63; Cc[i * 2] = F.in[I_CRE][(g * 16 + co) * 64 + p]; Cc[i * 2 + 1] = F.in[I_CIM][(g * 16 + co) * 64 + p]; }
        __syncthreads();
        unsigned char* gb = F.ws + WS_SSMTAB + (size_t)g * SSM_GRP_BYTES;
        bf16* Tf = (bf16*)(gb + SSM_T_OFF); bf16* Wf = (bf16*)(gb + SSM_W_OFF); bf16* Sf = (bf16*)(gb + SSM_S_OFF);
        for (int q = F.tid; q < 1024; q += 512) {
            const int idx = part * 1024 + q, j = idx & 7, ln = (idx >> 3) & 63, dj = idx >> 9, kq = ln >> 4, co = ln & 15, lag = dj - (kq >> 1), ch = 8 * (kq & 1) + j;
            float s = 0.f;
            if (lag >= 0) for (int p = 0; p < 64; ++p) {
                const float cr = Cc[(co * 64 + p) * 2], ci = Cc[(co * 64 + p) * 2 + 1], ar = Apow[(p * 33 + lag) * 2], ai = Apow[(p * 33 + lag) * 2 + 1], br = Bb[(p * 16 + ch) * 2], bi = Bb[(p * 16 + ch) * 2 + 1];
                const float tr = cr * ar - ci * ai, ti = cr * ai + ci * ar; s += tr * br - ti * bi; }
            if (lag == 0 && co == ch) s += F.in[I_SSMD][g * 16 + co];
            Tf[idx] = (bf16)(pk2(s, 0.f) & 0xffffu);
        }
        for (int q = F.tid; q < 4096; q += 512) {
            const int idx = part * 4096 + q, j = idx & 7, ln = (idx >> 3) & 63, nt = (idx >> 9) & 7, ks = idx >> 12, kq = ln >> 4;
            const int s_ = 2 * ks + (kq >> 1), ch = 8 * (kq & 1) + j, n = 16 * nt + (ln & 15), p = n & 63, e = 31 - s_;
            const float ar = Apow[(p * 33 + e) * 2], ai = Apow[(p * 33 + e) * 2 + 1], br = Bb[(p * 16 + ch) * 2], bi = Bb[(p * 16 + ch) * 2 + 1];
            const float v = (n < 64) ? (ar * br - ai * bi) : (ar * bi + ai * br);
            Wf[idx] = (bf16)(pk2(v, 0.f) & 0xffffu);
        }
        for (int q = F.tid; q < 4096; q += 512) {
            const int idx = part * 4096 + q, j = idx & 7, ln = (idx >> 3) & 63, t = (idx >> 9) & 31, ks = idx >> 14, kq = ln >> 4;
            const int k = 32 * ks + 8 * kq + j, p = k & 63, co = ln & 15;
            const float cr = Cc[(co * 64 + p) * 2], ci = Cc[(co * 64 + p) * 2 + 1], ar = Apow[(p * 33 + t + 1) * 2], ai = Apow[(p * 33 + t + 1) * 2 + 1];
            const float v = (k < 64) ? (cr * ar - ci * ai) : -(cr * ai + ci * ar);
            Sf[idx] = (bf16)(pk2(v, 0.f) & 0xffffu);
        }
        __syncthreads();
    }
}

__device__ __forceinline__ void transpose_item(const float* W, int K, int N, bf16* WT, int mode, LAS float* scr, int item, int lane) {
    const int nblk = N / 32, kb = item / nblk, nb = item % nblk, k0 = 64 * kb, n0 = 32 * nb;
    float tv[32];
#pragma unroll
    for (int i = 0; i < 32; ++i) { const int kk = 2 * i + (lane >> 5); tv[i] = W[(size_t)(k0 + kk) * N + n0 + (lane & 31)]; }
#pragma unroll
    for (int i = 0; i < 32; ++i) { const int kk = 2 * i + (lane >> 5); scr[kk * 33 + (lane & 31)] = tv[i]; }
    LDS_WAIT(); asm volatile("" ::: "memory");
    const int c = lane & 7;
#pragma unroll
    for (int j = 0; j < 4; ++j) { const int n = (lane >> 3) + 8 * j; const LAS float* s = scr + (8 * c) * 33 + n;
        v4u o; o.x = pk2(s[0 * 33], s[1 * 33]); o.y = pk2(s[2 * 33], s[3 * 33]); o.z = pk2(s[4 * 33], s[5 * 33]); o.w = pk2(s[6 * 33], s[7 * 33]);
        const int ng = n0 + n; const int drow = mode == 0 ? ng : (256 * (ng >> 7) + (ng & 127) + (mode == 2 ? 128 : 0));
        *(GAS v4u*)(WT + (size_t)drow * K + k0 + 8 * c) = o; }
    LDS_WAIT(); asm volatile("" ::: "memory");
}
__device__ __forceinline__ float clamp8(float v) { return __builtin_amdgcn_fmed3f(v, -440.f, 440.f); }
__device__ __forceinline__ unsigned pk4_fp8(float a, float b, float c, float d) { int w = __builtin_amdgcn_cvt_pk_fp8_f32(clamp8(a), clamp8(b), 0, false); w = __builtin_amdgcn_cvt_pk_fp8_f32(clamp8(c), clamp8(d), w, true); return (unsigned)w; }
__device__ __forceinline__ void transpose_item_f8(const float* W, int K, int N, unsigned char* WT, int mode, float scale, LAS float* scr, int item, int lane) {
    const int nblk = N / 32, kb = item / nblk, nb = item % nblk, k0 = 64 * kb, n0 = 32 * nb;
    const int g = lane >> 3, c = lane & 7;
    f32x4 tv[8];
    const float* wp = W + (size_t)(k0 + 8 * g) * N + n0 + 4 * c;
#pragma unroll
    for (int i = 0; i < 8; ++i) tv[i] = *(const f32x4*)(wp + (size_t)i * N);
#pragma unroll
    for (int j = 0; j < 4; ++j) {
        v2u o; o.x = pk4_fp8(tv[0][j] * scale, tv[1][j] * scale, tv[2][j] * scale, tv[3][j] * scale); o.y = pk4_fp8(tv[4][j] * scale, tv[5][j] * scale, tv[6][j] * scale, tv[7][j] * scale);
        const int ng = n0 + 4 * c + j; const int drow = mode == 0 ? ng : (256 * (ng >> 7) + (ng & 127) + (mode == 2 ? 128 : 0));
        *(GAS v2u*)(WT + (size_t)drow * K + k0 + 8 * g) = o; }
    (void)scr;
}
#define WDESC(it, S) const float* W##S; unsigned char* D##S; int K##S, N##S, M##S, I##S; do { const int it_ = (it); \
        if (it_ < I0) { W##S = F.in[I_WIN]; D##S = F.ws + WS_WIN; K##S = 1024; N##S = NPROJ; M##S = 0; I##S = it_; } \
        else if (it_ < I1) { W##S = F.in[I_WATT]; D##S = F.ws + WS_WO; K##S = 512; N##S = 1024; M##S = 0; I##S = it_ - I0; } \
        else if (it_ < I2) { W##S = F.in[I_WGLUV]; D##S = F.ws + WS_WGLU; K##S = 256; N##S = 1024; M##S = 1; I##S = it_ - I1; } \
        else if (it_ < I3) { W##S = F.in[I_WGLUG]; D##S = F.ws + WS_WGLU; K##S = 256; N##S = 1024; M##S = 2; I##S = it_ - I2; } \
        else if (it_ < I4) { W##S = F.in[I_WMIX]; D##S = F.ws + WS_WMIX; K##S = 1024; N##S = 1024; M##S = 0; I##S = it_ - I3; } \
        else if (it_ < I5) { const int r_ = it_ - I4, e_ = r_ >> 8; W##S = F.in[I_WEG] + (size_t)e_ * 1024 * 512; D##S = F.ws + WS_WGU + (size_t)e_ * 1024 * 1024; K##S = 1024; N##S = 512; M##S = 1; I##S = r_ & 255; } \
        else if (it_ < I6) { const int r_ = it_ - I5, e_ = r_ >> 8; W##S = F.in[I_WEU] + (size_t)e_ * 1024 * 512; D##S = F.ws + WS_WGU + (size_t)e_ * 1024 * 1024; K##S = 1024; N##S = 512; M##S = 2; I##S = r_ & 255; } \
        else { const int r_ = it_ - I6, e_ = r_ >> 8; W##S = F.in[I_WED] + (size_t)e_ * 512 * 1024; D##S = F.ws + WS_WDN + (size_t)e_ * 1024 * 512; K##S = 512; N##S = 1024; M##S = 0; I##S = r_ & 255; } } while (0)
#define WLOAD(S, tv) do { const int nblk_ = N##S / 32, kb_ = I##S / nblk_, nb_ = I##S % nblk_; const float* wp_ = W##S + (size_t)(64 * kb_ + 8 * (lane >> 3)) * N##S + 32 * nb_ + 4 * (lane & 7); \
        _Pragma("unroll") for (int i = 0; i < 8; ++i) tv[i] = __builtin_nontemporal_load((const f32x4*)(wp_ + (size_t)i * N##S)); } while (0)
#define WSTORE(S, tv) do { const int nblk_ = N##S / 32, kb_ = I##S / nblk_, nb_ = I##S % nblk_, k0_ = 64 * kb_, n0_ = 32 * nb_, g_ = lane >> 3, c_ = lane & 7; \
        _Pragma("unroll") for (int j = 0; j < 4; ++j) { v2u o; o.x = pk4_fp8(tv[0][j] * W8_SCALE, tv[1][j] * W8_SCALE, tv[2][j] * W8_SCALE, tv[3][j] * W8_SCALE); o.y = pk4_fp8(tv[4][j] * W8_SCALE, tv[5][j] * W8_SCALE, tv[6][j] * W8_SCALE, tv[7][j] * W8_SCALE); \
            const int ng = n0_ + 4 * c_ + j; const int drow = M##S == 0 ? ng : (256 * (ng >> 7) + (ng & 127) + (M##S == 2 ? 128 : 0)); \
            *(GAS v2u*)(D##S + (size_t)drow * K##S + k0_ + 8 * g_) = o; } } while (0)
constexpr int WI_EXPERT = 16 * 120 + 8 * 32 + 4 * 32 + 4 * 32 + 16 * 32, WI_END = WI_EXPERT + 3 * 32 * 256;
__device__ __forceinline__ void p0_weights(Frame& F, const int lo, const int hi) {
    const int lane = F.lane; const int gw = F.vcu * NWAVES + F.wave, NGW = F.G * NWAVES;
    constexpr int I0 = 16 * 120, I1 = I0 + 8 * 32, I2 = I1 + 4 * 32, I3 = I2 + 4 * 32, I4 = I3 + 16 * 32, I5 = I4 + 32 * 256, I6 = I5 + 32 * 256, I7 = I6 + 32 * 256;
    static_assert(I4 == WI_EXPERT && I7 == WI_END, "item ranges");
    f32x4 nv[8];
    if (lo + gw < hi) { WDESC(lo + gw, a); WLOAD(a, nv); }
    for (int it = lo + gw; it < hi; it += NGW) {
        f32x4 cv[8];
#pragma unroll
        for (int i = 0; i < 8; ++i) cv[i] = nv[i];
        const int nit = it + NGW < hi ? it + NGW : it;
        { WDESC(nit, n); WLOAD(n, nv); }
        { WDESC(it, c); WSTORE(c, cv); }
    }
}
#undef WDESC
#undef WLOAD
#undef WSTORE

__device__ __forceinline__ void p1_xn(Frame& F) {
    const int gw = F.vcu * NWAVES + F.wave; const int row0 = gw * 32, b = row0 >> 12;
    const float* mod = (const float*)(F.ws + WS_MOD) + b * 6144; const float* g = F.in[I_GPREMIX];
    f32x4 A1[4], A3[4];
#pragma unroll
    for (int j = 0; j < 4; ++j) { const int c = 4 * F.lane + 256 * j; const f32x4 gg = *(const f32x4*)(g + c), sc = *(const f32x4*)(mod + 1024 + c); A1[j] = gg * (sc + 1.0f); A3[j] = *(const f32x4*)(mod + c); }
    unsigned char* XN = F.ws + WS_RA;
    f32x4 nx[4];
    { const f32x4* xr = (const f32x4*)(F.in[I_X] + (size_t)row0 * 1024) + F.lane;
#pragma unroll
      for (int j = 0; j < 4; ++j) nx[j] = __builtin_nontemporal_load(xr + 64 * j); }
    for (int r = 0; r < 32; ++r) {
        const size_t row = (size_t)(row0 + r);
        f32x4 v[4]; float s = 0.f;
#pragma unroll
        for (int j = 0; j < 4; ++j) v[j] = nx[j];
        { const f32x4* xr = (const f32x4*)(F.in[I_X] + (row + (r < 31 ? 1 : 0)) * 1024) + F.lane;
#pragma unroll
          for (int j = 0; j < 4; ++j) nx[j] = __builtin_nontemporal_load(xr + 64 * j); }
#pragma unroll
        for (int j = 0; j < 4; ++j) s += (v[j].x * v[j].x + v[j].y * v[j].y) + (v[j].z * v[j].z + v[j].w * v[j].w);
        const float rstd = rsqrtf(wave_sum(s) * (1.0f / 1024.0f) + RMS_EPS);
        unsigned* o = (unsigned*)(XN + row * 1024) + F.lane;
#pragma unroll
        for (int j = 0; j < 4; ++j) { const f32x4 h = (v[j] * rstd * A1[j] + A3[j]) * A8_SCALE; o[64 * j] = pk4_fp8(h.x, h.y, h.z, h.w); }
    }
}

namespace att {
constexpr int LK = 0, LV = 32768, LBT = 65536, LKM = 67840, LWS = 72192, LSTG = 74240, LLIST = 111104;
constexpr int STG_ROW = 144, STG_WAVE = 32 * STG_ROW;
#define KSWZ64(row, colB) ((row) * 128 + ((colB) ^ ((((row) >> 1) & 7) << 4)))
__device__ __forceinline__ int crow(int r, int hi) { return (r & 3) + 8 * (r >> 2) + 4 * hi; }
__device__ __forceinline__ int v_st(int k, int c) { const int kk = (k & ~0xC) | ((k & 4) << 1) | ((k & 8) >> 1); return ((kk >> 3) * 2 + (c >> 5)) * 512 + ((kk & 7) * 32 + (c & 31)) * 2; }
__device__ __forceinline__ int v_rd_base(int lane) { return ((lane & 3) << 3) | (((lane >> 2) & 3) << 6) | (((lane >> 4) & 1) << 5) | (((lane >> 5) & 1) << 8); }
constexpr int v_rd_off(int d0, int ks, int half) { return d0 * 512 + ks * 2048 + half * 1024; }
template <int OFF> __device__ __forceinline__ s16x4 tr_read(int vb) { s16x4 r; asm volatile("ds_read_b64_tr_b16 %0, %1 offset:%2" : "=&v"(r) : "v"(vb), "i"(OFF) : "memory"); return r; }
#define SBAR() __builtin_amdgcn_sched_barrier(0)
template <int D0> __device__ __forceinline__ void pv_one(f32x16& od, int vb, bf16x8 pa0, bf16x8 pa1, bf16x8 pa2, bf16x8 pa3) {
    const s16x4 l0 = tr_read<v_rd_off(D0, 0, 0)>(vb), h0 = tr_read<v_rd_off(D0, 0, 1)>(vb), l1 = tr_read<v_rd_off(D0, 1, 0)>(vb), h1 = tr_read<v_rd_off(D0, 1, 1)>(vb);
    const s16x4 l2 = tr_read<v_rd_off(D0, 2, 0)>(vb), h2 = tr_read<v_rd_off(D0, 2, 1)>(vb), l3 = tr_read<v_rd_off(D0, 3, 0)>(vb), h3 = tr_read<v_rd_off(D0, 3, 1)>(vb);
    asm volatile("s_waitcnt lgkmcnt(0)" ::: "memory"); SBAR();
#define PK(L, H) (bf16x8){L[0], L[1], L[2], L[3], H[0], H[1], H[2], H[3]}
    od = __builtin_amdgcn_mfma_f32_32x32x16_bf16(pa0, PK(l0, h0), od, 0, 0, 0);
    od = __builtin_amdgcn_mfma_f32_32x32x16_bf16(pa1, PK(l1, h1), od, 0, 0, 0);
    od = __builtin_amdgcn_mfma_f32_32x32x16_bf16(pa2, PK(l2, h2), od, 0, 0, 0);
    od = __builtin_amdgcn_mfma_f32_32x32x16_bf16(pa3, PK(l3, h3), od, 0, 0, 0);
#undef PK
}
__device__ __forceinline__ void pv_two(f32x16 (&o)[2], int vb, bf16x8 pa0, bf16x8 pa1, bf16x8 pa2, bf16x8 pa3) {
    const s16x4 l0 = tr_read<v_rd_off(0, 0, 0)>(vb), h0 = tr_read<v_rd_off(0, 0, 1)>(vb), l1 = tr_read<v_rd_off(0, 1, 0)>(vb), h1 = tr_read<v_rd_off(0, 1, 1)>(vb);
    const s16x4 l2 = tr_read<v_rd_off(0, 2, 0)>(vb), h2 = tr_read<v_rd_off(0, 2, 1)>(vb), l3 = tr_read<v_rd_off(0, 3, 0)>(vb), h3 = tr_read<v_rd_off(0, 3, 1)>(vb);
    const s16x4 m0 = tr_read<v_rd_off(1, 0, 0)>(vb), g0 = tr_read<v_rd_off(1, 0, 1)>(vb), m1 = tr_read<v_rd_off(1, 1, 0)>(vb), g1 = tr_read<v_rd_off(1, 1, 1)>(vb);
    const s16x4 m2 = tr_read<v_rd_off(1, 2, 0)>(vb), g2 = tr_read<v_rd_off(1, 2, 1)>(vb), m3 = tr_read<v_rd_off(1, 3, 0)>(vb), g3 = tr_read<v_rd_off(1, 3, 1)>(vb);
    asm volatile("s_waitcnt lgkmcnt(8)" ::: "memory"); SBAR();
#define PK(L, H) (bf16x8){L[0], L[1], L[2], L[3], H[0], H[1], H[2], H[3]}
    o[0] = __builtin_amdgcn_mfma_f32_32x32x16_bf16(pa0, PK(l0, h0), o[0], 0, 0, 0);
    o[0] = __builtin_amdgcn_mfma_f32_32x32x16_bf16(pa1, PK(l1, h1), o[0], 0, 0, 0);
    o[0] = __builtin_amdgcn_mfma_f32_32x32x16_bf16(pa2, PK(l2, h2), o[0], 0, 0, 0);
    o[0] = __builtin_amdgcn_mfma_f32_32x32x16_bf16(pa3, PK(l3, h3), o[0], 0, 0, 0);
    asm volatile("s_waitcnt lgkmcnt(0)" ::: "memory"); SBAR();
    o[1] = __builtin_amdgcn_mfma_f32_32x32x16_bf16(pa0, PK(m0, g0), o[1], 0, 0, 0);
    o[1] = __builtin_amdgcn_mfma_f32_32x32x16_bf16(pa1, PK(m1, g1), o[1], 0, 0, 0);
    o[1] = __builtin_amdgcn_mfma_f32_32x32x16_bf16(pa2, PK(m2, g2), o[1], 0, 0, 0);
    o[1] = __builtin_amdgcn_mfma_f32_32x32x16_bf16(pa3, PK(m3, g3), o[1], 0, 0, 0);
#undef PK
}
__device__ __forceinline__ void stage_kv(Frame& F, size_t rowb, int h, int key0, int ntile) {
    const bf16* Kg = (const bf16*)(F.ws + WS_K); const bf16* Vg = (const bf16*)(F.ws + WS_V);
    const int sr = F.tid >> 3, sc = (F.tid & 7) * 8; const int kst = KSWZ64(sr, sc * 2), vst = v_st(sr, sc);
    for (int t = 0; t < ntile; ++t) { const size_t go = (rowb + key0 + t * 64 + sr) * ATTW + h * HD + sc;
        const bf16x8 kv = *(const bf16x8*)(Kg + go), vv = *(const bf16x8*)(Vg + go);
        *(LAS bf16x8*)(F.lds + LK + t * 8192 + kst) = kv; *(LAS bf16x8*)(F.lds + LV + t * 8192 + vst) = vv; }
}
template <bool GENERAL> __device__ __forceinline__ void tile_step(LAS unsigned char* L, int kt, const bf16x8 (&qr)[4], float cinit, int ib, float& m_reg, float& l_reg, f32x16 (&o)[2],
                                                                  LAS float* wsf, int r32, int hi, int vb0) {
    f32x16 p0, p1;
#pragma unroll
    for (int r = 0; r < 16; ++r) { p0[r] = cinit; p1[r] = cinit; }
    const LAS unsigned char* Kt = L + LK + kt * 8192;
#pragma unroll
    for (int d0 = 0; d0 < 4; ++d0) { const int cb = (d0 * 16 + hi * 8) * 2;
        const bf16x8 k0 = *(const LAS bf16x8*)(Kt + KSWZ64(r32, cb)); const bf16x8 k1 = *(const LAS bf16x8*)(Kt + KSWZ64(32 + r32, cb));
        p0 = __builtin_amdgcn_mfma_f32_32x32x16_bf16(k0, qr[d0], p0, 0, 0, 0);
        p1 = __builtin_amdgcn_mfma_f32_32x32x16_bf16(k1, qr[d0], p1, 0, 0, 0); }
    if (GENERAL) {
        const LAS float* btab = (const LAS float*)(L + LBT);
        float bv0[16], bv1[16];
#pragma unroll
        for (int r = 0; r < 16; ++r) { const int c = (r & 3) + 8 * (r >> 2); bv0[r] = btab[ib - c]; bv1[r] = btab[ib - 32 - c]; }
        SBAR();
#pragma unroll
        for (int r = 0; r < 16; ++r) { p0[r] += bv0[r]; p1[r] += bv1[r]; }
    }
    float pmax = p0[0];
#pragma unroll
    for (int r = 1; r < 16; ++r) pmax = fmaxf(pmax, p0[r]);
#pragma unroll
    for (int r = 0; r < 16; ++r) pmax = fmaxf(pmax, p1[r]);
    { auto rr = __builtin_amdgcn_permlane32_swap(__float_as_uint(pmax), __float_as_uint(pmax), false, false); pmax = fmaxf(__uint_as_float(rr[0]), __uint_as_float(rr[1])); }
    pmax = fmaxf(pmax, -1e20f);
    const float mn = fmaxf(m_reg, pmax); const float alpha = __builtin_amdgcn_exp2f(m_reg - mn); m_reg = mn;
    float ps = 0.f;
#pragma unroll
    for (int r = 0; r < 16; ++r) { p0[r] = __builtin_amdgcn_exp2f(p0[r] - mn); p1[r] = __builtin_amdgcn_exp2f(p1[r] - mn); ps += p0[r] + p1[r]; }
    { auto rr = __builtin_amdgcn_permlane32_swap(__float_as_uint(ps), __float_as_uint(ps), false, false); ps = __uint_as_float(rr[0]) + __uint_as_float(rr[1]); }
    l_reg = l_reg * alpha + ps;
    bf16x8 pa0, pa1, pa2, pa3;
#define PK4(P, BASE, OUT) do { unsigned a0 = pk2(P[BASE + 0], P[BASE + 1]), a1 = pk2(P[BASE + 2], P[BASE + 3]); \
    unsigned b0 = pk2(P[BASE + 4], P[BASE + 5]), b1 = pk2(P[BASE + 6], P[BASE + 7]); \
    auto r0 = __builtin_amdgcn_permlane32_swap(a0, b0, false, false); auto r1 = __builtin_amdgcn_permlane32_swap(a1, b1, false, false); \
    v4u w = {r0[0], r1[0], r0[1], r1[1]}; OUT = __builtin_bit_cast(bf16x8, w); } while (0)
    PK4(p0, 0, pa0); PK4(p0, 8, pa1); PK4(p1, 0, pa2); PK4(p1, 8, pa3);
#undef PK4
    if (__any(alpha < 1.f)) { if (hi == 0) wsf[r32] = alpha; LDS_WAIT();
#pragma unroll
        for (int r = 0; r < 16; ++r) { const float a = wsf[crow(r, hi)]; o[0][r] *= a; o[1][r] *= a; }
        LDS_WAIT(); }
    const int vb = vb0 + kt * 8192;
    pv_one<0>(o[0], vb, pa0, pa1, pa2, pa3); pv_one<1>(o[1], vb, pa0, pa1, pa2, pa3);
}

__device__ __forceinline__ bool owned(int qb, int sub) { const int q = qb & 3; return sub ? (q == 1 || q == 2) : (q == 0 || q == 3); }
__device__ __forceinline__ void select_rows(Frame& F, int b, int h, int half) {
    LAS float* kmean = (LAS float*)(F.lds + LKM);
    LAS unsigned short* mloc = (LAS unsigned short*)(F.lds + LK);
    LAS int* lcnt = (LAS int*)(F.lds + LK + 4096);
    { const float* kp = (const float*)(F.ws + WS_KPART);
      for (int i = F.tid; i < 1024; i += 512) { const int n = i >> 6, d = i & 63; const size_t o = (size_t)((b * 16 + n) * 2) * 512 + h * 64 + d; kmean[i] = (kp[o] + kp[o + 512]) * (1.0f / 256.0f); }
      if (F.tid < 32) lcnt[F.tid] = 0; }
    __syncthreads();
    const bf16* Qg = (const bf16*)(F.ws + WS_Q); unsigned short* sel = (unsigned short*)(F.ws + WS_SEL);
    for (int c = 0; c < 4; ++c) {
        const int row = half * 2048 + c * 512 + F.tid, qb = row >> 8;
        const v4u* qp = (const v4u*)(Qg + ((size_t)b * SEQ + row) * ATTW + h * HD);
        float qf[64];
#pragma unroll
        for (int i = 0; i < 8; ++i) { const v4u w = qp[i]; qf[8 * i] = bflo(w.x); qf[8 * i + 1] = bfhi(w.x); qf[8 * i + 2] = bflo(w.y); qf[8 * i + 3] = bfhi(w.y); qf[8 * i + 4] = bflo(w.z); qf[8 * i + 5] = bfhi(w.z); qf[8 * i + 6] = bflo(w.w); qf[8 * i + 7] = bfhi(w.w); }
        float v0 = -3.0e38f, v1 = -3.0e38f, v2 = -3.0e38f; int i0 = -1, i1 = -1, i2 = -1;
        for (int n = 0; n < qb; ++n) {
            float g = 0.f;
#pragma unroll
            for (int d = 0; d < 64; ++d) g += qf[d] * kmean[n * 64 + d];
            if (g > v0) { v2 = v1; i2 = i1; v1 = v0; i1 = i0; v0 = g; i0 = n; }
            else if (g > v1) { v2 = v1; i2 = i1; v1 = g; i1 = n; }
            else if (g > v2) { v2 = g; i2 = n; }
        }
        unsigned m = 0u; if (i0 >= 0) m |= 1u << i0; if (i1 >= 0) m |= 1u << i1; if (i2 >= 0) m |= 1u << i2;
        sel[((size_t)(b * NH + h)) * SEQ + row] = (unsigned short)m; mloc[c * 512 + F.tid] = (unsigned short)m;
    }
    __syncthreads();
    unsigned short* rl = (unsigned short*)(F.ws + WS_RLIST) + ((size_t)(b * NH + h) * 16) * 4 * 1024;
    for (int qi = 0; qi < 8; ++qi) {
        const int qb = half * 8 + qi, sub = owned(qb, 0) ? 0 : 1;
        if (F.tid < 256) { const int lr = qi * 256 + F.tid; unsigned m = mloc[lr];
            while (m) { const int n = __builtin_ctz(m); m &= m - 1u; const int pos = __hip_atomic_fetch_add(lcnt + n * 2 + sub, 1, __ATOMIC_RELAXED, __HIP_MEMORY_SCOPE_WORKGROUP);
                rl[((size_t)(n * 2 + sub) * 2 + half) * 1024 + pos] = (unsigned short)(half * 2048 + lr); } }
        __syncthreads();
    }
    if (F.tid < 32) { int* rc = (int*)(F.ws + WS_RCNT) + ((size_t)(b * NH + h) * 16) * 4; rc[F.tid * 2 + half] = lcnt[F.tid]; }
    __syncthreads();
}

template <bool GENERAL, bool FIRST, bool PREF> __device__ __forceinline__ void tile_pair(LAS unsigned char* L, int kt0, bf16x8 (&qr)[4], float cinit, int ib, float& m_reg, float& l_reg, f32x16 (&o)[2],
                                                                             LAS float* wsf, int r32, int hi, int vb0, const bf16* qnext) {
    f32x16 s[2][2];
#pragma unroll
    for (int t = 0; t < 2; ++t) {
#pragma unroll
        for (int r = 0; r < 16; ++r) { s[t][0][r] = cinit; s[t][1][r] = cinit; }
        const LAS unsigned char* Kt = L + LK + (kt0 + t) * 8192;
#pragma unroll
        for (int d0 = 0; d0 < 4; ++d0) { const int cb = (d0 * 16 + hi * 8) * 2;
            const bf16x8 k0 = *(const LAS bf16x8*)(Kt + KSWZ64(r32, cb)); const bf16x8 k1 = *(const LAS bf16x8*)(Kt + KSWZ64(32 + r32, cb));
            s[t][0] = __builtin_amdgcn_mfma_f32_32x32x16_bf16(k0, qr[d0], s[t][0], 0, 0, 0);
            s[t][1] = __builtin_amdgcn_mfma_f32_32x32x16_bf16(k1, qr[d0], s[t][1], 0, 0, 0); }
    }
    if (PREF) {
#pragma unroll
        for (int d0 = 0; d0 < 4; ++d0) qr[d0] = *(const bf16x8*)(qnext + d0 * 16); }
    if (GENERAL) {
        const LAS float* btab = (const LAS float*)(L + LBT);
#pragma unroll
        for (int t = 0; t < 2; ++t) { float bv0[16], bv1[16];
#pragma unroll
            for (int r = 0; r < 16; ++r) { const int c = (r & 3) + 8 * (r >> 2); int i0 = ib - t * 64 - c, i1 = ib - t * 64 - 32 - c; i0 = i0 < 575 ? i0 : 575; i1 = i1 < 575 ? i1 : 575; bv0[r] = btab[i0]; bv1[r] = btab[i1]; }
            SBAR();
#pragma unroll
            for (int r = 0; r < 16; ++r) { s[t][0][r] += bv0[r]; s[t][1][r] += bv1[r]; } }
    }
    float pmax = fmaxf(s[0][0][0], s[1][0][0]);
#pragma unroll
    for (int r = 0; r < 16; ++r) pmax = fmaxf(pmax, fmaxf(fmaxf(s[0][0][r], s[0][1][r]), fmaxf(s[1][0][r], s[1][1][r])));
    { auto rr = __builtin_amdgcn_permlane32_swap(__float_as_uint(pmax), __float_as_uint(pmax), false, false); pmax = fmaxf(__uint_as_float(rr[0]), __uint_as_float(rr[1])); }
    pmax = fmaxf(pmax, -1e20f);
    const float mn = fmaxf(m_reg, pmax); const float alpha = __builtin_amdgcn_exp2f(m_reg - mn); m_reg = mn;
    float ps = 0.f;
#pragma unroll
    for (int t = 0; t < 2; ++t)
#pragma unroll
        for (int r = 0; r < 16; ++r) { s[t][0][r] = __builtin_amdgcn_exp2f(s[t][0][r] - mn); s[t][1][r] = __builtin_amdgcn_exp2f(s[t][1][r] - mn); ps += s[t][0][r] + s[t][1][r]; }
    { auto rr = __builtin_amdgcn_permlane32_swap(__float_as_uint(ps), __float_as_uint(ps), false, false); ps = __uint_as_float(rr[0]) + __uint_as_float(rr[1]); }
    l_reg = FIRST ? ps : (l_reg * alpha + ps);
    if (!FIRST) { if (__any(alpha < 1.f)) { if (hi == 0) wsf[r32] = alpha; LDS_WAIT();
#pragma unroll
        for (int r = 0; r < 16; ++r) { const float a = wsf[crow(r, hi)]; o[0][r] *= a; o[1][r] *= a; }
        LDS_WAIT(); } }
#define PK4(P, BASE, OUT) do { unsigned a0 = pk2(P[BASE + 0], P[BASE + 1]), a1 = pk2(P[BASE + 2], P[BASE + 3]); \
    unsigned b0 = pk2(P[BASE + 4], P[BASE + 5]), b1 = pk2(P[BASE + 6], P[BASE + 7]); \
    auto r0 = __builtin_amdgcn_permlane32_swap(a0, b0, false, false); auto r1 = __builtin_amdgcn_permlane32_swap(a1, b1, false, false); \
    v4u w = {r0[0], r1[0], r0[1], r1[1]}; OUT = __builtin_bit_cast(bf16x8, w); } while (0)
#pragma unroll
    for (int t = 0; t < 2; ++t) { bf16x8 pa0, pa1, pa2, pa3;
        PK4(s[t][0], 0, pa0); PK4(s[t][0], 8, pa1); PK4(s[t][1], 0, pa2); PK4(s[t][1], 8, pa3);
        const int vb = vb0 + (kt0 + t) * 8192;
        pv_one<0>(o[0], vb, pa0, pa1, pa2, pa3); pv_one<1>(o[1], vb, pa0, pa1, pa2, pa3); }
#undef PK4
}

struct MobaPre { bf16x8 k[4], v[4]; v2u lw; int c0, c1; };
__device__ __forceinline__ void moba_preload(Frame& F, int b, int h, int n, int sub, MobaPre& P) {
    int tid = F.tid; asm volatile("" : "+v"(tid));
    const size_t rowb = (size_t)b * SEQ; const int sr = tid >> 3, sc = (tid & 7) * 8;
    const bf16* Kg = (const bf16*)(F.ws + WS_K); const bf16* Vg = (const bf16*)(F.ws + WS_V);
#pragma unroll
    for (int t = 0; t < 4; ++t) { const size_t go = (rowb + n * 256 + t * 64 + sr) * ATTW + h * HD + sc; P.k[t] = *(const bf16x8*)(Kg + go); P.v[t] = *(const bf16x8*)(Vg + go); }
    const int* rc = (const int*)(F.ws + WS_RCNT) + (((size_t)(b * NH + h) * 16 + n) * 2 + sub) * 2;
    P.c0 = rc[0]; P.c1 = rc[1];
    const int hf = tid >> 8, e0 = (tid & 255) * 4;
    P.lw = *(const v2u*)((const unsigned short*)(F.ws + WS_RLIST) + ((((size_t)(b * NH + h) * 16 + n) * 2 + sub) * 2 + hf) * 1024 + e0);
}
__device__ __forceinline__ void moba_unit(Frame& F, int b, int h, int n, int sub, MobaPre& P) {
    const int tid = F.tid, lane = F.lane, wid = F.wave, r32 = lane & 31, hi = lane >> 5;
    LAS unsigned char* L = F.lds; const size_t rowb = (size_t)b * SEQ;
    LAS float* btab = (LAS float*)(L + LBT); LAS float* wsf = (LAS float*)(L + LWS) + wid * 64;
    LAS unsigned short* list = (LAS unsigned short*)(L + LLIST); LAS int* qctr = (LAS int*)(L + LKM + 64);
    const unsigned short* sel = (const unsigned short*)(F.ws + WS_SEL) + ((size_t)(b * NH + h)) * SEQ;
    __syncthreads();
    const int sr = tid >> 3, sc = (tid & 7) * 8; const int kst = KSWZ64(sr, sc * 2), vst = v_st(sr, sc);
    const int c0 = P.c0, c1 = P.c1;
    { const int hf = tid >> 8, e0 = (tid & 255) * 4; const int ch = hf ? c1 : c0, ob = hf ? c0 : 0; const v2u w = P.lw;
      if (e0 < ch) {
          list[ob + e0] = (unsigned short)(w.x & 0xffffu); if (e0 + 1 < ch) list[ob + e0 + 1] = (unsigned short)(w.x >> 16);
          if (e0 + 2 < ch) list[ob + e0 + 2] = (unsigned short)(w.y & 0xffffu); if (e0 + 3 < ch) list[ob + e0 + 3] = (unsigned short)(w.y >> 16); } }
    const int base = c0 + c1;
#pragma unroll
    for (int t = 0; t < 4; ++t) { *(LAS bf16x8*)(L + LK + t * 8192 + kst) = P.k[t]; *(LAS bf16x8*)(L + LV + t * 8192 + vst) = P.v[t]; }
    if (tid == 0) qctr[0] = 0;
    __syncthreads();
    const int count = base; const int ngroups = (count + 31) >> 5;
    const int nown = owned(n, sub) ? 8 : 0, nitems = nown + ngroups;
    const float b31 = btab[64 + 200];
    const int vb0 = (int)(unsigned)(uintptr_t)(L + LV) + v_rd_base(lane);
    const bf16* Qg = (const bf16*)(F.ws + WS_Q);
    unsigned char* PO8 = (unsigned char*)F.out; float* PL = (float*)(F.ws + WS_PL);
    typedef float f32x2_ __attribute__((ext_vector_type(2)));
    LAS unsigned char* stg = L + LSTG + wid * STG_WAVE;
#define PULL(v) do { int _v = 0; if (lane == 0) _v = __hip_atomic_fetch_add(qctr, 1, __ATOMIC_RELAXED, __HIP_MEMORY_SCOPE_WORKGROUP); v = __builtin_amdgcn_readfirstlane(_v); } while (0)
#define ITEM_ROW(it) (((it) < nown) ? (n * 256 + (7 - (it)) * 32 + r32) : (int)list[(((it) - nown) * 32 + r32) < count ? (((it) - nown) * 32 + r32) : count - 1])
    int cur; PULL(cur);
    bf16x8 qr[4]; int row = 0;
    if (cur < nitems) { row = ITEM_ROW(cur); const bf16* Qw = Qg + (rowb + row) * ATTW + h * HD + hi * 8;
#pragma unroll
        for (int d0 = 0; d0 < 4; ++d0) qr[d0] = *(const bf16x8*)(Qw + d0 * 16); }
    while (cur < nitems) {
        int nxt; PULL(nxt);
        const int rown = ITEM_ROW(nxt < nitems ? nxt : cur);
        const bf16* Qn = Qg + (rowb + rown) * ATTW + h * HD + hi * 8;
        float m_reg = -1e30f, l_reg = 0.f; f32x16 o[2]; o[0] = f32x16{}; o[1] = f32x16{};
        const unsigned msk = sel[row];
        if (cur < nown) {
            const int rg = 7 - cur; const int nkt = (rg >> 1) + 1;
            const size_t pi = ((rowb + row) * NH + h) * 3;
            float lsraw[3];
#pragma unroll
            for (int s = 0; s < 3; ++s) lsraw[s] = PL[pi + s];
            for (int kt = 0; kt < nkt; ++kt) tile_step<true>(L, kt, qr, 0.f, 64 + (rg * 32 + r32) - kt * 64 - 4 * hi, m_reg, l_reg, o, wsf, r32, hi, vb0);
            const int nv = __builtin_popcount(msk);
            const float lse_own = m_reg + __builtin_amdgcn_logf(l_reg);
            float ls[3]; float M = lse_own;
#pragma unroll
            for (int s = 0; s < 3; ++s) { ls[s] = (s < nv) ? lsraw[s] : -1e30f; M = fmaxf(M, ls[s]); }
            float wown = __builtin_amdgcn_exp2f(lse_own - M), ws_[3], W = wown;
#pragma unroll
            for (int s = 0; s < 3; ++s) { ws_[s] = __builtin_amdgcn_exp2f(ls[s] - M); W += ws_[s]; }
            const float rW = __builtin_amdgcn_rcpf(W);
            if (hi == 0) wsf[32 + r32] = wown * rW * __builtin_amdgcn_rcpf(l_reg); LDS_WAIT();
#pragma unroll
            for (int r = 0; r < 16; ++r) { const int orow = crow(r, hi); const float cf = wsf[32 + orow];
                *(LAS bf16*)(stg + orow * STG_ROW + r32 * 2) = (bf16)(pk2(o[0][r] * cf, 0.f) & 0xffffu); *(LAS bf16*)(stg + orow * STG_ROW + 64 + r32 * 2) = (bf16)(pk2(o[1][r] * cf, 0.f) & 0xffffu); }
            LDS_WAIT();
            float acc[32];
            { const LAS v4u* src = (const LAS v4u*)(stg + r32 * STG_ROW + hi * 64);
#pragma unroll
              for (int i = 0; i < 4; ++i) { const v4u w = src[i]; acc[8 * i] = bflo(w.x); acc[8 * i + 1] = bfhi(w.x); acc[8 * i + 2] = bflo(w.y); acc[8 * i + 3] = bfhi(w.y); acc[8 * i + 4] = bflo(w.z); acc[8 * i + 5] = bfhi(w.z); acc[8 * i + 6] = bflo(w.w); acc[8 * i + 7] = bfhi(w.w); } }
#pragma unroll
            for (int s = 0; s < 3; ++s) if (s < nv) { const float cs = ws_[s] * rW * (1.0f / A8_SCALE); const v4u* src = (const v4u*)(PO8 + (pi + s) * 64) + hi * 2;
#pragma unroll
                for (int i = 0; i < 2; ++i) { const v4u w = src[i]; const unsigned ww[4] = {w.x, w.y, w.z, w.w};
#pragma unroll
                    for (int q = 0; q < 4; ++q) { const f32x2_ lo = __builtin_amdgcn_cvt_pk_f32_fp8((int)ww[q], false), hi2 = __builtin_amdgcn_cvt_pk_f32_fp8((int)ww[q], true);
                        acc[16 * i + 4 * q] += cs * lo.x; acc[16 * i + 4 * q + 1] += cs * lo.y; acc[16 * i + 4 * q + 2] += cs * hi2.x; acc[16 * i + 4 * q + 3] += cs * hi2.y; } }
                asm volatile("" ::: "memory"); }
            { v4u* dst = (v4u*)(F.ws + WS_ATT + (rowb + row) * ATTW + h * HD) + hi * 2;
#pragma unroll
              for (int i = 0; i < 2; ++i) { v4u w; const float* a = acc + 16 * i;
                  w.x = pk4_fp8(a[0] * A8_SCALE, a[1] * A8_SCALE, a[2] * A8_SCALE, a[3] * A8_SCALE); w.y = pk4_fp8(a[4] * A8_SCALE, a[5] * A8_SCALE, a[6] * A8_SCALE, a[7] * A8_SCALE);
                  w.z = pk4_fp8(a[8] * A8_SCALE, a[9] * A8_SCALE, a[10] * A8_SCALE, a[11] * A8_SCALE); w.w = pk4_fp8(a[12] * A8_SCALE, a[13] * A8_SCALE, a[14] * A8_SCALE, a[15] * A8_SCALE); dst[i] = w; } }
            LDS_WAIT();
#pragma unroll
            for (int d0 = 0; d0 < 4; ++d0) qr[d0] = *(const bf16x8*)(Qn + d0 * 16);
        } else {
            const bool valid = ((cur - nown) * 32 + r32) < count;
            const bool adj = __any((row >> 8) == n + 1);
            if (adj) { const int ib = 64 + row - n * 256 - 4 * hi;
                tile_pair<true, true, false>(L, 0, qr, 0.f, ib, m_reg, l_reg, o, wsf, r32, hi, vb0, Qn); tile_pair<true, false, true>(L, 2, qr, 0.f, ib - 128, m_reg, l_reg, o, wsf, r32, hi, vb0, Qn); }
            else { tile_pair<false, true, false>(L, 0, qr, b31, 0, m_reg, l_reg, o, wsf, r32, hi, vb0, Qn); tile_pair<false, false, true>(L, 2, qr, b31, 0, m_reg, l_reg, o, wsf, r32, hi, vb0, Qn); }
            if (hi == 0) wsf[32 + r32] = l_reg; LDS_WAIT();
#pragma unroll
            for (int r = 0; r < 16; ++r) { const int orow = crow(r, hi); const float rl = __builtin_amdgcn_rcpf(wsf[32 + orow]);
                *(LAS bf16*)(stg + orow * STG_ROW + r32 * 2) = (bf16)(pk2(o[0][r] * rl, 0.f) & 0xffffu); *(LAS bf16*)(stg + orow * STG_ROW + 64 + r32 * 2) = (bf16)(pk2(o[1][r] * rl, 0.f) & 0xffffu); }
            LDS_WAIT();
            if (valid) {
                const int slot = __builtin_popcount(msk & ((1u << n) - 1u));
                const size_t pi = ((rowb + row) * NH + h) * 3 + slot;
                v4u* dst = (v4u*)(PO8 + pi * 64) + hi * 2; const LAS v4u* src = (const LAS v4u*)(stg + r32 * STG_ROW + hi * 64);
#pragma unroll
                for (int i = 0; i < 2; ++i) { const v4u a = src[2 * i], c = src[2 * i + 1]; v4u w;
                    w.x = pk4_fp8(bflo(a.x) * A8_SCALE, bfhi(a.x) * A8_SCALE, bflo(a.y) * A8_SCALE, bfhi(a.y) * A8_SCALE); w.y = pk4_fp8(bflo(a.z) * A8_SCALE, bfhi(a.z) * A8_SCALE, bflo(a.w) * A8_SCALE, bfhi(a.w) * A8_SCALE);
                    w.z = pk4_fp8(bflo(c.x) * A8_SCALE, bfhi(c.x) * A8_SCALE, bflo(c.y) * A8_SCALE, bfhi(c.y) * A8_SCALE); w.w = pk4_fp8(bflo(c.z) * A8_SCALE, bfhi(c.z) * A8_SCALE, bflo(c.w) * A8_SCALE, bfhi(c.w) * A8_SCALE); dst[i] = w; }
                if (hi == 0) PL[pi] = m_reg + __builtin_amdgcn_logf(l_reg);
            }
            LDS_WAIT();
        }
        cur = nxt; row = rown;
    }
#undef PULL
#undef ITEM_ROW
    asm volatile("" ::: "memory"); __builtin_amdgcn_sched_barrier(0);
    moba_preload(F, b, h, n + 1 < 16 ? n + 1 : 15, sub, P);
}
#undef SBAR
}

namespace ssm {
constexpr int LW = 0, LX = 65536, XSTR = 136, LT = 100352, LT2 = RING_BYTES + 2048;
static_assert(LX + 128 * XSTR * 2 <= LT && LT + 30 * 1024 <= RING_BYTES && LT2 >= TILEE_OFF && LT2 + 2048 <= LDS_BYTES, "SSM LDS map");
__device__ __forceinline__ float gelu_tanh(float x) {
    const float a = 0.7978845608028654f * (x + 0.044715f * x * x * x);
    const float e = __builtin_amdgcn_exp2f(2.0f * LOG2E * a);
    const float th = 1.0f - 2.0f * __builtin_amdgcn_rcpf(1.0f + e);
    return 0.5f * x * (1.0f + th);
}
__device__ __forceinline__ void ssm_unit(Frame& F, int b, int g) {
    const int lane = F.lane, w = F.wave, m = lane & 15, kq = lane >> 4;
    LAS unsigned char* L = F.lds;
    const bf16* Ug = (const bf16*)(F.ws + WS_U); unsigned char* Zg = F.ws + WS_Z;
    const unsigned char* gb = F.ws + WS_SSMTAB + (size_t)g * SSM_GRP_BYTES;
    const bf16x8* Wf = (const bf16x8*)(gb + SSM_W_OFF) + lane; const bf16x8* Sf = (const bf16x8*)(gb + SSM_S_OFF) + lane;
    const size_t rowb = (size_t)b * SEQ;
    bf16x8 A[16];
    { const bf16* up = Ug + (rowb + (size_t)(16 * w + m) * 32 + (kq >> 1)) * SSMW + g * 16 + 8 * (kq & 1);
#pragma unroll
      for (int ks = 0; ks < 16; ++ks) A[ks] = *(const bf16x8*)(up + (size_t)(2 * ks) * SSMW); }
    LAS float* Wl = (LAS float*)(L + LW);
    bf16x8 Bq[16], Bn[16];
#pragma unroll
    for (int ks = 0; ks < 16; ++ks) Bq[ks] = Wf[(ks * 8) * 64];
#define SSM_S1(BC, BN, nt_) do { const int ntn_ = (nt_) + 1 < 8 ? (nt_) + 1 : 7; \
        _Pragma("unroll") for (int ks = 0; ks < 16; ++ks) BN[ks] = Wf[(ks * 8 + ntn_) * 64]; \
        __builtin_amdgcn_sched_barrier(0); \
        pg8::f32x4 acc = {0.f, 0.f, 0.f, 0.f}, ac1 = acc, ac2 = acc, ac3 = acc;     \
        _Pragma("unroll") for (int ks = 0; ks < 16; ks += 4) { acc = __builtin_amdgcn_mfma_f32_16x16x32_bf16(A[ks], BC[ks], acc, 0, 0, 0); ac1 = __builtin_amdgcn_mfma_f32_16x16x32_bf16(A[ks + 1], BC[ks + 1], ac1, 0, 0, 0); \
            ac2 = __builtin_amdgcn_mfma_f32_16x16x32_bf16(A[ks + 2], BC[ks + 2], ac2, 0, 0, 0); ac3 = __builtin_amdgcn_mfma_f32_16x16x32_bf16(A[ks + 3], BC[ks + 3], ac3, 0, 0, 0); } \
        acc = (acc + ac1) + (ac2 + ac3); \
        _Pragma("unroll") for (int r = 0; r < 4; ++r) Wl[(16 * w + 4 * kq + r) * 128 + 16 * (nt_) + m] = acc[r]; } while (0)
#pragma unroll 1
    for (int nt = 0; nt < 8; nt += 2) { SSM_S1(Bq, Bn, nt); SSM_S1(Bn, Bq, nt + 1); }
#undef SSM_S1
    __syncthreads();
    bf16x8 tst[4];
#pragma unroll
    for (int i = 0; i < 4; ++i) tst[i] = *((const bf16x8*)(gb + SSM_T_OFF) + F.tid + 512 * i);
    LAS bf16* Xl = (LAS bf16*)(L + LX);
    if (F.tid < 64) {
        const int p = F.tid; const float* aL = (const float*)(F.ws + WS_SSMAL) + (g * 64 + p) * 2; const float ar = aL[0], ai = aL[1];
        float xr = 0.f, xi = 0.f;
#pragma unroll 8
        for (int c = 0; c < SSM_NCH; ++c) {
            Xl[c * XSTR + p] = (bf16)(pk2(xr, 0.f) & 0xffffu); Xl[c * XSTR + 64 + p] = (bf16)(pk2(xi, 0.f) & 0xffffu);
            const float wr_ = Wl[c * 128 + p], wi_ = Wl[c * 128 + 64 + p];
            const float nr = ar * xr - ai * xi + wr_, ni = ar * xi + ai * xr + wi_; xr = nr; xi = ni;
        }
    }
    bf16x8 Bs[4];
#pragma unroll
    for (int ks = 0; ks < 4; ++ks) Bs[ks] = Sf[(ks * 32) * 64];
#pragma unroll
    for (int i = 0; i < 4; ++i) { const int p = F.tid + 512 * i, e = p >> 6; *(LAS bf16x8*)(L + (e < 30 ? LT + e * 1024 : LT2 + (e - 30) * 1024) + (p & 63) * 16) = tst[i]; }
    __syncthreads();
    bf16x8 Xf[4];
#pragma unroll
    for (int ks = 0; ks < 4; ++ks) Xf[ks] = *(const LAS bf16x8*)(Xl + (16 * w + m) * XSTR + 32 * ks + 8 * kq);
#pragma unroll 1
    for (int par = 0; par < 2; ++par) {
        const bf16x8 zf = {0, 0, 0, 0, 0, 0, 0, 0};
        bf16x8 R[17], Bs1[4];
#pragma unroll
        for (int k = 0; k < 17; ++k) R[k] = zf;
#pragma unroll 1
        for (int tt0 = 0; tt0 < 16; tt0 += 2) {
#pragma unroll
            for (int k = 14; k >= 0; --k) { R[k + 2] = R[k]; asm volatile("" : "+v"(R[k + 2])); }
#pragma unroll
            for (int j4 = 0; j4 < 2; ++j4) { const int e = par + 2 * (tt0 + j4); R[1 - j4] = *(const LAS bf16x8*)(L + (e < 30 ? LT + e * 1024 : LT2 + (e - 30) * 1024) + lane * 16); }
#define SSM_STEP(j4, SC, SN) do { const int tt = tt0 + (j4), t = 2 * tt + par; \
                pg8::f32x4 acc = {0.f, 0.f, 0.f, 0.f}, ac1 = acc, ac2 = acc, ac3 = acc;     \
                { const int tn = tt + 1 < 16 ? t + 2 : (par == 0 ? 1 : 31);     \
                  _Pragma("unroll") for (int ks = 0; ks < 4; ++ks) SN[ks] = Sf[(ks * 32 + tn) * 64]; } \
                __builtin_amdgcn_sched_barrier(0); \
                acc = __builtin_amdgcn_mfma_f32_16x16x32_bf16(Xf[0], SC[0], acc, 0, 0, 0); ac1 = __builtin_amdgcn_mfma_f32_16x16x32_bf16(Xf[1], SC[1], ac1, 0, 0, 0); \
                ac2 = __builtin_amdgcn_mfma_f32_16x16x32_bf16(Xf[2], SC[2], ac2, 0, 0, 0); ac3 = __builtin_amdgcn_mfma_f32_16x16x32_bf16(Xf[3], SC[3], ac3, 0, 0, 0); \
                _Pragma("unroll") for (int ks = 0; ks < 16; ks += 4) if (ks <= tt) { \
                    acc = __builtin_amdgcn_mfma_f32_16x16x32_bf16(A[ks], R[ks + 1 - (j4)], acc, 0, 0, 0); \
                    if (ks + 1 <= tt) ac1 = __builtin_amdgcn_mfma_f32_16x16x32_bf16(A[ks + 1], R[ks + 2 - (j4)], ac1, 0, 0, 0); \
                    if (ks + 2 <= tt) ac2 = __builtin_amdgcn_mfma_f32_16x16x32_bf16(A[ks + 2], R[ks + 3 - (j4)], ac2, 0, 0, 0); \
                    if (ks + 3 <= tt) ac3 = __builtin_amdgcn_mfma_f32_16x16x32_bf16(A[ks + 3], R[ks + 4 - (j4)], ac3, 0, 0, 0); } \
                acc = (acc + ac1) + (ac2 + ac3); \
                _Pragma("unroll") for (int r = 0; r < 4; ++r) { const size_t tok = rowb + (size_t)(16 * w + 4 * kq + r) * 32 + t; const size_t o = tok * SSMW + g * 16 + m; \
                    Zg[o] = (unsigned char)(__builtin_amdgcn_cvt_pk_fp8_f32(clamp8(gelu_tanh(acc[r]) * A8_SCALE), 0.f, 0, false) & 0xff); } } while (0)
            SSM_STEP(0, Bs, Bs1); SSM_STEP(1, Bs1, Bs);
#undef SSM_STEP
        }
    }
    __syncthreads();
}
}

__device__ __forceinline__ void p3a_select_ssm(Frame& F) {
    const int bh = F.vcu >> 1;
    att::select_rows(F, bh >> 3, bh & 7, F.vcu & 1);
    ssm::ssm_unit(F, F.vcu >> 4, F.vcu & 15);
}
__device__ __forceinline__ void p3b_moba(Frame& F) {
    const int bh = F.vcu >> 1, sub = F.vcu & 1;
    { LAS float* btab = (LAS float*)(F.lds + att::LBT); const float* bt = (const float*)(F.ws + WS_BTAB) + (bh & 7) * 576; for (int i = F.tid; i < 576; i += 512) btab[i] = bt[i]; }
    att::MobaPre P; att::moba_preload(F, bh >> 3, bh & 7, 0, sub, P);
#pragma unroll 1
    for (int n = 0; n < 16; ++n) att::moba_unit(F, bh >> 3, bh & 7, n, sub, P);
}

__device__ __forceinline__ void p7_rows(Frame& F) {
    const int gw = F.vcu * NWAVES + F.wave; const int row0 = gw * 32, b = row0 >> 12;
    const float* mod = (const float*)(F.ws + WS_MOD) + b * 6144;
    f32x4 A1[4], A2[4], A3[4];
#pragma unroll
    for (int j = 0; j < 4; ++j) { const int c = 4 * F.lane + 256 * j;
        A1[j] = *(const f32x4*)(mod + 2048 + c) * *(const f32x4*)(F.in[I_GPOSTMIX] + c);
        A2[j] = *(const f32x4*)(F.in[I_GPREFFN] + c) * (*(const f32x4*)(mod + 4096 + c) + 1.0f);
        A3[j] = *(const f32x4*)(mod + 3072 + c); }
    const bf16* YM = (const bf16*)(F.ws + WS_YMIX); const float* ssq = (const float*)(F.ws + WS_SSQ);
    f32x4 nx[4]; unsigned ny[4]; float nq;
    { const f32x4* xr = (const f32x4*)(F.in[I_X] + (size_t)row0 * 1024) + F.lane; const unsigned* yr = (const unsigned*)((const unsigned char*)YM + (size_t)row0 * 2048) + F.lane;
#pragma unroll
      for (int j = 0; j < 4; ++j) { nx[j] = __builtin_nontemporal_load(xr + 64 * j); ny[j] = yr[64 * j]; }
      nq = ssq[(size_t)row0 * 16 + (F.lane & 15)]; }
    for (int r = 0; r < 32; ++r) {
        const size_t row = (size_t)(row0 + r);
        f32x4 xv[4]; unsigned yv[4]; float q = nq;
#pragma unroll
        for (int j = 0; j < 4; ++j) { xv[j] = nx[j]; yv[j] = ny[j]; }
        { const size_t rn = row + (r < 31 ? 1 : 0);
          const f32x4* xr = (const f32x4*)(F.in[I_X] + rn * 1024) + F.lane; const unsigned* yr = (const unsigned*)((const unsigned char*)YM + rn * 2048) + F.lane;
#pragma unroll
          for (int j = 0; j < 4; ++j) { nx[j] = __builtin_nontemporal_load(xr + 64 * j); ny[j] = yr[64 * j]; }
          nq = ssq[rn * 16 + (F.lane & 15)]; }
        q += __shfl_xor(q, 1); q += __shfl_xor(q, 2); q += __shfl_xor(q, 4); q += __shfl_xor(q, 8);
        const float rstd1 = rsqrtf(q * (1.0f / 1024.0f) + RMS_EPS) * 0.125f;
        v2u* xo = (v2u*)(row < (size_t)X1_SPLIT ? F.ws + WS_X1A + row * 2048 : F.ws + WS_X1B + (row - X1_SPLIT) * 2048) + F.lane;
        f32x4 v[4]; float s = 0.f;
#pragma unroll
        for (int j = 0; j < 4; ++j) { const pg8::f32x2_ ylo = __builtin_amdgcn_cvt_pk_f32_fp8((int)yv[j], false), yhi = __builtin_amdgcn_cvt_pk_f32_fp8((int)yv[j], true); const f32x4 y = {ylo.x, ylo.y, yhi.x, yhi.y};
            v[j] = xv[j] + A1[j] * (y * rstd1); { v2u xw; xw.x = pk2(v[j].x, v[j].y); xw.y = pk2(v[j].z, v[j].w); xo[64 * j] = xw; }
            s += (v[j].x * v[j].x + v[j].y * v[j].y) + (v[j].z * v[j].z + v[j].w * v[j].w); }
        const float rstd2 = rsqrtf(wave_sum(s) * (1.0f / 1024.0f) + RMS_EPS);
        unsigned* o8 = (unsigned*)(F.ws + WS_H2F8 + row * 1024) + F.lane;
        if (F.lane == 0) ((LAS float*)(F.lds + 122880))[F.wave * 32 + r] = rstd2;
#pragma unroll
        for (int j = 0; j < 4; ++j) { const f32x4 hs = (v[j] * rstd2 * A2[j] + A3[j]) * A8_SCALE; o8[64 * j] = pk4_fp8(hs.x, hs.y, hs.z, hs.w); }
    }
}

__device__ __forceinline__ void p8_router(Frame& F) {
    LAS unsigned char* L = F.lds;
    const int b = (F.vcu * 256) >> 12;
    LAS float* cb = (LAS float*)(L + 123904);
    { const v4u* src = (const v4u*)(F.ws + WS_ROUTW + (size_t)b * 98304); LAS v4u* dst = (LAS v4u*)L; for (int i = F.tid; i < 6144; i += 512) dst[i] = src[i];
      if (F.tid < 48) cb[F.tid] = ((const float*)(F.ws + WS_ROUTC))[b * 48 + F.tid]; }
    __syncthreads();
    const int lane = F.lane, m = lane & 15, kq = lane >> 4;
    LAS float* lg = (LAS float*)(L + 98304 + F.wave * 3072);
    const LAS float* rs2 = (const LAS float*)(L + 122880) + F.wave * 32;
    int* list = (int*)(F.ws + WS_LIST); float* wgt = (float*)(F.ws + WS_WGT);
    const int gw = F.vcu * NWAVES + F.wave;
    for (int tile = gw * 2; tile < gw * 2 + 2; ++tile) {
        const size_t arow = (size_t)(tile * 16 + m);
        const bf16* ap = (const bf16*)(arow < (size_t)X1_SPLIT ? F.ws + WS_X1A + arow * 2048 : F.ws + WS_X1B + (arow - X1_SPLIT) * 2048) + 8 * kq;
        pg8::f32x4 a0 = {0.f, 0.f, 0.f, 0.f}, a1 = a0, a2 = a0;
#pragma unroll 8
        for (int ks = 0; ks < 32; ++ks) { const bf16x8 av = *(const bf16x8*)(ap + 32 * ks);
            const LAS bf16x8* bp = (const LAS bf16x8*)L + (ks * 3) * 64 + lane;
            a0 = __builtin_amdgcn_mfma_f32_16x16x32_bf16(av, bp[0], a0, 0, 0, 0);
            a1 = __builtin_amdgcn_mfma_f32_16x16x32_bf16(av, bp[64], a1, 0, 0, 0);
            a2 = __builtin_amdgcn_mfma_f32_16x16x32_bf16(av, bp[128], a2, 0, 0, 0); }
#pragma unroll
        for (int r = 0; r < 4; ++r) { lg[(4 * kq + r) * 48 + m] = a0[r]; lg[(4 * kq + r) * 48 + 16 + m] = a1[r]; lg[(4 * kq + r) * 48 + 32 + m] = a2[r]; }
        LDS_WAIT(); asm volatile("" ::: "memory");
        if (lane < 16) {
            const LAS float* q = lg + lane * 48; const int tok = tile * 16 + lane; const float r2 = rs2[(tile & 1) * 16 + lane];
            float gl[4]; int gi = 0; float gm;
#pragma unroll
            for (int i = 0; i < 4; ++i) gl[i] = q[i] * r2 + cb[i];
            gm = gl[0];
#pragma unroll
            for (int i = 1; i < 4; ++i) if (gl[i] > gm) { gm = gl[i]; gi = i; }
            float gs = 0.f;
#pragma unroll
            for (int i = 0; i < 4; ++i) gs += __expf(gl[i] - gm);
            const float gp = 1.0f / gs;
            float e1 = -3.0e38f, e2 = -3.0e38f; int i1 = 0, i2 = 0;
#pragma unroll
            for (int i = 0; i < 8; ++i) { const float v = q[4 + gi * 8 + i] * r2 + cb[4 + gi * 8 + i];
                if (v > e1) { e2 = e1; i2 = i1; e1 = v; i1 = i; } else if (v > e2) { e2 = v; i2 = i; } }
            const float t = __expf(e2 - e1), w1 = gp / (1.0f + t), w2 = gp * t / (1.0f + t);
            const int x1 = gi * 8 + i1, x2 = gi * 8 + i2;
            const int p1 = (int)__hip_atomic_fetch_add(F.ctl + CW_CNT + 64 * x1, 1u, RLX_AGENT);
            const int p2 = (int)__hip_atomic_fetch_add(F.ctl + CW_CNT + 64 * x2, 1u, RLX_AGENT);
            list[(size_t)x1 * NTOK + p1] = tok * 2; list[(size_t)x2 * NTOK + p2] = tok * 2 + 1;
            wgt[tok * 2] = w1; wgt[tok * 2 + 1] = w2;
        }
        LDS_WAIT(); asm volatile("" ::: "memory");
    }
}

__device__ __forceinline__ int moe_layout(Frame& F) {
    LAS int* te = (LAS int*)(F.lds + TILEE_OFF);
    if (F.tid < 64) {
        const int e = F.tid; int c = 0;
        if (e < NEXP) c = (int)__hip_atomic_load(F.ctl + CW_CNT + 64 * e, RLX_AGENT);
        const int nt = (c + MOEB - 1) / MOEB; int incl = nt;
#pragma unroll
        for (int d = 1; d < 32; d <<= 1) { const int v = __shfl_up(incl, d); if (e >= d) incl += v; }
        const int start = incl - nt;
        if (e < NEXP) { te[600 + e] = start * MOEB; te[640 + e] = c; for (int t = 0; t < nt; ++t) te[start + t] = e; }
        if (e == NEXP - 1) te[600 + NEXP] = incl * MOEB;
    }
    __syncthreads();
    return te[600 + NEXP] / MOEB;
}

__device__ __forceinline__ void moe_rowmap(Frame& F, int ntiles, int cw, int nw) {
    LAS int* te = (LAS int*)(F.lds + TILEE_OFF);
    const int nrows = ntiles * MOEB;
    const int* list = (const int*)(F.ws + WS_LIST); int* rowmap = (int*)(F.ws + WS_ROWMAP);
    for (int r = cw * 512 + F.tid; r < nrows; r += nw * 512) {
        const int e = te[r >> 8]; const int i = r - te[600 + e];
        if (i < te[640 + e]) { const int tk = list[(size_t)e * NTOK + i]; rowmap[tk] = r; }
    }
}

__device__ __forceinline__ void p12_combine(Frame& F) {
    const int gw = F.vcu * NWAVES + F.wave; const int row0 = gw * 32, b = row0 >> 12;
    const float* mod = (const float*)(F.ws + WS_MOD) + b * 6144;
    f32x4 A1[4];
#pragma unroll
    for (int j = 0; j < 4; ++j) { const int c = 4 * F.lane + 256 * j; A1[j] = *(const f32x4*)(mod + 5120 + c) * *(const f32x4*)(F.in[I_GPOSTFFN] + c); }
    const unsigned char* YR = F.ws + WS_XS; const int* rowmap = (const int*)(F.ws + WS_ROWMAP);
    typedef float f32x2_ __attribute__((ext_vector_type(2)));
    const int myrm = rowmap[(size_t)row0 * 2 + F.lane];
    const float myw = ((const float*)(F.ws + WS_WGT))[(size_t)row0 * 2 + F.lane] * (1.0f / pg8::YR8_SCALE);
    unsigned na[4], nc[4]; v2u nxw[4];
#define CMB_LOAD(r_) do { const int r0_ = __shfl(myrm, 2 * (r_)), r1_ = __shfl(myrm, 2 * (r_) + 1); const size_t rw_ = (size_t)(row0 + (r_)); \
        const unsigned* y0_ = (const unsigned*)(YR + (size_t)r0_ * 1024) + F.lane; const unsigned* y1_ = (const unsigned*)(YR + (size_t)r1_ * 1024) + F.lane; \
        const v2u* xi_ = (const v2u*)(rw_ < (size_t)X1_SPLIT ? F.ws + WS_X1A + rw_ * 2048 : F.ws + WS_X1B + (rw_ - X1_SPLIT) * 2048) + F.lane; \
        _Pragma("unroll") for (int j = 0; j < 4; ++j) { na[j] = y0_[64 * j]; nc[j] = y1_[64 * j]; nxw[j] = xi_[64 * j]; } } while (0)
    CMB_LOAD(0);
    for (int r = 0; r < 32; ++r) {
        const size_t row = (size_t)(row0 + r);
        unsigned ca[4], cc[4]; v2u cx[4];
#pragma unroll
        for (int j = 0; j < 4; ++j) { ca[j] = na[j]; cc[j] = nc[j]; cx[j] = nxw[j]; }
        { const int rn = r < 31 ? r + 1 : r; CMB_LOAD(rn); }
        f32x4 f[4]; float s = 0.f; const float w0 = __shfl(myw, 2 * r), w1 = __shfl(myw, 2 * r + 1);
#pragma unroll
        for (int j = 0; j < 4; ++j) { const int a = (int)ca[j], c = (int)cc[j];
            const f32x2_ al = __builtin_amdgcn_cvt_pk_f32_fp8(a, false), ah = __builtin_amdgcn_cvt_pk_f32_fp8(a, true), cl = __builtin_amdgcn_cvt_pk_f32_fp8(c, false), ch = __builtin_amdgcn_cvt_pk_f32_fp8(c, true);
            f[j] = (f32x4){al.x * w0 + cl.x * w1, al.y * w0 + cl.y * w1, ah.x * w0 + ch.x * w1, ah.y * w0 + ch.y * w1};
            s += (f[j].x * f[j].x + f[j].y * f[j].y) + (f[j].z * f[j].z + f[j].w * f[j].w); }
        const float rstd = rsqrtf(wave_sum(s) * (1.0f / 1024.0f) + RMS_EPS);
        f32x4* xo = (f32x4*)(F.out + row * 1024) + F.lane;
#pragma unroll
        for (int j = 0; j < 4; ++j) { const v2u xw = cx[j]; const f32x4 x1 = {bflo(xw.x), bfhi(xw.x), bflo(xw.y), bfhi(xw.y)}; xo[64 * j] = x1 + A1[j] * (f[j] * rstd); }
    }
#undef CMB_LOAD
}

struct Args { const float* in[29]; float* out; unsigned char* ws; int ph_lo, ph_hi; };
#if defined(SPLIT5)
constexpr int N_PHASES = 10;
#else
constexpr int N_PHASES = 9;
#endif
#ifndef MK_N_LAUNCHES
#define MK_N_LAUNCHES 1
#endif

__global__ void __launch_bounds__(NWAVES * 64, 2) layer_fwd(Args args) {
    extern __shared__ __attribute__((aligned(16))) unsigned char lds[];
    Frame F;
    F.lds = (LAS unsigned char*)lds; F.MISC = (volatile LAS unsigned*)(F.lds + MISC_OFF);
    F.tid = threadIdx.x; F.lane = F.tid & 63; F.wave = __builtin_amdgcn_readfirstlane(F.tid >> 6);
    F.G = gridDim.x; { const int bx = blockIdx.x; F.vcu = (F.G % 8 == 0) ? (bx % 8) * (F.G / 8) + bx / 8 : bx; }
    F.ws = args.ws; F.ctl = (gu32*)(args.ws + WS_CTL); F.out = args.out;
#pragma unroll
    for (int i = 0; i < 29; ++i) F.in[i] = args.in[i];
    for (int u = F.tid; u < (LDS_BYTES - LDSCTL_OFF) / 4; u += NWAVES * 64) ((LAS unsigned*)(F.lds + LDSCTL_OFF))[u] = 0u;
    __syncthreads();
    XcdBarrier bar; bar.bar = (unsigned*)(F.ctl + CW_BAR); bar.x = 0; bar.st = nullptr;
    if (MK_N_LAUNCHES == 1) bar = xcd_barrier_post((unsigned*)(F.ctl + CW_BAR), F.MISC + 8);
    const int lo = args.ph_lo, hi = args.ph_hi;
#ifndef ONLYP
#define ONLYP -1
#endif
#define IN(k) ((ONLYP < 0 || ONLYP == (k)) && lo <= (k) && (k) < hi)
#define SEAM(k) do { if (IN(k) && IN((k) + 1)) xcd_barrier(bar); } while (0)
#define REFRESH() do { int t_ = threadIdx.x; asm volatile("" : "+v"(t_)); F.tid = t_; F.lane = t_ & 63; F.wave = __builtin_amdgcn_readfirstlane(t_ >> 6); } while (0)
    bf16* const RA = (bf16*)(F.ws + WS_RA); bf16* const RB = (bf16*)(F.ws + WS_RB);

    if (IN(0)) { REFRESH(); p0_mod(F); } SEAM(0);
    if (IN(1)) { REFRESH(); p1_xn(F); p0_tables(F); p0_weights(F, 0, WI_EXPERT); } SEAM(1);
    if (IN(2)) { REFRESH();
        pg8::Gemm g{RA, (const bf16*)(F.ws + WS_WIN), NTOK, NPROJ, DM / 2}; pg8::StaticOrder S; S.init(NTOK, NPROJ, F.G, (int)blockIdx.x);
        pg8::EpiProj E{(bf16*)(F.ws + WS_Q), (bf16*)(F.ws + WS_K), (bf16*)(F.ws + WS_V), (bf16*)(F.ws + WS_U), (bf16*)(F.ws + WS_GA), (bf16*)(F.ws + WS_GS), (float*)(F.ws + WS_KPART)};
        pg8::gemm_phase<pg8::EpiProj, pg8::StaticOrder, true, true, true>(F.lds, g, S, E, A8_E8, W8_E8);
    } SEAM(2);
    if (IN(3)) { REFRESH(); p3a_select_ssm(F); } SEAM(3);
    if (IN(4)) { REFRESH(); p3b_moba(F); } SEAM(4);
    if (IN(5)) { REFRESH();
        const int pm = F.vcu;
        if ((pm & 1) == 0) { p0_weights(F, WI_EXPERT, WI_END); VM_WAIT(); __syncthreads(); REFRESH(); }
        { pg8::Gemm g{(const bf16*)(F.ws + WS_Z), (const bf16*)(F.ws + WS_WGLU), NTOK, 2048, SSMW / 2}; pg8::PanelOrder S{pm, 8, pm & 7};
          pg8::EpiGlu E{(const bf16*)(F.ws + WS_GS), RA};
          pg8::gemm_phase<pg8::EpiGlu, pg8::PanelOrder, true, true, true>(F.lds, g, S, E, A8_E8, W8_E8); }
        VM_WAIT(); __syncthreads();
        { pg8::Gemm g{(const bf16*)(F.ws + WS_ATT), (const bf16*)(F.ws + WS_WO), NTOK, DM, ATTW / 2}; pg8::PanelOrder S{pm, 4, pm & 3};
          pg8::EpiAttOut E{F.ws + WS_GA, F.ws + WS_GS, RA, (unsigned char*)RB};
          pg8::gemm_phase<pg8::EpiAttOut, pg8::PanelOrder, true, true, true>(F.lds, g, S, E, A8_E8, W8_E8); }
        VM_WAIT(); __syncthreads();
        { pg8::Gemm g{RB, (const bf16*)(F.ws + WS_WMIX), NTOK, DM, DM / 2}; pg8::PanelOrder S{pm, 4, pm & 3};
          pg8::EpiMix E{(bf16*)(F.ws + WS_YMIX), (float*)(F.ws + WS_SSQ)};
          pg8::gemm_phase<pg8::EpiMix, pg8::PanelOrder, true, true, true>(F.lds, g, S, E, A8_E8, W8_E8); }
        VM_WAIT(); __syncthreads();
        REFRESH(); p7_rows(F);
        VM_WAIT(); __syncthreads();
#if !defined(SPLIT5)
        REFRESH(); p8_router(F);
        if ((F.vcu & 1) != 0) { REFRESH(); p0_weights(F, WI_EXPERT, WI_END); }
    } SEAM(5);
#else
        if ((F.vcu & 1) != 0) { REFRESH(); p0_weights(F, WI_EXPERT, WI_END); }
    } SEAM(5);
    if (IN(9)) { REFRESH(); p8_router(F); } if (IN(9) && IN(6)) xcd_barrier(bar);
#endif
    if (IN(6)) { REFRESH();
        const int ntiles = moe_layout(F);
        pg8::Gemm g{(const bf16*)(F.ws + WS_H2F8), (const bf16*)(F.ws + WS_WGU), ntiles * MOEB, DM, DM / 2};
        pg8::MoeOrder S{(const LAS int*)(F.lds + TILEE_OFF), (const int*)(F.ws + WS_LIST), ntiles, F.G, F.vcu};
        pg8::EpiMoe1 E{(unsigned char*)RA};
        pg8::gemm_phase_g<pg8::EpiMoe1, pg8::MoeOrder, true>(F.lds, g, S, E, A8_E8, W8_E8);
        { REFRESH(); const int n9 = (ntiles * 4) % F.G;
          if (F.vcu >= n9) moe_rowmap(F, ntiles, F.vcu - n9, F.G - n9); }
    } SEAM(6);
    if (IN(7)) { REFRESH();
        const int ntiles = moe_layout(F);
        pg8::Gemm g{RA, (const bf16*)(F.ws + WS_WDN), ntiles * MOEB, DM, DEXP / 2};
        pg8::MoeOrder S{(const LAS int*)(F.lds + TILEE_OFF), (const int*)(F.ws + WS_LIST), ntiles, F.G, F.vcu};
        pg8::EpiMoe2 E{F.ws + WS_XS, (const float*)(F.ws + WS_RW)};
        pg8::gemm_phase<pg8::EpiMoe2, pg8::MoeOrder, true, true, true>(F.lds, g, S, E, 124, W8_E8);
    } SEAM(7);
    if (IN(8)) { REFRESH(); p12_combine(F); }
#undef IN
#undef SEAM
}

extern "C" void kernel_launch(void* const* d_in, const int* in_sizes, int n_in, void* d_out, int out_size, void* d_ws, size_t ws_size, hipStream_t stream) {
    static int grid = 0;
    if (grid == 0) {
        if (n_in != 29 || in_sizes[0] != NTOK * DM || out_size != NTOK * DM || ws_size < WS_END) {
            fprintf(stderr, "kernel_launch: unexpected problem (n_in %d, in0 %d, out %d, ws %zu); nothing launched\n", n_in, n_in > 0 ? in_sizes[0] : -1, out_size, ws_size); grid = -1; return; }
        int dev = 0, cus = 0, per_cu = 0;
        if (hipGetDevice(&dev) != hipSuccess || hipDeviceGetAttribute(&cus, hipDeviceAttributeMultiprocessorCount, dev) != hipSuccess) { grid = -1; return; }
        if (hipFuncSetAttribute((const void*)layer_fwd, hipFuncAttributeMaxDynamicSharedMemorySize, LDS_BYTES) != hipSuccess) { fprintf(stderr, "kernel_launch: hipFuncSetAttribute failed\n"); grid = -1; return; }
        if (hipOccupancyMaxActiveBlocksPerMultiprocessor(&per_cu, (const void*)layer_fwd, NWAVES * 64, LDS_BYTES) != hipSuccess || per_cu < 1) fprintf(stderr, "kernel_launch: occupancy query says %d\n", per_cu);
        (void)hipGetLastError();
        grid = cus;
        if (grid != 256) { fprintf(stderr, "kernel_launch: this kernel is built for a 256-CU device (got %d)\n", grid); grid = -1; return; }
    }
    if (grid < 0) return;
    (void)hipMemsetAsync((char*)d_ws + WS_CTL, 0, CTL_ZERO_BYTES, stream);
    Args a{};
    for (int i = 0; i < 29; ++i) a.in[i] = (const float*)d_in[i];
    a.out = (float*)d_out; a.ws = (unsigned char*)d_ws;
#if MK_N_LAUNCHES == 1
    void* kargs[] = {&a};
#if defined(PROBE_A)
    a.ph_lo = 0; a.ph_hi = PROBE_A;
    (void)hipLaunchCooperativeKernel((const void*)layer_fwd, dim3(grid), dim3(NWAVES * 64), kargs, LDS_BYTES, stream);
    (void)hipMemsetAsync((char*)d_ws + WS_CTL + CW_BAR * 4, 0, XCD_BAR_WORDS * 4, stream);
    a.ph_lo = PROBE_B; a.ph_hi = N_PHASES;
    (void)hipLaunchCooperativeKernel((const void*)layer_fwd, dim3(grid), dim3(NWAVES * 64), kargs, LDS_BYTES, stream);
#else
    a.ph_lo = 0; a.ph_hi = N_PHASES;
    hipError_t e = hipLaunchCooperativeKernel((const void*)layer_fwd, dim3(grid), dim3(NWAVES * 64), kargs, LDS_BYTES, stream);
    if (e != hipSuccess) fprintf(stderr, "kernel_launch: cooperative launch failed: %s\n", hipGetErrorString(e));
#endif
#else
    for (int p = 0; p < N_PHASES; ++p) { a.ph_lo = p; a.ph_hi = p + 1; hipLaunchKernelGGL(layer_fwd, dim3(grid), dim3(NWAVES * 64), LDS_BYTES, stream, a); }
#endif
}
```
